# Optimizing an MI355X kernel written in HIP

```python
import jax, jax.numpy as jnp
from jax import lax
import numpy as np

D_MODEL = 4096
BATCH = 1
SEQ = 8192
DEPTH = 1

RMS_EPS = 1e-6

RWKV_HEADS = 32
RWKV_HEAD_DIM = 64
RWKV_WIDTH = RWKV_HEADS * RWKV_HEAD_DIM
DECAY_LORA = 64
ICLR_LORA = 64
GATE_LORA = 256
GN_EPS = 64e-5
RWKV_COLS = 3 * RWKV_WIDTH + DECAY_LORA + ICLR_LORA + GATE_LORA
RWKV_SPLITS = (RWKV_WIDTH, 2 * RWKV_WIDTH, 3 * RWKV_WIDTH,
               3 * RWKV_WIDTH + DECAY_LORA, 3 * RWKV_WIDTH + DECAY_LORA + ICLR_LORA)

MOBA_HEADS = 16
MOBA_HEAD_DIM = 128
MOBA_WIDTH = MOBA_HEADS * MOBA_HEAD_DIM
MOBA_BLOCK = 256
MOBA_TOPK = 3
MOBA_QCHUNK = 64
MOBA_COLS = 3 * MOBA_WIDTH

GATE_COLS = 2 * D_MODEL
IN_COLS = RWKV_COLS + MOBA_COLS + GATE_COLS

PEER_HEADS = 8
PEER_NKEYS = 128
PEER_EXPERTS = PEER_NKEYS * PEER_NKEYS
PEER_QDIM = 256
PEER_HALF = PEER_QDIM // 2
PEER_TOPK = 16
PEER_TCHUNK = 64

kernel_name = "hybrid_rwkv7_moba_peer_gated"


def rms_norm(x, g):
    xf = x.astype(jnp.float32)
    y = xf * lax.rsqrt(jnp.mean(xf * xf, axis=-1, keepdims=True) + RMS_EPS)
    return (y * g.astype(jnp.float32)).astype(x.dtype)


def _rwkv7_step(state, inp):
    r_t, w_t, k_t, v_t, a_t, b_t = inp
    sa = jnp.einsum('bhvk,bhk->bhv', state, a_t)
    state = (state * w_t[:, :, None, :] + sa[..., None] * b_t[:, :, None, :]
             + v_t[..., None] * k_t[:, :, None, :])
    y = jnp.einsum('bhvk,bhk->bhv', state, r_t)
    return state, y


def rwkv7_time_mix(z, mu, w0, w2, a0, a2, g2, k_k, k_a, r_k, gn_w, gn_b):
    B, S, _ = z.shape
    H, N = RWKV_HEADS, RWKV_HEAD_DIM
    out_dtype = z.dtype
    z = z.astype(jnp.float32)
    z_prev = jnp.pad(z, ((0, 0), (1, 0), (0, 0)))[:, :S]
    z = z + (z_prev - z) * mu
    r, k, v, wd, ad, gd = jnp.split(z, RWKV_SPLITS, axis=-1)
    w_log = -jax.nn.softplus(-(w0 + jnp.tanh(wd) @ w2)) - 0.5
    decay = jnp.exp(-jnp.exp(w_log))
    iclr = jax.nn.sigmoid(a0 + ad @ a2)
    g = jax.nn.sigmoid(gd) @ g2
    kk = (k * k_k).reshape(B, S, H, N)
    kk = kk * lax.rsqrt(jnp.sum(kk * kk, axis=-1, keepdims=True) + 1e-12)
    k = k * (1.0 + (iclr - 1.0) * k_a)
    r_h, k_h, v_h, w_h, a_h = (t.reshape(B, S, H, N) for t in (r, k, v, decay, iclr))
    xs = tuple(t.transpose(1, 0, 2, 3) for t in (r_h, w_h, k_h, v_h, -kk, kk * a_h))
    state0 = jnp.zeros((B, H, N, N), jnp.float32)
    _, y = lax.scan(_rwkv7_step, state0, xs)
    y = y.transpose(1, 0, 2, 3)
    mean = jnp.mean(y, axis=-1, keepdims=True)
    var = jnp.mean(jnp.square(y - mean), axis=-1, keepdims=True)
    y = ((y - mean) * lax.rsqrt(var + GN_EPS)).reshape(B, S, H * N) * gn_w + gn_b
    bonus = jnp.sum(r_h * k_h * r_k, axis=-1, keepdims=True) * v_h
    y = (y + bonus.reshape(B, S, H * N)) * g
    return y.astype(out_dtype)


def moba_attention(q, k, v):
    B, S, _ = q.shape
    H, D, BS, QC = MOBA_HEADS, MOBA_HEAD_DIM, MOBA_BLOCK, MOBA_QCHUNK
    NB = -(-S // BS)
    S_pad = NB * BS

    def heads(t):
        t = jnp.pad(t, ((0, 0), (0, S_pad - S), (0, 0)))
        return t.reshape(B, S_pad, H, D).transpose(0, 2, 1, 3)

    q, k, v = heads(q), heads(k), heads(v)
    kb = k.reshape(B, H, NB, BS, D)
    vb = v.reshape(B, H, NB, BS, D)
    k_mean = jnp.mean(kb.astype(jnp.float32), axis=3)
    gate = jnp.einsum('bhsd,bhnd->bhsn', q.astype(jnp.float32), k_mean)
    q_blk = jnp.arange(S_pad) // BS
    fully_past = jnp.arange(NB)[None, :] < q_blk[:, None]
    gate = jnp.where(fully_past, gate, -jnp.inf)
    n_sel = min(MOBA_TOPK, NB)
    _, sel = lax.top_k(gate, n_sel)
    valid = jnp.arange(n_sel)[None, :] < q_blk[:, None]
    n_chunks = S_pad // QC
    q_c = q.reshape(B, H, n_chunks, QC, D).transpose(2, 0, 1, 3, 4)
    sel_c = sel.reshape(B, H, n_chunks, QC, n_sel).transpose(2, 0, 1, 3, 4)
    valid_c = valid.reshape(n_chunks, QC, n_sel)
    bi = jnp.arange(B)[:, None, None, None]
    hi = jnp.arange(H)[None, :, None, None]
    scale = D ** -0.5

    def one_chunk(args):
        c, qc, selc, validc = args
        pos = c * QC + jnp.arange(QC)
        own = (c * QC) // BS
        k_sel = kb[bi, hi, selc]
        v_sel = vb[bi, hi, selc]
        s_past = jnp.einsum('bhqd,bhqjnd->bhqjn', qc, k_sel) * scale
        s_past = jnp.where(validc[None, None, :, :, None], s_past, -jnp.inf)
        k_own = lax.dynamic_index_in_dim(kb, own, axis=2, keepdims=False)
        v_own = lax.dynamic_index_in_dim(vb, own, axis=2, keepdims=False)
        s_own = jnp.einsum('bhqd,bhnd->bhqn', qc, k_own) * scale
        kpos = own * BS + jnp.arange(BS)
        s_own = jnp.where(kpos[None, :] <= pos[:, None], s_own, -jnp.inf)
        s = jnp.concatenate([s_past.reshape(B, H, QC, n_sel * BS), s_own], axis=-1)
        p = jax.nn.softmax(s.astype(jnp.float32), axis=-1).astype(v.dtype)
        p_past = p[..., :n_sel * BS].reshape(B, H, QC, n_sel, BS)
        p_own = p[..., n_sel * BS:]
        return (jnp.einsum('bhqjn,bhqjnd->bhqd', p_past, v_sel)
                + jnp.einsum('bhqn,bhnd->bhqd', p_own, v_own))

    o = lax.map(one_chunk, (jnp.arange(n_chunks), q_c, sel_c, valid_c))
    o = o.transpose(1, 2, 0, 3, 4).reshape(B, H, S_pad, D).transpose(0, 2, 1, 3)
    return o.reshape(B, S_pad, H * D)[:, :S]


def peer_ffn(x, w_q, sub_keys, u_tab, v_tab):
    B, S, Dm = x.shape
    qry = (x @ w_q).reshape(B, S, PEER_HEADS, 2, PEER_HALF)
    scores = jnp.einsum('bshcd,hcnd->bshcn', qry, sub_keys).astype(jnp.float32)
    s_top, i_top = lax.top_k(scores, PEER_TOPK)
    cand = (s_top[..., 0, :, None] + s_top[..., 1, None, :]).reshape(B, S, PEER_HEADS, PEER_TOPK ** 2)
    cand_idx = (i_top[..., 0, :, None] * PEER_NKEYS + i_top[..., 1, None, :]).reshape(B, S, PEER_HEADS, PEER_TOPK ** 2)
    best, pos = lax.top_k(cand, PEER_TOPK)
    expert = jnp.take_along_axis(cand_idx, pos, axis=-1)
    gate = jax.nn.softmax(best, axis=-1)
    T = B * S
    E = PEER_HEADS * PEER_TOPK
    n_chunks = T // PEER_TCHUNK
    xf = x.reshape(n_chunks, PEER_TCHUNK, Dm)
    ef = expert.reshape(n_chunks, PEER_TCHUNK, E)
    gf = gate.reshape(n_chunks, PEER_TCHUNK, E)

    def one_chunk(args):
        xc, ec, gc = args
        u = u_tab[ec]
        hid = jax.nn.gelu(jnp.einsum('td,ted->te', xc, u).astype(jnp.float32), approximate=False)
        return jnp.einsum('te,ted->td', (gc * hid).astype(xc.dtype), v_tab[ec])

    y = lax.map(one_chunk, (xf, ef, gf))
    return y.reshape(B, S, Dm)


def setup_inputs(seed: int = 0) -> dict:
    key = jax.random.key(seed)
    ks = jax.random.split(key, 24)
    f32 = jnp.float32
    L = DEPTH

    def nrm(k, shape, scale):
        return jax.random.normal(k, shape, f32) * scale

    return {
        "x": nrm(ks[0], (BATCH, SEQ, D_MODEL), 1.0),
        "ln1_g": 1.0 + nrm(ks[1], (L, D_MODEL), 0.02),
        "w_in": nrm(ks[2], (L, D_MODEL, IN_COLS), D_MODEL ** -0.5),
        "rwkv_mu": jax.random.uniform(ks[3], (L, RWKV_COLS), f32),
        "rwkv_w0": jax.random.uniform(ks[4], (L, RWKV_WIDTH), f32, -6.0, -1.0),
        "rwkv_w2": nrm(ks[5], (L, DECAY_LORA, RWKV_WIDTH), 0.5 * DECAY_LORA ** -0.5),
        "rwkv_a0": nrm(ks[6], (L, RWKV_WIDTH), 0.1),
        "rwkv_a2": nrm(ks[7], (L, ICLR_LORA, RWKV_WIDTH), 0.5 * ICLR_LORA ** -0.5),
        "rwkv_g2": nrm(ks[8], (L, GATE_LORA, RWKV_WIDTH), GATE_LORA ** -0.5),
        "rwkv_k_k": 0.85 + nrm(ks[9], (L, RWKV_WIDTH), 0.02),
        "rwkv_k_a": 1.0 + nrm(ks[10], (L, RWKV_WIDTH), 0.02),
        "rwkv_r_k": nrm(ks[11], (L, RWKV_HEADS, RWKV_HEAD_DIM), 0.1),
        "rwkv_gn_w": 1.0 + nrm(ks[12], (L, RWKV_WIDTH), 0.02),
        "rwkv_gn_b": nrm(ks[13], (L, RWKV_WIDTH), 0.02),
        "w_proj_rwkv": nrm(ks[14], (L, RWKV_WIDTH, D_MODEL), RWKV_WIDTH ** -0.5),
        "w_proj_moba": nrm(ks[15], (L, MOBA_WIDTH, D_MODEL), MOBA_WIDTH ** -0.5),
        "w_out": nrm(ks[16], (L, D_MODEL, D_MODEL), D_MODEL ** -0.5),
        "ln2_g": 1.0 + nrm(ks[17], (L, D_MODEL), 0.02),
        "peer_w_q": nrm(ks[18], (L, D_MODEL, PEER_HEADS * PEER_QDIM), D_MODEL ** -0.5),
        "peer_sub_keys": nrm(ks[19], (L, PEER_HEADS, 2, PEER_NKEYS, PEER_HALF), PEER_HALF ** -0.5),
        "peer_u": nrm(ks[20], (L, PEER_EXPERTS, D_MODEL), D_MODEL ** -0.5),
        "peer_v": nrm(ks[21], (L, PEER_EXPERTS, D_MODEL), PEER_HEADS ** -0.5),
        "ln_f_g": 1.0 + nrm(ks[22], (D_MODEL,), 0.02),
    }


def reference(x, ln1_g, w_in, rwkv_mu, rwkv_w0, rwkv_w2, rwkv_a0, rwkv_a2, rwkv_g2,
              rwkv_k_k, rwkv_k_a, rwkv_r_k, rwkv_gn_w, rwkv_gn_b,
              w_proj_rwkv, w_proj_moba, w_out, ln2_g,
              peer_w_q, peer_sub_keys, peer_u, peer_v, ln_f_g):
    h = x
    for l in range(DEPTH):
        xn = rms_norm(h, ln1_g[l])
        z = xn @ w_in[l]
        z_rwkv = z[..., :RWKV_COLS]
        z_moba = z[..., RWKV_COLS:RWKV_COLS + MOBA_COLS]
        z_gate = z[..., RWKV_COLS + MOBA_COLS:]
        y_a = rwkv7_time_mix(z_rwkv, rwkv_mu[l], rwkv_w0[l], rwkv_w2[l], rwkv_a0[l], rwkv_a2[l],
                             rwkv_g2[l], rwkv_k_k[l], rwkv_k_a[l], rwkv_r_k[l],
                             rwkv_gn_w[l], rwkv_gn_b[l])
        q_b, k_b, v_b = jnp.split(z_moba, 3, axis=-1)
        y_b = moba_attention(q_b, k_b, v_b)
        gate_a, gate_b = jnp.split(jax.nn.sigmoid(z_gate), 2, axis=-1)
        merged = gate_a * (y_a @ w_proj_rwkv[l]) + gate_b * (y_b @ w_proj_moba[l])
        h = h + merged @ w_out[l]
        hn = rms_norm(h, ln2_g[l])
        h = h + peer_ffn(hn, peer_w_q[l], peer_sub_keys[l], peer_u[l], peer_v[l])
    return rms_norm(h, ln_f_g)
```

```cpp
#include <hip/hip_runtime.h>
#include <cstdio>
#include <cstdint>
__device__ __forceinline__ int fresh_lane() { int l; asm volatile("v_mbcnt_lo_u32_b32 %0, -1, 0\n\tv_mbcnt_hi_u32_b32 %0, -1, %0" : "=v"(l)); return l; }
namespace pg8 {
#define PG8_LAS __attribute__((address_space(3)))
typedef unsigned short bf16_t;
typedef short bf16x8 __attribute__((ext_vector_type(8)));
typedef float f32x4 __attribute__((ext_vector_type(4)));
typedef unsigned u32x4 __attribute__((ext_vector_type(4)));
constexpr int BM = 256, BK = 64, HALF = 128, HTB = HALF * BK * 2  , STAGE_BYTES = 8 * HTB, NXCD = 8, WGM = 8;

__host__ __device__ __forceinline__ int lds_byte(int r, int c) { const int st = (r >> 4) * 2 + (c >> 5), rr = r & 15, cc = c & 31, ob = rr * 64 + cc * 2; return st * 1024 + (ob ^ (((ob >> 9) & 1) << 5)); }
__host__ __device__ __forceinline__ void stage_rc(int b, int& R, int& C) { const int st = b / 1024, sb = b % 1024, swz = sb ^ (((sb >> 9) & 1) << 5); R = (st >> 1) * 16 + swz / 64; C = (st & 1) * 32 + (swz % 64) / 2; }
__host__ __device__ __forceinline__ int perm32(int rho) { const int n = rho >> 4, i = rho & 15; return 8 * (i >> 2) + 4 * n + (i & 3); }

struct Unit { int pm, pn; };
struct Gemm { const bf16_t* A; const bf16_t* Bt; int M, N, K; };

struct StaticOrder {
    int nM, nN, nwg, G, c;
    __host__ __device__ void init(int M, int N, int G_, int c_) { nM = M / BM; nN = N / BM; nwg = nM * nN; G = G_; c = c_; }
    __host__ __device__ bool next(int i, Unit& u) const {
        const long L = (long)i * G + c; if (L >= nwg) return false;
        int wgid = (int)L; { const int q = nwg / NXCD, r = nwg % NXCD, xcd = wgid % NXCD, off = wgid / NXCD; wgid = (xcd < r ? xcd * (q + 1) : r * (q + 1) + (xcd - r) * q) + off; }
        const int nig = WGM * nN, gid = wgid / nig, fm = gid * WGM, gsz = (nM - fm) < WGM ? (nM - fm) : WGM;
        u.pm = fm + ((wgid % nig) % gsz); u.pn = (wgid % nig) / gsz; return true;
    }
    __device__ __forceinline__ void a_ready(const Unit&) const {}
    __device__ __forceinline__ void done(const Unit&) const {}
};


__device__ __forceinline__ unsigned cvt_pk_bf16(float lo, float hi) { unsigned r; asm volatile("v_cvt_pk_bf16_f32 %0, %1, %2" : "=v"(r) : "v"(lo), "v"(hi)); return r; }
typedef float f32x2 __attribute__((ext_vector_type(2)));
typedef unsigned u32x2 __attribute__((ext_vector_type(2)));
__device__ __forceinline__ float fast_sigmoid(float x) { return __builtin_amdgcn_rcpf(1.0f + __builtin_amdgcn_exp2f(-1.44269504089f * x)); }
__device__ __forceinline__ float bf_lo(unsigned w) { return __uint_as_float(w << 16); }
__device__ __forceinline__ float bf_hi(unsigned w) { return __uint_as_float(w & 0xffff0000u); }

struct EpiBf16 {
    static constexpr bool PERM = true, AFTER_DRAIN = false;
    bf16_t* O; int ldc;
    __device__ __forceinline__ void operator()(const f32x4 (&acc)[2][2][4][2], const Unit& u, int wr, int wc, int fr_, int fq_) const {
        const int l_ = fresh_lane(), fr = l_ & 15, fq = l_ >> 4;
        const int row0 = u.pm * BM + wr * 64 + fr, col0 = u.pn * BM + wc * 32 + 8 * fq;
#pragma unroll
        for (int ai = 0; ai < 2; ++ai)
#pragma unroll
            for (int m = 0; m < 4; ++m) { bf16_t* rowp = O + (size_t)(row0 + ai * HALF + m * 16) * ldc + col0;
#pragma unroll
                for (int bj = 0; bj < 2; ++bj) { const f32x4 v0 = acc[ai][bj][m][0], v1 = acc[ai][bj][m][1];
                    u32x4 w; w.x = cvt_pk_bf16(v0[0], v0[1]); w.y = cvt_pk_bf16(v0[2], v0[3]); w.z = cvt_pk_bf16(v1[0], v1[1]); w.w = cvt_pk_bf16(v1[2], v1[3]);
                    *(u32x4*)(rowp + bj * HALF) = w; } }
    }
};
struct EpiZ {
    static constexpr bool PERM = true, AFTER_DRAIN = false;
    bf16_t *ZR, *ZM, *ZG; int pn0;
    __device__ __forceinline__ void operator()(const f32x4 (&acc)[2][2][4][2], const Unit& u, int wr, int wc, int fr_, int fq_) const {
        const int l_ = fresh_lane(), fr = l_ & 15, fq = l_ >> 4;
        bf16_t* base; int ldc, colt; bool sig = false; const int pn = u.pn + pn0;
        if (pn < 26) { base = ZR; ldc = 6656; colt = pn * BM; }
        else if (pn < 50) { base = ZM; ldc = 6144; colt = (pn - 26) * BM; }
        else { base = ZG; ldc = 8192; colt = (pn - 50) * BM; sig = true; }
        const int row0 = u.pm * BM + wr * 64 + fr, col0 = colt + wc * 32 + 8 * fq;
#pragma unroll
        for (int ai = 0; ai < 2; ++ai)
#pragma unroll
            for (int m = 0; m < 4; ++m) { bf16_t* rowp = base + (size_t)(row0 + ai * HALF + m * 16) * ldc + col0;
#pragma unroll
                for (int bj = 0; bj < 2; ++bj) { f32x4 v0 = acc[ai][bj][m][0], v1 = acc[ai][bj][m][1];
                    if (sig) {
#pragma unroll
                        for (int j = 0; j < 4; ++j) { v0[j] = fast_sigmoid(v0[j]); v1[j] = fast_sigmoid(v1[j]); } }
                    u32x4 w; w.x = cvt_pk_bf16(v0[0], v0[1]); w.y = cvt_pk_bf16(v0[2], v0[3]); w.z = cvt_pk_bf16(v1[0], v1[1]); w.w = cvt_pk_bf16(v1[2], v1[3]);
                    *(u32x4*)(rowp + bj * HALF) = w; } }
    }
};
struct EpiLora {
    static constexpr bool PERM = false, AFTER_DRAIN = false;
    float *WDEC, *ICLR, *GG; const float *w0, *a0;
    __device__ __forceinline__ void operator()(const f32x4 (&acc)[2][2][4][2], const Unit& u, int wr, int wc, int fr_, int fq_) const {
        const int l_ = fresh_lane(), fr = l_ & 15, fq = l_ >> 4;
        const int mode = u.pn >> 3; float* base = WDEC + (size_t)mode * ((size_t)8192 * 2048);
        bf16_t* baseh = (bf16_t*)base;
        const int row0 = u.pm * BM + wr * 64 + fr, col0 = (u.pn & 7) * BM + wc * 32 + 4 * fq;
        const float* bp = mode == 0 ? w0 : a0;
#pragma unroll
        for (int ai = 0; ai < 2; ++ai)
#pragma unroll
            for (int m = 0; m < 4; ++m) { const size_t ro = (size_t)(row0 + ai * HALF + m * 16) * 2048 + col0;
#pragma unroll
                for (int bj = 0; bj < 2; ++bj)
#pragma unroll
                    for (int n = 0; n < 2; ++n) { f32x4 v = acc[ai][bj][m][n];
                        if (mode < 2) v += *(const f32x4*)(bp + col0 + bj * HALF + n * 16);
                        if (mode == 0) {
#pragma unroll
                            for (int j = 0; j < 4; ++j) { const float x = -v[j]; const float sp = fmaxf(x, 0.f) + __logf(1.0f + __expf(-fabsf(x))); v[j] = __expf(-__expf(-sp - 0.5f)); } }
                        else if (mode == 1) {
#pragma unroll
                            for (int j = 0; j < 4; ++j) v[j] = fast_sigmoid(v[j]); }
                        if (mode == 0) *(f32x4*)(base + ro + bj * HALF + n * 16) = v;
                        else { u32x2 w; w.x = cvt_pk_bf16(v[0], v[1]); w.y = cvt_pk_bf16(v[2], v[3]); *(u32x2*)(baseh + ro + bj * HALF + n * 16) = w; } }
                asm volatile("" ::: "memory"); }
    }
};
struct EpiGateMul {
    static constexpr bool PERM = false, AFTER_DRAIN = false;
    bf16_t* T; int ldc; const bf16_t* G; int ldg;
    __device__ __forceinline__ void operator()(const f32x4 (&acc)[2][2][4][2], const Unit& u, int wr, int wc, int fr_, int fq_) const {
        const int l_ = fresh_lane(), fr = l_ & 15, fq = l_ >> 4;
        const int row0 = u.pm * BM + wr * 64 + fr, col0 = u.pn * BM + wc * 32 + 4 * fq;
#pragma unroll
        for (int ai = 0; ai < 2; ++ai)
#pragma unroll
            for (int m = 0; m < 4; ++m) { const size_t r = (size_t)(row0 + ai * HALF + m * 16);
#pragma unroll
                for (int bj = 0; bj < 2; ++bj)
#pragma unroll
                    for (int n = 0; n < 2; ++n) { const u32x2 g = *(const u32x2*)(G + r * ldg + col0 + bj * HALF + n * 16); const f32x4 a = acc[ai][bj][m][n];
                        u32x2 w; w.x = cvt_pk_bf16(a[0] * bf_lo(g.x), a[1] * bf_hi(g.x)); w.y = cvt_pk_bf16(a[2] * bf_lo(g.y), a[3] * bf_hi(g.y)); *(u32x2*)(T + r * ldc + col0 + bj * HALF + n * 16) = w; } }
    }
};
struct EpiGateAdd {
    static constexpr bool PERM = false, AFTER_DRAIN = false;
    const bf16_t* T; int ldc; const bf16_t* G; int ldg; bf16_t* O;
    __device__ __forceinline__ void operator()(const f32x4 (&acc)[2][2][4][2], const Unit& u, int wr, int wc, int fr_, int fq_) const {
        const int l_ = fresh_lane(), fr = l_ & 15, fq = l_ >> 4;
        const int row0 = u.pm * BM + wr * 64 + fr, col0 = u.pn * BM + wc * 32 + 4 * fq;
#pragma unroll
        for (int ai = 0; ai < 2; ++ai)
#pragma unroll
            for (int m = 0; m < 4; ++m) { const size_t r = (size_t)(row0 + ai * HALF + m * 16);
#pragma unroll
                for (int bj = 0; bj < 2; ++bj)
#pragma unroll
                    for (int n = 0; n < 2; ++n) { const u32x2 g = *(const u32x2*)(G + r * ldg + col0 + bj * HALF + n * 16); const f32x4 a = acc[ai][bj][m][n];
                        const u32x2 t = *(const u32x2*)(T + r * ldc + col0 + bj * HALF + n * 16);
                        u32x2 w; w.x = cvt_pk_bf16(bf_lo(t.x) + a[0] * bf_lo(g.x), bf_hi(t.x) + a[1] * bf_hi(g.x)); w.y = cvt_pk_bf16(bf_lo(t.y) + a[2] * bf_lo(g.y), bf_hi(t.y) + a[3] * bf_hi(g.y));
                        *(u32x2*)(O + r * ldc + col0 + bj * HALF + n * 16) = w; }
                asm volatile("" ::: "memory"); }
    }
};
struct EpiRes {
    static constexpr bool PERM = false, AFTER_DRAIN = false;
    float* C; const float* R; int ldc;
    __device__ __forceinline__ void operator()(const f32x4 (&acc)[2][2][4][2], const Unit& u, int wr, int wc, int fr_, int fq_) const {
        const int l_ = fresh_lane(), fr = l_ & 15, fq = l_ >> 4;
        const int row0 = u.pm * BM + wr * 64 + fr, col0 = u.pn * BM + wc * 32 + 4 * fq;
#pragma unroll
        for (int ai = 0; ai < 2; ++ai)
#pragma unroll
            for (int m = 0; m < 4; ++m) { const size_t r = (size_t)(row0 + ai * HALF + m * 16);
#pragma unroll
                for (int bj = 0; bj < 2; ++bj)
#pragma unroll
                    for (int n = 0; n < 2; ++n) { const size_t o = r * ldc + col0 + bj * HALF + n * 16; *(f32x4*)(C + o) = *(const f32x4*)(R + o) + acc[ai][bj][m][n]; } }
    }
};

struct EpiResNorm {
    static constexpr bool PERM = false, AFTER_DRAIN = false;
    const float* R; int ldc; bf16_t* HB; float* PSQ;
    __device__ __forceinline__ void operator()(const f32x4 (&acc)[2][2][4][2], const Unit& u, int wr, int wc, int fr_, int fq_) const {
        const int l_ = fresh_lane(), fr = l_ & 15, fq = l_ >> 4;
        const int row0 = u.pm * BM + wr * 64 + fr, col0 = u.pn * BM + wc * 32 + 4 * fq;
#pragma unroll
        for (int ai = 0; ai < 2; ++ai)
#pragma unroll
            for (int m = 0; m < 4; ++m) { const size_t r = (size_t)(row0 + ai * HALF + m * 16); float ss = 0.f;
#pragma unroll
                for (int bj = 0; bj < 2; ++bj)
#pragma unroll
                    for (int n = 0; n < 2; ++n) { const size_t o = r * ldc + col0 + bj * HALF + n * 16; const f32x4 c = *(const f32x4*)(R + o) + acc[ai][bj][m][n];
                        ss += (c[0] * c[0] + c[1] * c[1]) + (c[2] * c[2] + c[3] * c[3]);
                        u32x2 w; w.x = cvt_pk_bf16(c[0], c[1]); w.y = cvt_pk_bf16(c[2], c[3]); *(u32x2*)(HB + o) = w; }
                ss += __builtin_bit_cast(float, __builtin_amdgcn_ds_bpermute((l_ ^ 16) << 2, __builtin_bit_cast(int, ss)));
                ss += __builtin_bit_cast(float, __builtin_amdgcn_ds_bpermute((l_ ^ 32) << 2, __builtin_bit_cast(int, ss)));
                if (fq == 0) PSQ[r * 64 + u.pn * 4 + wc] = ss;
                asm volatile("" ::: "memory"); }
    }
};

typedef int i32x8 __attribute__((ext_vector_type(8)));
typedef int i32x4 __attribute__((ext_vector_type(4)));
template <class Epi, class Sched, bool ALIGN_EPI = false, bool SP2 = false, bool F8 = false>
__device__ __forceinline__ void gemm_phase(PG8_LAS unsigned char* lds, const Gemm g, const Sched& S, const Epi& E, int wid_) {
    const int wid = __builtin_amdgcn_readfirstlane(wid_), lane = fresh_lane(), tid = wid * 64 + lane, wr = wid >> 2, wc = wid & 3, fr = lane & 15, fq = lane >> 4;
    const int K = g.K, nt = K / BK;
    unsigned voffA, voffB;
    { int R, C; stage_rc(tid * 16, R, C); const int Rb = Epi::PERM ? ((R & ~31) + perm32(R & 31)) : R; voffA = (unsigned)(R * K + C) * 2u; voffB = (unsigned)(Rb * K + C) * 2u; }
    const size_t rstep64 = (size_t)64 * K * 2;
    const size_t kstep = (size_t)(BK * 2);
    const size_t hstep = (size_t)HALF * K * 2;
    const size_t tstep = 2 * hstep;
    const unsigned ldsw = (unsigned)wid * 1024u;
    const int aoff = lds_byte(wr * 64 + fr, fq * 8), boff = lds_byte(wc * 32 + fr, fq * 8);
#define PG8_SA(b, h) (((b) * 2 + (h)) * HTB)
#define PG8_SB(b, h) ((4 + (b) * 2 + (h)) * HTB)
#define PG8_STAGE(bufoff, gbase, voff) do { _Pragma("unroll") for (int _i = 0; _i < 2; ++_i) \
        __builtin_amdgcn_global_load_lds((const unsigned*)((const char*)(gbase) + _i * rstep64 + (voff)), (PG8_LAS unsigned*)(lds + (bufoff) + ldsw + _i * 8192), 16, 0, 0); } while (0)
#define PG8_LDA(dst, b, h) do { _Pragma("unroll") for (int m = 0; m < 4; ++m) { if constexpr (F8) { const i32x4 _lo = *(const PG8_LAS i32x4*)(lds + PG8_SA(b, h) + aoff + m * 2048), _hi = *(const PG8_LAS i32x4*)(lds + PG8_SA(b, h) + aoff + m * 2048 + 1024); dst##8[m] = __builtin_shufflevector(_lo, _hi, 0, 1, 2, 3, 4, 5, 6, 7); } \
        else { _Pragma("unroll") for (int k = 0; k < 2; ++k) dst[m][k] = *(const PG8_LAS bf16x8*)(lds + PG8_SA(b, h) + aoff + m * 2048 + k * 1024); } } } while (0)
#define PG8_LDB(dst, b, h) do { _Pragma("unroll") for (int n = 0; n < 2; ++n) { if constexpr (F8) { const i32x4 _lo = *(const PG8_LAS i32x4*)(lds + PG8_SB(b, h) + boff + n * 2048), _hi = *(const PG8_LAS i32x4*)(lds + PG8_SB(b, h) + boff + n * 2048 + 1024); dst##8[n] = __builtin_shufflevector(_lo, _hi, 0, 1, 2, 3, 4, 5, 6, 7); } \
        else { _Pragma("unroll") for (int k = 0; k < 2; ++k) dst[n][k] = *(const PG8_LAS bf16x8*)(lds + PG8_SB(b, h) + boff + n * 2048 + k * 1024); } } } while (0)
#define PG8_MMA(ai, bj, At, Bt) do { __builtin_amdgcn_s_setprio(1); _Pragma("unroll") for (int m = 0; m < 4; ++m) _Pragma("unroll") for (int n = 0; n < 2; ++n) { \
        if constexpr (F8) acc[ai][bj][m][n] = __builtin_amdgcn_mfma_scale_f32_16x16x128_f8f6f4(Bt##8[n], At##8[m], acc[ai][bj][m][n], 0, 0, 0, 0x7b77, 1, 0x7b77); \
        else { _Pragma("unroll") for (int k = 0; k < 2; ++k) acc[ai][bj][m][n] = __builtin_amdgcn_mfma_f32_16x16x32_bf16(Bt[n][k], At[m][k], acc[ai][bj][m][n], 0, 0, 0); } } __builtin_amdgcn_s_setprio(0); } while (0)
#define PG8_WAIT_V(n) asm volatile("s_waitcnt vmcnt(" #n ")" ::: "memory")
#define PG8_WAIT_L(n) asm volatile("s_waitcnt lgkmcnt(" #n ")" ::: "memory")
#define PG8_BAR __builtin_amdgcn_s_barrier()
#define PG8_SCHED __builtin_amdgcn_sched_barrier(0)
    Unit cur, nxt; int ui = 0;
    if (!S.next(0, cur)) return;
    f32x4 acc[2][2][4][2];
#pragma unroll
    for (int a = 0; a < 2; ++a)
#pragma unroll
        for (int b = 0; b < 2; ++b)
#pragma unroll
            for (int m = 0; m < 4; ++m)
#pragma unroll
                for (int n = 0; n < 2; ++n) acc[a][b][m][n] = (f32x4){0.f, 0.f, 0.f, 0.f};
    bf16x8 At[4][2], B0[2][2], B1[2][2]; i32x8 At8[4], B08[2], B18[2];
    const char* cA = (const char*)g.A + (size_t)cur.pm * tstep; const char* cB = (const char*)g.Bt + (size_t)cur.pn * tstep;
    S.a_ready(cur);
    if constexpr (SP2) {
        PG8_STAGE(PG8_SB(0, 0), cB, voffB); PG8_STAGE(PG8_SB(0, 1), cB + hstep, voffB); PG8_STAGE(PG8_SA(0, 0), cA, voffA); PG8_STAGE(PG8_SA(0, 1), cA + hstep, voffA);
        if (wr == 1) PG8_BAR;
        PG8_WAIT_V(2); PG8_BAR;
        PG8_STAGE(PG8_SB(1, 0), cB + kstep, voffB); PG8_STAGE(PG8_SA(1, 0), cA + kstep, voffA); PG8_STAGE(PG8_SB(1, 1), cB + hstep + kstep, voffB);
        PG8_WAIT_V(6); PG8_BAR;
    } else {
        PG8_STAGE(PG8_SB(0, 0), cB, voffB); PG8_STAGE(PG8_SA(0, 0), cA, voffA); PG8_STAGE(PG8_SB(0, 1), cB + hstep, voffB); PG8_STAGE(PG8_SA(0, 1), cA + hstep, voffA);
        if (wr == 1) PG8_BAR;
        PG8_WAIT_V(4); PG8_BAR;
        PG8_STAGE(PG8_SB(1, 0), cB + kstep, voffB); PG8_STAGE(PG8_SA(1, 0), cA + kstep, voffA); PG8_STAGE(PG8_SB(1, 1), cB + hstep + kstep, voffB);
        PG8_WAIT_V(6); PG8_BAR;
    }
    for (;;) {
        const bool has_next = S.next(ui + 1, nxt);
        const char* nA = has_next ? (const char*)g.A + (size_t)nxt.pm * tstep : cA; const char* nB = has_next ? (const char*)g.Bt + (size_t)nxt.pn * tstep : cB;
        for (int t = 0; t < nt; t += 2) {
            const bool last = (t == nt - 2);
            const char* a1 = cA + (size_t)(t + 1) * kstep;
            const char* a2 = last ? nA : cA + (size_t)(t + 2) * kstep; const char* b2 = last ? nB : cB + (size_t)(t + 2) * kstep;
            const char* a3 = a2 + kstep; const char* b3 = b2 + kstep;
            if (last && has_next) S.a_ready(nxt);
            if constexpr (SP2) {
            PG8_LDB(B0, 0, 0); PG8_LDB(B1, 0, 1); PG8_SCHED; PG8_LDA(At, 0, 0); PG8_STAGE(PG8_SA(1, 1), a1 + hstep, voffA);
            PG8_WAIT_V(8); PG8_WAIT_L(0); PG8_BAR; PG8_MMA(0, 0, At, B0); PG8_MMA(0, 1, At, B1); PG8_BAR; PG8_SCHED;
            PG8_LDA(At, 0, 1); PG8_STAGE(PG8_SB(0, 0), b2, voffB); PG8_STAGE(PG8_SB(0, 1), b2 + hstep, voffB); PG8_STAGE(PG8_SA(0, 0), a2, voffA);
            PG8_WAIT_V(8); PG8_WAIT_L(0); PG8_BAR; PG8_MMA(1, 0, At, B0); PG8_MMA(1, 1, At, B1); PG8_BAR; PG8_SCHED;
            PG8_LDB(B0, 1, 0); PG8_LDB(B1, 1, 1); PG8_SCHED; PG8_LDA(At, 1, 0); PG8_STAGE(PG8_SA(0, 1), a2 + hstep, voffA);
            PG8_WAIT_V(8); PG8_WAIT_L(0); PG8_BAR; PG8_MMA(0, 0, At, B0); PG8_MMA(0, 1, At, B1); PG8_BAR; PG8_SCHED;
            PG8_LDA(At, 1, 1); PG8_STAGE(PG8_SB(1, 0), b3, voffB); PG8_STAGE(PG8_SB(1, 1), b3 + hstep, voffB); PG8_STAGE(PG8_SA(1, 0), a3, voffA);
            PG8_WAIT_V(8); PG8_WAIT_L(0); PG8_BAR; PG8_MMA(1, 0, At, B0); PG8_MMA(1, 1, At, B1); PG8_BAR; PG8_SCHED;
            } else {
            PG8_LDB(B0, 0, 0); PG8_SCHED; PG8_LDA(At, 0, 0); PG8_STAGE(PG8_SA(1, 1), a1 + hstep, voffA);
            PG8_WAIT_L(8); PG8_BAR; PG8_WAIT_L(0); PG8_MMA(0, 0, At, B0); PG8_BAR; PG8_SCHED;
            PG8_LDB(B1, 0, 1); PG8_STAGE(PG8_SB(0, 0), b2, voffB);
            PG8_BAR; PG8_WAIT_L(0); PG8_MMA(0, 1, At, B1); PG8_BAR;
            PG8_LDA(At, 0, 1); PG8_STAGE(PG8_SA(0, 0), a2, voffA);
            PG8_BAR; PG8_WAIT_L(0); PG8_MMA(1, 0, At, B0); PG8_BAR; PG8_SCHED;
            PG8_STAGE(PG8_SB(0, 1), b2 + hstep, voffB);
            PG8_WAIT_V(6); PG8_BAR; PG8_MMA(1, 1, At, B1); PG8_BAR;
            PG8_LDB(B0, 1, 0); PG8_SCHED; PG8_LDA(At, 1, 0); PG8_STAGE(PG8_SA(0, 1), a2 + hstep, voffA);
            PG8_WAIT_L(8); PG8_BAR; PG8_WAIT_L(0); PG8_MMA(0, 0, At, B0); PG8_BAR; PG8_SCHED;
            PG8_LDB(B1, 1, 1); PG8_STAGE(PG8_SB(1, 0), b3, voffB);
            PG8_BAR; PG8_WAIT_L(0); PG8_MMA(0, 1, At, B1); PG8_BAR;
            PG8_LDA(At, 1, 1); PG8_STAGE(PG8_SA(1, 0), a3, voffA);
            PG8_BAR; PG8_WAIT_L(0); PG8_MMA(1, 0, At, B0); PG8_BAR; PG8_SCHED;
            PG8_STAGE(PG8_SB(1, 1), b3 + hstep, voffB);
            PG8_WAIT_V(6); PG8_BAR; PG8_MMA(1, 1, At, B1); PG8_BAR;
            }
        }
        if constexpr (ALIGN_EPI) { if (wr == 0) PG8_BAR; }
        if constexpr (!Epi::AFTER_DRAIN) { E(acc, cur, wr, wc, fr, fq); S.done(cur); }
        if (!has_next) break;
#pragma unroll
        for (int a = 0; a < 2; ++a)
#pragma unroll
            for (int b = 0; b < 2; ++b)
#pragma unroll
                for (int m = 0; m < 4; ++m)
#pragma unroll
                    for (int n = 0; n < 2; ++n) acc[a][b][m][n] = (f32x4){0.f, 0.f, 0.f, 0.f};
        cur = nxt; cA = nA; cB = nB; ++ui;
        if constexpr (ALIGN_EPI) { if (wr == 1) PG8_BAR; }
    }
    PG8_WAIT_V(0);
    if constexpr (!ALIGN_EPI) { if (wr == 0) PG8_BAR; }
    PG8_BAR;
    if constexpr (Epi::AFTER_DRAIN) { E.fused(acc, cur, wr, wc, fr, fq, lds, wid, lane); S.done(cur); }
#undef PG8_SA
#undef PG8_SB
#undef PG8_STAGE
#undef PG8_LDA
#undef PG8_LDB
#undef PG8_MMA
#undef PG8_WAIT_V
#undef PG8_WAIT_L
#undef PG8_BAR
#undef PG8_SCHED
}
}

#ifndef PG8_SP2
#define PG8_SP2 true
#endif
#ifndef PG8_ALIGN
#define PG8_ALIGN true
#endif

constexpr int S_ = 8192, D_ = 4096;
constexpr int RW = 2048, RH = 32, RN = 64;
constexpr int IN_COLS = 20864, RWKV_COLS = 6528;
constexpr int ZR_LD = 6656, ZM_LD = 6144, ZG_LD = 8192, ZN = ZR_LD + ZM_LD + ZG_LD;
constexpr int MH = 16, MD = 128, MBS = 256, MNB = 32;
constexpr int PH = 8, PNK = 128, PE = 16384, PT = 16;
constexpr int LORA_K = 384, LORA_N = 6144;
constexpr int SCAN_REC = 896;
constexpr int NWAVES = 8;
constexpr int N_PHASES = 13;
#ifndef MK_N_LAUNCHES
#define MK_N_LAUNCHES 1
#endif

constexpr size_t MiB = 1u << 20;
constexpr size_t WS_CTL = 0, CTL_ZERO_BYTES = 1 * MiB;
constexpr size_t WS_KMEAN = 1 * MiB;
constexpr size_t WS_SUBK = 2 * MiB;
constexpr size_t WS_LORABT = 3 * MiB;
constexpr size_t WS_LORAA = 8 * MiB;
constexpr size_t WS_PIDX = 14 * MiB;
constexpr size_t WS_PG = 18 * MiB;
constexpr size_t WS_BC = 22 * MiB;
constexpr size_t WS_WPA = 32 * MiB;
constexpr size_t WS_WPB = 48 * MiB;
constexpr size_t WS_WOUT = 64 * MiB;
constexpr size_t WS_WQ = 96 * MiB;
constexpr size_t WS_U8 = 112 * MiB;
constexpr size_t WS_V8 = 176 * MiB;
constexpr size_t WS_VSC = 240 * MiB;
constexpr size_t WS_USC = 244 * MiB;
constexpr size_t WS_PSQ = 8 * MiB;
constexpr size_t WS_WINT = 368 * MiB;
constexpr size_t WS_WINT8 = 368 * MiB;
constexpr size_t WS_XN8 = 476 * MiB;
constexpr size_t WS_XN = 532 * MiB;
constexpr size_t WS_WDEC = 432 * MiB;
constexpr size_t WS_ICLR = 496 * MiB;
constexpr size_t WS_GG = 560 * MiB;
constexpr size_t WS_PARTO = 432 * MiB;
constexpr size_t WS_PARTML = 692 * MiB;
constexpr size_t WS_MLIST = 23 * MiB;
constexpr size_t WS_YA = 368 * MiB;
constexpr size_t WS_YB = 400 * MiB;
constexpr size_t WS_HN8 = 368 * MiB;
constexpr size_t WS_HN = 564 * MiB;
constexpr size_t WS_ZR = 628 * MiB;
constexpr size_t WS_Y = 628 * MiB;
constexpr size_t WS_QRY = 692 * MiB;
constexpr size_t WS_ZM = 732 * MiB;
constexpr size_t WS_ZG = 828 * MiB;
constexpr size_t WS_SCAN = 956 * MiB;
constexpr size_t WS_TMP = 956 * MiB;
constexpr size_t WS_MERGED = 1084 * MiB;
constexpr size_t WS_END = 1180 * MiB;
constexpr size_t WS_H1R = 732 * MiB;

constexpr int CW_BAR = 4096;
constexpr int CW_MCNT = 16384;

constexpr int RING_BYTES = 131072;
constexpr int LDS_BYTES = 147456;
constexpr int LDSCTL_OFF = LDS_BYTES - 1024, MISC_OFF = LDSCTL_OFF + 320;

#define GAS __attribute__((address_space(1)))
#define LAS __attribute__((address_space(3)))
typedef unsigned short bf16;
typedef unsigned v4u __attribute__((ext_vector_type(4)));
typedef unsigned v2u __attribute__((ext_vector_type(2)));
typedef float f32x4 __attribute__((ext_vector_type(4)));
typedef float f32x2 __attribute__((ext_vector_type(2)));
typedef __bf16 bf2_t __attribute__((ext_vector_type(2)));
#define LDS_WAIT() asm volatile("s_waitcnt lgkmcnt(0)" ::: "memory")
#define VM_WAIT() asm volatile("s_waitcnt vmcnt(0)" ::: "memory")
__device__ __forceinline__ unsigned f2bf(float f) { unsigned u = __builtin_bit_cast(unsigned, f); return (u + 0x7fffu + ((u >> 16) & 1u)) >> 16; }
__device__ __forceinline__ unsigned pk2(float lo, float hi) { return f2bf(lo) | (f2bf(hi) << 16); }
__device__ __forceinline__ float bflo(unsigned w) { return __uint_as_float(w << 16); }
__device__ __forceinline__ float bfhi(unsigned w) { return __uint_as_float(w & 0xffff0000u); }
__device__ __forceinline__ f32x4 bf4(v2u w) { return (f32x4){bflo(w.x), bfhi(w.x), bflo(w.y), bfhi(w.y)}; }
__device__ __forceinline__ float bf1(bf16 h) { return __uint_as_float(((unsigned)h) << 16); }
__device__ __forceinline__ float dot2bf(unsigned a, unsigned b, float c) { return __builtin_amdgcn_fdot2_f32_bf16(__builtin_bit_cast(bf2_t, a), __builtin_bit_cast(bf2_t, b), c, false); }
__device__ __forceinline__ float sigmoidf_(float x) { return 1.0f / (1.0f + __expf(-x)); }

#define XB_TMO      128
#define XB_XCNT(j)  (256  + 64 * (j))
#define XB_XSUB(j)  (1280 + 64 * (j))
#define XB_XGEN(j)  (2304 + 64 * (j))
#define XB_TOP      3328
#define XB_TOPGEN   3392
#define XCD_BAR_WORDS 3456
#define XB_SPIN_CAP (1u << 18)
__device__ __forceinline__ unsigned xb_ld(unsigned* p)              { return __hip_atomic_load(p, __ATOMIC_RELAXED, __HIP_MEMORY_SCOPE_AGENT); }
__device__ __forceinline__ unsigned xb_add(unsigned* p, unsigned v) { return __hip_atomic_fetch_add(p, v, __ATOMIC_RELAXED, __HIP_MEMORY_SCOPE_AGENT); }
__device__ __forceinline__ unsigned xb_xcc_id() { return (unsigned)__builtin_amdgcn_s_getreg((3 << 11) | 20) & 0xFu; }
#define XB_SPIN(cond, bar) do { unsigned _sp = 0; while (cond) { __builtin_amdgcn_s_sleep(1); \
    if ((++_sp & 255u) == 0u) { if (xb_ld(&(bar)[XB_TMO])) break; if (_sp > XB_SPIN_CAP) { atomicAdd(&(bar)[XB_TMO], 1u); break; } } } } while (0)
struct XcdBarrier { unsigned* bar; unsigned x; volatile LAS unsigned* st; };
__device__ __forceinline__ XcdBarrier xcd_barrier_post(unsigned* bar, volatile LAS unsigned* st) {
    XcdBarrier b; b.bar = bar; b.x = xb_xcc_id(); b.st = st;
    if (threadIdx.x == 0) (void)xb_add(&bar[XB_XCNT(b.x)], 1u);
    return b;
}
__device__ __forceinline__ void xcd_barrier_complete(unsigned* bar, unsigned x, unsigned& nloc, unsigned& nx) {
    const unsigned G = gridDim.x * gridDim.y * gridDim.z;
    unsigned sum, cnt, mine, sp = 0u;
    for (;;) {
        sum = 0u; cnt = 0u; mine = 0u;
#pragma unroll
        for (unsigned j = 0; j < 16; ++j) { const unsigned c = xb_ld(&bar[XB_XCNT(j)]); sum += c; cnt += (c > 0u) ? 1u : 0u; mine = (j == x) ? c : mine; }
        if (sum == G) break;
        __builtin_amdgcn_s_sleep(1);
        if ((++sp & 255u) == 0u) { if (xb_ld(&bar[XB_TMO])) break; if (sp > XB_SPIN_CAP) { atomicAdd(&bar[XB_TMO], 1u); break; } }
    }
    nloc = mine > 0u ? mine : 1u; nx = cnt > 0u ? cnt : 1u;
}
__device__ __forceinline__ void xcd_barrier(const XcdBarrier& b) {
    asm volatile("s_waitcnt vmcnt(0)" ::: "memory");
    __syncthreads();
    if (threadIdx.x == 0) {
        unsigned* bar = b.bar;
        __builtin_amdgcn_s_waitcnt(0);
        unsigned nloc = b.st[0], nx = b.st[1];
        if (nloc == 0u) { xcd_barrier_complete(bar, b.x, nloc, nx); b.st[0] = nloc; b.st[1] = nx; }
        const unsigned old = xb_add(&bar[XB_XSUB(b.x)], 1u);
        const unsigned gen = old / nloc;
        if (old + 1u == (gen + 1u) * nloc) {
            __builtin_amdgcn_fence(__ATOMIC_RELEASE, "agent");
            asm volatile("s_waitcnt vmcnt(0)" ::: "memory");
            const unsigned og = xb_add(&bar[XB_TOP], 1u);
            const unsigned tg = og / nx;
            if (og + 1u == (tg + 1u) * nx) xb_add(&bar[XB_TOPGEN], 1u);
            else XB_SPIN(xb_ld(&bar[XB_TOPGEN]) == tg, bar);
            __builtin_amdgcn_fence(__ATOMIC_ACQUIRE, "agent");
            xb_add(&bar[XB_XGEN(b.x)], 1u);
            asm volatile("s_waitcnt vmcnt(0)" ::: "memory");
        } else {
            XB_SPIN(xb_ld(&bar[XB_XGEN(b.x)]) == gen, bar);
            __builtin_amdgcn_fence(__ATOMIC_ACQUIRE, "agent");
            asm volatile("s_waitcnt vmcnt(0)" ::: "memory");
        }
    }
    __syncthreads();
}

struct Frame {
    LAS unsigned char* lds;
    int tid, lane, wave, G, gw, NGW;
    const float* const* in;
    float* out;
    unsigned char* ws;
};
__device__ __forceinline__ float dpp_add16(float v) {
    v += __builtin_bit_cast(float, __builtin_amdgcn_update_dpp(0, __builtin_bit_cast(int, v), 0xB1, 0xF, 0xF, false));
    v += __builtin_bit_cast(float, __builtin_amdgcn_update_dpp(0, __builtin_bit_cast(int, v), 0x4E, 0xF, 0xF, false));
    v += __builtin_bit_cast(float, __builtin_amdgcn_update_dpp(0, __builtin_bit_cast(int, v), 0x141, 0xF, 0xF, false));
    v += __builtin_bit_cast(float, __builtin_amdgcn_update_dpp(0, __builtin_bit_cast(int, v), 0x140, 0xF, 0xF, false));
    return v;
}
__device__ __forceinline__ float dpp_max16(float v) {
    v = fmaxf(v, __builtin_bit_cast(float, __builtin_amdgcn_update_dpp(0, __builtin_bit_cast(int, v), 0xB1, 0xF, 0xF, false)));
    v = fmaxf(v, __builtin_bit_cast(float, __builtin_amdgcn_update_dpp(0, __builtin_bit_cast(int, v), 0x4E, 0xF, 0xF, false)));
    v = fmaxf(v, __builtin_bit_cast(float, __builtin_amdgcn_update_dpp(0, __builtin_bit_cast(int, v), 0x141, 0xF, 0xF, false)));
    v = fmaxf(v, __builtin_bit_cast(float, __builtin_amdgcn_update_dpp(0, __builtin_bit_cast(int, v), 0x140, 0xF, 0xF, false)));
    return v;
}
__device__ __forceinline__ float rdlane(float v, int l) { return __builtin_bit_cast(float, __builtin_amdgcn_readlane(__builtin_bit_cast(int, v), l)); }
__device__ __forceinline__ float wave_sum(float v) { v = dpp_add16(v); return (rdlane(v, 0) + rdlane(v, 16)) + (rdlane(v, 32) + rdlane(v, 48)); }
__device__ __forceinline__ float wave_max(float v) { v = dpp_max16(v); return fmaxf(fmaxf(rdlane(v, 0), rdlane(v, 16)), fmaxf(rdlane(v, 32), rdlane(v, 48))); }

__device__ __forceinline__ void p0_transpose_item(const float* W, int K, int N, bf16* WT, int row_add, LAS float* scr, int item, int lane, const float* kscale = nullptr) {
    const int nblk = N / 32, kb = item / nblk, nb = item % nblk, k0 = 64 * kb, n0 = 32 * nb;
#pragma unroll
    for (int i = 0; i < 32; ++i) { const int kk = 2 * i + (lane >> 5); const float wv = W[(size_t)(k0 + kk) * N + n0 + (lane & 31)]; scr[kk * 33 + (lane & 31)] = kscale ? wv * kscale[k0 + kk] : wv; }
    LDS_WAIT(); asm volatile("" ::: "memory");
    const int c = lane & 7;
#pragma unroll
    for (int j = 0; j < 4; ++j) { const int n = (lane >> 3) + 8 * j; const LAS float* s = scr + (8 * c) * 33 + n;
        v4u o; o.x = pk2(s[0 * 33], s[1 * 33]); o.y = pk2(s[2 * 33], s[3 * 33]); o.z = pk2(s[4 * 33], s[5 * 33]); o.w = pk2(s[6 * 33], s[7 * 33]);
        *(v4u*)(WT + (size_t)(row_add + n0 + n) * K + k0 + 8 * c) = o; }
    LDS_WAIT(); asm volatile("" ::: "memory");
}
__device__ __forceinline__ void rms_row_to_bf16(const float* xrow, const float* g, bf16* orow, int lane) {
    const f32x4* xr = (const f32x4*)xrow + lane; const f32x4* gr = (const f32x4*)g + lane;
    f32x4 v[16]; float s = 0.f;
#pragma unroll
    for (int j = 0; j < 16; ++j) { v[j] = xr[64 * j]; s += (v[j].x * v[j].x + v[j].y * v[j].y) + (v[j].z * v[j].z + v[j].w * v[j].w); }
    const float rs = 1.0f / sqrtf(wave_sum(s) * (1.f / D_) + 1e-6f);
    v2u* o8 = (v2u*)orow + lane;
#pragma unroll
    for (int j = 0; j < 16; ++j) { const f32x4 gg = gr[64 * j]; v2u w; w.x = pk2(v[j].x * rs * gg.x, v[j].y * rs * gg.y); w.y = pk2(v[j].z * rs * gg.z, v[j].w * rs * gg.w); o8[64 * j] = w; }
}
__device__ __forceinline__ unsigned pk4_fp8(float a, float b, float c, float d) { int w = 0; w = __builtin_amdgcn_cvt_pk_fp8_f32(a, b, w, false); w = __builtin_amdgcn_cvt_pk_fp8_f32(c, d, w, true); return (unsigned)w; }
__device__ __forceinline__ void rms_row_to_fp8(const float* xrow, const float* g, unsigned char* orow, int lane) {
    const f32x4* xr = (const f32x4*)xrow + lane; const f32x4* gr = (const f32x4*)g + lane;
    f32x4 v[16]; float s = 0.f;
#pragma unroll
    for (int j = 0; j < 16; ++j) { v[j] = xr[64 * j]; s += (v[j].x * v[j].x + v[j].y * v[j].y) + (v[j].z * v[j].z + v[j].w * v[j].w); }
    const float rs = 16.0f / sqrtf(wave_sum(s) * (1.f / D_) + 1e-6f);
    unsigned* o4 = (unsigned*)orow + lane;
#pragma unroll
    for (int j = 0; j < 16; ++j) { const f32x4 gg = gr[64 * j]; o4[64 * j] = pk4_fp8(v[j].x * rs * gg.x, v[j].y * rs * gg.y, v[j].z * rs * gg.z, v[j].w * rs * gg.w); }
}
__device__ __forceinline__ void rms_row_to_both(const float* xrow, const float* g, bf16* orow, unsigned char* orow8, int lane) {
    const f32x4* xr = (const f32x4*)xrow + lane; const f32x4* gr = (const f32x4*)g + lane;
    f32x4 v[16]; float s = 0.f;
#pragma unroll
    for (int j = 0; j < 16; ++j) { v[j] = xr[64 * j]; s += (v[j].x * v[j].x + v[j].y * v[j].y) + (v[j].z * v[j].z + v[j].w * v[j].w); }
    const float rs = 1.0f / sqrtf(wave_sum(s) * (1.f / D_) + 1e-6f);
    unsigned* o4 = (unsigned*)orow8 + lane; (void)orow;
#pragma unroll
    for (int j = 0; j < 16; ++j) { const f32x4 y = v[j] * rs * gr[64 * j]; o4[64 * j] = pk4_fp8(y.x * 16.f, y.y * 16.f, y.z * 16.f, y.w * 16.f); }
}
__device__ __forceinline__ void p0_transpose_item_fp8(const float* W, int K, int N, unsigned char* WT, int row_add, LAS float* scr, int item, int lane) {
    const int nblk = N / 32, kb = item / nblk, nb = item % nblk, k0 = 64 * kb, n0 = 32 * nb;
#pragma unroll
    for (int i = 0; i < 32; ++i) { const int kk = 2 * i + (lane >> 5); scr[kk * 33 + (lane & 31)] = W[(size_t)(k0 + kk) * N + n0 + (lane & 31)]; }
    LDS_WAIT(); asm volatile("" ::: "memory");
    const int c = lane & 3;
#pragma unroll
    for (int j = 0; j < 2; ++j) { const int n = (lane >> 2) + 16 * j; const LAS float* s = scr + (16 * c) * 33 + n; v4u o;
        o.x = pk4_fp8(s[0 * 33] * 256.f, s[1 * 33] * 256.f, s[2 * 33] * 256.f, s[3 * 33] * 256.f); o.y = pk4_fp8(s[4 * 33] * 256.f, s[5 * 33] * 256.f, s[6 * 33] * 256.f, s[7 * 33] * 256.f);
        o.z = pk4_fp8(s[8 * 33] * 256.f, s[9 * 33] * 256.f, s[10 * 33] * 256.f, s[11 * 33] * 256.f); o.w = pk4_fp8(s[12 * 33] * 256.f, s[13 * 33] * 256.f, s[14 * 33] * 256.f, s[15 * 33] * 256.f);
        *(v4u*)(WT + (size_t)(row_add + n0 + n) * K + k0 + 16 * c) = o; }
    LDS_WAIT(); asm volatile("" ::: "memory");
}
__device__ __forceinline__ void cvt_straight(const float* src, bf16* dst, size_t n, size_t gt, size_t ngt) {
    for (size_t i = gt; i < n / 8; i += ngt) { const f32x4 a = ((const f32x4*)src)[2 * i], b = ((const f32x4*)src)[2 * i + 1];
        v4u o; o.x = pk2(a.x, a.y); o.y = pk2(a.z, a.w); o.z = pk2(b.x, b.y); o.w = pk2(b.z, b.w); ((v4u*)dst)[i] = o; }
}

__device__ __forceinline__ void quant_rows(const float* src, unsigned char* dst, float* scales, int nrows, int gw, int ngw, int lane) {
    for (int r = gw; r < nrows; r += ngw) {
        const f32x4* s4 = (const f32x4*)(src + (size_t)r * D_) + lane; f32x4 v[16]; float m = 0.f;
#pragma unroll
        for (int j = 0; j < 16; ++j) { v[j] = s4[64 * j]; m = fmaxf(fmaxf(m, fmaxf(fabsf(v[j].x), fabsf(v[j].y))), fmaxf(fabsf(v[j].z), fabsf(v[j].w))); }
        m = wave_max(m); const float inv = m > 0.f ? 127.0f / m : 0.f;
        unsigned* d4 = (unsigned*)(dst + (size_t)r * D_) + lane;
#pragma unroll
        for (int j = 0; j < 16; ++j) { const unsigned q0 = (unsigned)((int)rintf(v[j].x * inv) + 128), q1 = (unsigned)((int)rintf(v[j].y * inv) + 128), q2 = (unsigned)((int)rintf(v[j].z * inv) + 128), q3 = (unsigned)((int)rintf(v[j].w * inv) + 128);
            d4[64 * j] = q0 | (q1 << 8) | (q2 << 16) | (q3 << 24); }
        if (lane == 0) scales[r] = m * (1.0f / 127.0f);
    }
}
__device__ __forceinline__ unsigned fp6_code(float y) {
    const float a = fminf(fabsf(y), 7.5f);
    const int m = a < 2.0f ? (int)rintf(a * 8.0f) : (a < 4.0f ? 16 + (int)rintf((a - 2.0f) * 4.0f) : 24 + (int)rintf((a - 4.0f) * 2.0f));
    return (unsigned)m | (y < 0.f ? 32u : 0u);
}
__device__ __forceinline__ void quant_rows_fp6(const float* src, unsigned char* dst, float* scales, int nrows, int gw, int ngw, int lane) {
    for (int r = gw; r < nrows; r += ngw) {
        const f32x4* s4 = (const f32x4*)(src + (size_t)r * D_) + lane; f32x4 v[16]; float m = 0.f;
#pragma unroll
        for (int j = 0; j < 16; ++j) { v[j] = s4[64 * j]; m = fmaxf(fmaxf(m, fmaxf(fabsf(v[j].x), fabsf(v[j].y))), fmaxf(fabsf(v[j].z), fabsf(v[j].w))); }
        m = wave_max(m); const float inv = m > 0.f ? 7.5f / m : 0.f;
        const int k = lane & 3;
        unsigned* d4 = (unsigned*)(dst + (size_t)r * 3072) + ((lane >> 4) * 12 + ((lane & 15) >> 2) * 3 + k);
#pragma unroll
        for (int j = 0; j < 16; ++j) {
            const unsigned P = fp6_code(v[j].x * inv) | (fp6_code(v[j].y * inv) << 6) | (fp6_code(v[j].z * inv) << 12) | (fp6_code(v[j].w * inv) << 18);
            const unsigned P0 = (unsigned)__builtin_amdgcn_update_dpp(0, (int)P, 0x00, 0xF, 0xF, false), P1 = (unsigned)__builtin_amdgcn_update_dpp(0, (int)P, 0x55, 0xF, 0xF, false);
            const unsigned P2 = (unsigned)__builtin_amdgcn_update_dpp(0, (int)P, 0xAA, 0xF, 0xF, false), P3 = (unsigned)__builtin_amdgcn_update_dpp(0, (int)P, 0xFF, 0xF, 0xF, false);
            const unsigned d0 = P0 | (P1 << 24), d1 = (P1 >> 8) | (P2 << 16), d2 = (P2 >> 16) | (P3 << 8);
            if (k < 3) d4[48 * j] = k == 0 ? d0 : (k == 1 ? d1 : d2);
        }
        if (lane == 0) scales[r] = m * (1.0f / 7.5f);
    }
}
__device__ __forceinline__ void quant_rows4(const float* src, const float* cscale, unsigned char* dst, bf16* bscale, int nrows, int gw, int ngw, int lane) {
    for (int r = gw; r < nrows; r += ngw) {
        const f32x4* s4 = (const f32x4*)(src + (size_t)r * D_) + lane;
        unsigned* d4 = (unsigned*)(dst + (size_t)r * 128) + (lane >> 1);
        f32x4 vv[16];
#pragma unroll
        for (int j = 0; j < 16; ++j) vv[j] = s4[64 * j] * ((const f32x4*)cscale)[lane + 64 * j];
#pragma unroll
        for (int j = 0; j < 16; ++j) {
            const f32x4 v = vv[j];
            float m = fmaxf(fmaxf(fabsf(v.x), fabsf(v.y)), fmaxf(fabsf(v.z), fabsf(v.w)));
            m = fmaxf(m, __builtin_bit_cast(float, __builtin_amdgcn_update_dpp(0, __builtin_bit_cast(int, m), 0xB1, 0xF, 0xF, false)));
            m = fmaxf(m, __builtin_bit_cast(float, __builtin_amdgcn_update_dpp(0, __builtin_bit_cast(int, m), 0x4E, 0xF, 0xF, false)));
            m = fmaxf(m, __builtin_bit_cast(float, __builtin_amdgcn_update_dpp(0, __builtin_bit_cast(int, m), 0x141, 0xF, 0xF, false)));
            const unsigned sb = f2bf(m * (1.0f / 7.0f)); const float s = __uint_as_float(sb << 16); const float inv = s > 0.f ? 1.0f / s : 0.f;
            const int q0 = min(max((int)rintf(v.x * inv), -7), 7), q1 = min(max((int)rintf(v.y * inv), -7), 7), q2 = min(max((int)rintf(v.z * inv), -7), 7), q3 = min(max((int)rintf(v.w * inv), -7), 7);
            const unsigned P = (unsigned)(q0 + 8) | ((unsigned)(q1 + 8) << 8) | ((unsigned)(q2 + 8) << 16) | ((unsigned)(q3 + 8) << 24);
            const unsigned Q = (unsigned)__builtin_amdgcn_update_dpp(0, (int)P, 0xB1, 0xF, 0xF, false);
            if ((lane & 1) == 0) d4[(size_t)j * (16384 * 32)] = P | (Q << 4);
            if ((lane & 7) == 0) bscale[((size_t)j * 16384 + r) * 8 + (lane >> 3)] = (bf16)sb;
        }
    }
}
__device__ __forceinline__ void p0_prologue(Frame& F) {
    LAS float* scr = (LAS float*)(F.lds + F.wave * 16384);
    const float* w_in = F.in[2];
    constexpr int I_IN = (D_ / 64) * (IN_COLS / 32);
    for (int it = F.gw; it < I_IN; it += F.NGW) { const int n0 = (it % (IN_COLS / 32)) * 32;
        p0_transpose_item_fp8(w_in, D_, IN_COLS, F.ws + WS_WINT8, (n0 >= RWKV_COLS ? 128 : 0), scr, it, F.lane); }
    const size_t gt = (size_t)blockIdx.x * 512 + F.tid, ngt = (size_t)F.G * 512;
    { v4u* p = (v4u*)(F.ws + WS_WINT8 + (size_t)RWKV_COLS * D_); const v4u z = {0u, 0u, 0u, 0u}; for (size_t i = gt; i < (size_t)128 * D_ / 16; i += ngt) p[i] = z; }
    { bf16* LB = (bf16*)(F.ws + WS_LORABT); const float* w2 = F.in[5]; const float* a2 = F.in[7]; const float* g2 = F.in[8];
      for (size_t i = gt; i < (size_t)LORA_N * LORA_K; i += ngt) { const int row = (int)(i / LORA_K), col = (int)(i % LORA_K); const int seg = row >> 11, n = row & 2047; float v = 0.f;
          if (seg == 0 && col < 64) v = w2[(size_t)col * RW + n]; else if (seg == 1 && col >= 64 && col < 128) v = a2[(size_t)(col - 64) * RW + n]; else if (seg == 2 && col >= 128) v = g2[(size_t)(col - 128) * RW + n];
          LB[i] = (bf16)f2bf(v); } }
    for (int m = F.gw; m < S_; m += F.NGW) rms_row_to_both(F.in[0] + (size_t)m * D_, F.in[1], (bf16*)(F.ws + WS_XN) + (size_t)m * D_, F.ws + WS_XN8 + (size_t)m * D_, F.lane);
}

__device__ __forceinline__ void late_prep(Frame& F, int mgw, int mngw) {
    LAS float* scr = (LAS float*)(F.lds + F.wave * 16384);
    constexpr int I_PA = (RW / 64) * (D_ / 32), I_OUT = (D_ / 64) * (D_ / 32), I_Q = (D_ / 64) * (2048 / 32);
    for (int it = mgw; it < 2 * I_PA + I_OUT + I_Q; it += mngw) {
        int r = it;
        if (r < I_PA) { p0_transpose_item(F.in[14], RW, D_, (bf16*)(F.ws + WS_WPA), 0, scr, r, F.lane); continue; } r -= I_PA;
        if (r < I_PA) { p0_transpose_item_fp8(F.in[15], RW, D_, F.ws + WS_WPB, 0, scr, r, F.lane); continue; } r -= I_PA;
        if (r < I_OUT) { p0_transpose_item(F.in[16], D_, D_, (bf16*)(F.ws + WS_WOUT), 0, scr, r, F.lane); continue; } r -= I_OUT;
        p0_transpose_item(F.in[18], D_, 2048, (bf16*)(F.ws + WS_WQ), 0, scr, r, F.lane, F.in[17]);
    }
    quant_rows4(F.in[20], F.in[17], F.ws + WS_U8, (bf16*)(F.ws + WS_USC), PE, mgw, mngw, F.lane);
    quant_rows_fp6(F.in[21], F.ws + WS_V8, (float*)(F.ws + WS_VSC), PE, mgw, mngw, F.lane);
    cvt_straight(F.in[19], (bf16*)(F.ws + WS_SUBK), (size_t)16 * 128 * 128, (size_t)mgw * 64 + F.lane, (size_t)mngw * 64);
}

__device__ __forceinline__ void p2_prep(Frame& F) {
    const size_t gt = (size_t)blockIdx.x * 512 + F.tid, ngt = (size_t)F.G * 512;
    const bf16* ZR = (const bf16*)(F.ws + WS_ZR); const float* mu = F.in[3]; bf16* LA = (bf16*)(F.ws + WS_LORAA);
    for (size_t i = gt; i < (size_t)S_ * LORA_K; i += ngt) { const int t = (int)(i / LORA_K), c = (int)(i % LORA_K);
        const float zc = bf1(ZR[(size_t)t * ZR_LD + 6144 + c]), zp = t > 0 ? bf1(ZR[(size_t)(t - 1) * ZR_LD + 6144 + c]) : 0.f;
        const float zs = zc + (zp - zc) * mu[6144 + c];
        const float v = c < 64 ? tanhf(zs) : (c < 128 ? zs : sigmoidf_(zs));
        LA[i] = (bf16)f2bf(v); }
    const bf16* ZM = (const bf16*)(F.ws + WS_ZM); bf16* KMH = (bf16*)(F.ws + WS_KMEAN); bf16* KML = (bf16*)(F.ws + WS_KMEAN + 262144);
    LAS float* red = (LAS float*)F.lds;
    for (int item = blockIdx.x; item < MNB * 8; item += F.G) {
        const int j = item >> 3, cg = item & 7, col = cg * 256 + 4 * F.lane; f32x4 s = {0.f, 0.f, 0.f, 0.f};
        const bf16* zp = ZM + (size_t)(j * MBS + F.wave * 32) * ZM_LD + 2048 + col;
#pragma unroll 8
        for (int r = 0; r < 32; ++r) s += bf4(*(const v2u*)(zp + (size_t)r * ZM_LD));
        *(LAS f32x4*)(red + F.wave * 256 + 4 * F.lane) = s;
        __syncthreads();
        if (F.tid < 256) { float a = 0.f;
#pragma unroll
            for (int w = 0; w < 8; ++w) a += red[w * 256 + F.tid];
            a *= (1.0f / MBS); const int cc = cg * 256 + F.tid; const size_t o = ((size_t)(cc >> 7) * MNB + j) * MD + (cc & 127);
            const unsigned hi = f2bf(a); KMH[o] = (bf16)hi; KML[o] = (bf16)f2bf(a - __uint_as_float(hi << 16)); }
        __syncthreads();
    }
}

__device__ __forceinline__ void p4_rwkv_prep(Frame& F) {
    const bf16* ZR = (const bf16*)(F.ws + WS_ZR); const float* mu = F.in[3];
    const float* WDEC = (const float*)(F.ws + WS_WDEC); const bf16* ICLR = (const bf16*)(F.ws + WS_ICLR);
    const float* k_k = F.in[9]; const float* k_a = F.in[10]; const float* r_k = F.in[11];
    unsigned char* SC = F.ws + WS_SCAN; float* BC = (float*)(F.ws + WS_BC);
#pragma unroll 4
    for (int item = F.gw; item < S_ * 8; item += F.NGW) {
        const int t = item >> 3, hq = item & 7, c = hq * 256 + 4 * F.lane, h = hq * 4 + (F.lane >> 4), q = F.lane & 15;
        const bf16* zc = ZR + (size_t)t * ZR_LD + c; const bf16* zp = zc - ZR_LD;
        const f32x4 rc = bf4(*(const v2u*)zc), kc = bf4(*(const v2u*)(zc + 2048)), vc = bf4(*(const v2u*)(zc + 4096));
        f32x4 rp = {0.f, 0.f, 0.f, 0.f}, kp = rp, vp = rp;
        if (t > 0) { rp = bf4(*(const v2u*)zp); kp = bf4(*(const v2u*)(zp + 2048)); vp = bf4(*(const v2u*)(zp + 4096)); }
        const f32x4 r = rc + (rp - rc) * *(const f32x4*)(mu + c), k = kc + (kp - kc) * *(const f32x4*)(mu + 2048 + c), v = vc + (vp - vc) * *(const f32x4*)(mu + 4096 + c);
        const f32x4 iclr = bf4(*(const v2u*)(ICLR + (size_t)t * RW + c)), w = *(const f32x4*)(WDEC + (size_t)t * RW + c);
        f32x4 kk = k * *(const f32x4*)(k_k + c);
        const float ss = dpp_add16((kk.x * kk.x + kk.y * kk.y) + (kk.z * kk.z + kk.w * kk.w)); kk = kk * (1.0f / sqrtf(ss + 1e-12f));
        const f32x4 km = k * (1.0f + (iclr - 1.0f) * *(const f32x4*)(k_a + c));
        const f32x4 rkr = r * km * *(const f32x4*)(r_k + c);
        const float bc = dpp_add16((rkr.x + rkr.y) + (rkr.z + rkr.w));
        unsigned char* rec = SC + ((size_t)h * S_ + t) * SCAN_REC;
        *(f32x4*)(rec + 16 * q) = w;
        const f32x4 a = -kk, b = kk * iclr;
        *(v2u*)(rec + 256 + 8 * q) = (v2u){pk2(r.x, r.y), pk2(r.z, r.w)};
        *(v2u*)(rec + 384 + 8 * q) = (v2u){pk2(km.x, km.y), pk2(km.z, km.w)};
        *(v2u*)(rec + 512 + 8 * q) = (v2u){pk2(v.x, v.y), pk2(v.z, v.w)};
        *(v2u*)(rec + 640 + 8 * q) = (v2u){pk2(a.x, a.y), pk2(a.z, a.w)};
        *(v2u*)(rec + 768 + 8 * q) = (v2u){pk2(b.x, b.y), pk2(b.z, b.w)};
        if (q == 0) BC[t * RH + h] = bc;
    }
}

constexpr int SC_T = 32;
#define SCAN_ISSUE(c_) do { const unsigned char* g_ = src + (size_t)(c_) * SC_T * SCAN_REC; _Pragma("unroll") for (int i = 0; i < 7; ++i) sx[i] = *(const v4u*)(g_ + (size_t)(pt + 256 * i) * 16); } while (0)
#define SCAN_COMMIT(c_) do { LAS float* dst_ = inb + ((c_) & 1) * (SC_T * 384); \
    _Pragma("unroll") for (int i = 0; i < 7; ++i) { const int p_ = pt + 256 * i, s_ = p_ / 56, pi_ = p_ % 56; LAS float* d_ = dst_ + s_ * 384; \
        if (pi_ < 16) *(LAS v4u*)(d_ + pi_ * 4) = sx[i]; \
        else { LAS float* dd_ = d_ + 64 + (pi_ - 16) * 8; \
            *(LAS f32x4*)dd_ = (f32x4){bflo(sx[i].x), bfhi(sx[i].x), bflo(sx[i].y), bfhi(sx[i].y)}; *(LAS f32x4*)(dd_ + 4) = (f32x4){bflo(sx[i].z), bfhi(sx[i].z), bflo(sx[i].w), bfhi(sx[i].w)}; } } } while (0)
__device__ __forceinline__ void scan_flush_y(const LAS float* yb, float* Y, int c, int pt, int colbase) {
    const LAS float* s = yb + (c & 1) * (SC_T * 16);
#pragma unroll
    for (int i = 0; i < 2; ++i) { const int idx = pt + 256 * i, st = idx >> 4, rr = idx & 15; Y[(size_t)(c * SC_T + st) * RW + colbase + rr] = s[idx]; }
}
__device__ __forceinline__ void p5_scan_block(Frame& F, int sb) {
    const int h = sb >> 2, rg = sb & 3;
    LAS float* inb = (LAS float*)F.lds;
    LAS float* yb = (LAS float*)(F.lds + 98304);
    const unsigned char* src = F.ws + WS_SCAN + (size_t)h * S_ * SCAN_REC;
    float* Y = (float*)(F.ws + WS_Y);
    const int pt = F.tid - 256, colbase = h * 64 + rg * 16;
    constexpr int NCH = S_ / SC_T;
    v4u sx[7];
    if (F.wave >= 4) { SCAN_ISSUE(0); SCAN_COMMIT(0); SCAN_ISSUE(1); }
    __syncthreads();
    const int q = F.lane & 15, rloc = 4 * F.wave + (F.lane >> 4);
    const bool b0 = (q & 1) != 0, b1 = (q & 2) != 0, b2 = (q & 4) != 0, b3 = (q & 8) != 0;
    const int qidx = (b0 ? 8 : 0) | (b1 ? 4 : 0) | (b2 ? 2 : 0) | (b3 ? 1 : 0);
    f32x2 Sa = {0.f, 0.f}, Sb = {0.f, 0.f};
    for (int c = 0; c < NCH; ++c) {
        if (F.wave < 4) {
            const LAS float* p = inb + (c & 1) * (SC_T * 384) + 4 * q; LAS float* yo = yb + (c & 1) * (SC_T * 16) + rloc;
            const LAS float* pv = inb + (c & 1) * (SC_T * 384) + 192 + rg * 16 + rloc;
            f32x4 w4 = *(const LAS f32x4*)(p), r4 = *(const LAS f32x4*)(p + 64), k4 = *(const LAS f32x4*)(p + 128), a4 = *(const LAS f32x4*)(p + 256), b4 = *(const LAS f32x4*)(p + 320); float vv = pv[0];
            float yp[16];
#pragma unroll
            for (int s = 0; s < SC_T; ++s) {
                f32x4 nw = w4, nr = r4, nk = k4, na = a4, nb = b4; float nv = vv;
                if (s + 1 < SC_T) { nw = *(const LAS f32x4*)(p + (s + 1) * 384); nr = *(const LAS f32x4*)(p + (s + 1) * 384 + 64); nk = *(const LAS f32x4*)(p + (s + 1) * 384 + 128);
                    na = *(const LAS f32x4*)(p + (s + 1) * 384 + 256); nb = *(const LAS f32x4*)(p + (s + 1) * 384 + 320); nv = pv[(s + 1) * 384]; }
                const f32x2 pa = Sa * a4.lo + Sb * a4.hi;
                float sa = pa.x + pa.y;
                const f32x2 ta = Sa * w4.lo + k4.lo * vv, tb = Sb * w4.hi + k4.hi * vv;
                sa = dpp_add16(sa);
                Sa = ta + b4.lo * sa; Sb = tb + b4.hi * sa;
                const f32x2 py = Sa * r4.lo + Sb * r4.hi;
                yp[s & 15] = py.x + py.y;
                if ((s & 15) == 15) {
#define SCAN_RS(N_, SEL_, CTRL_) _Pragma("unroll") for (int i = 0; i < (N_); ++i) { const float keep = (SEL_) ? yp[2 * i + 1] : yp[2 * i], send = (SEL_) ? yp[2 * i] : yp[2 * i + 1]; \
                        yp[i] = keep + __builtin_bit_cast(float, __builtin_amdgcn_update_dpp(0, __builtin_bit_cast(int, send), (CTRL_), 0xF, 0xF, false)); }
                    SCAN_RS(8, b3, 0x128) SCAN_RS(4, b2, 0x141) SCAN_RS(2, b1, 0x1B) SCAN_RS(1, b0, 0xB1)
#undef SCAN_RS
                    yo[((s & 16) + qidx) * 16] = yp[0];
                }
                w4 = nw; r4 = nr; k4 = nk; a4 = na; b4 = nb; vv = nv;
            }
        } else {
            if (c + 1 < NCH) SCAN_COMMIT(c + 1);
            if (c + 2 < NCH) SCAN_ISSUE(c + 2);
            if (c > 0) scan_flush_y(yb, Y, c - 1, pt, colbase);
        }
        __syncthreads();
    }
    if (F.wave >= 4) scan_flush_y(yb, Y, NCH - 1, pt, colbase);
}

__device__ __forceinline__ int moba_list_off(int j) { return 8192 * j - 128 * j * (j + 1); }
constexpr int MLIST_HEAD = 126976;
__device__ __forceinline__ int dpp_min16i(int v) {
    v = min(v, __builtin_amdgcn_update_dpp(0, v, 0xB1, 0xF, 0xF, false));
    v = min(v, __builtin_amdgcn_update_dpp(0, v, 0x4E, 0xF, 0xF, false));
    v = min(v, __builtin_amdgcn_update_dpp(0, v, 0x141, 0xF, 0xF, false));
    v = min(v, __builtin_amdgcn_update_dpp(0, v, 0x140, 0xF, 0xF, false));
    return v;
}
typedef short gbf16x8 __attribute__((ext_vector_type(8)));
__device__ __forceinline__ void p4_moba_gate(Frame& F) {
    const bf16* ZM = (const bf16*)(F.ws + WS_ZM); const bf16* KMH = (const bf16*)(F.ws + WS_KMEAN); const bf16* KML = (const bf16*)(F.ws + WS_KMEAN + 262144);
    unsigned* CNT = (unsigned*)(F.ws + WS_CTL) + CW_MCNT; int* LIST = (int*)(F.ws + WS_MLIST);
    const int g = F.lane >> 4, l15 = F.lane & 15;
    for (int item = F.gw + 16 * MH; item < (S_ / 16) * MH; item += F.NGW) {
        const int tile = item >> 4, h = item & 15, t0 = tile * 16, blk = t0 >> 8;
        f32x4 acc[2] = {{0.f, 0.f, 0.f, 0.f}, {0.f, 0.f, 0.f, 0.f}};
#pragma unroll
        for (int ks = 0; ks < 4; ++ks) { const gbf16x8 a = *(const gbf16x8*)(ZM + (size_t)(t0 + l15) * ZM_LD + h * MD + 32 * ks + 8 * g);
#pragma unroll
            for (int nt = 0; nt < 2; ++nt) { const size_t o = ((size_t)h * MNB + l15 + 16 * nt) * MD + 32 * ks + 8 * g;
                acc[nt] = __builtin_amdgcn_mfma_f32_16x16x32_bf16(a, *(const gbf16x8*)(KMH + o), acc[nt], 0, 0, 0);
                acc[nt] = __builtin_amdgcn_mfma_f32_16x16x32_bf16(a, *(const gbf16x8*)(KML + o), acc[nt], 0, 0, 0); } }
#pragma unroll
        for (int r4 = 0; r4 < 4; ++r4) {
            float s0 = l15 < blk ? acc[0][r4] : -INFINITY, s1 = l15 + 16 < blk ? acc[1][r4] : -INFINITY;
            const int t = t0 + 4 * g + r4;
#pragma unroll
            for (int r = 0; r < 3; ++r) { const float m = dpp_max16(fmaxf(s0, s1));
                const int jm = (s0 == m) ? l15 : ((s1 == m) ? l15 + 16 : 99); const int jw = dpp_min16i(jm);
                if (m > -INFINITY && jm == jw) { const unsigned pos = atomicAdd(&CNT[(h * 32 + jw) * 16], 1u); LIST[(size_t)h * MLIST_HEAD + moba_list_off(jw) + pos] = t * 4 + r;
                    if (jw < 16) s0 = -INFINITY; else s1 = -INFINITY; } }
        }
    }
}
__device__ __forceinline__ int moba_off(int row, int ch) { return 256 * row + 16 * (ch ^ (((row & 3) << 2) | ((row >> 2) & 3))); }
typedef short bf16x8 __attribute__((ext_vector_type(8)));
typedef short s16x4 __attribute__((ext_vector_type(4)));
__device__ __forceinline__ void p5_moba_units(Frame& F, int mb, int nmb) {
    const bf16* ZM = (const bf16*)(F.ws + WS_ZM);
    const unsigned* CNT = (const unsigned*)(F.ws + WS_CTL) + CW_MCNT; const int* LIST = (const int*)(F.ws + WS_MLIST);
    bf16* PO = (bf16*)(F.ws + WS_PARTO); float* PML = (float*)(F.ws + WS_PARTML);
    LAS unsigned char* kv = F.lds;
    LAS unsigned char* pw = F.lds + 65536 + F.wave * 8448;
    LAS int* pref = (LAS int*)(F.lds + 133120);
    LAS int* nchs = pref + 520;
    if (F.tid < 512) nchs[F.tid] = (int)((CNT[F.tid * 16] + 127u) >> 7);
    __syncthreads();
    if (F.tid < 512) { int s = 0; for (int i = 0; i < F.tid; ++i) s += nchs[i]; pref[F.tid] = s; if (F.tid == 511) pref[512] = s + nchs[511]; }
    __syncthreads();
    const int U = 1024 + pref[512];
    const int g = F.lane >> 4, l15 = F.lane & 15;
    const float scale = 0.08838834764831845f;
#define MOBA_DECODE(u_, h_, j_, qb_, cnt_, own_, lst_) do { \
        if ((u_) < 1024) { own_ = 1; h_ = (u_) >> 6; j_ = ((u_) >> 1) & 31; qb_ = ((u_) & 1) * 128; cnt_ = 256; lst_ = LIST; } \
        else { own_ = 0; const int v_ = (u_) - 1024; int lo_ = 0, hi_ = 512; \
            while (hi_ - lo_ > 1) { const int mid_ = (lo_ + hi_) >> 1; if (pref[mid_] <= v_) lo_ = mid_; else hi_ = mid_; } \
            lo_ = __builtin_amdgcn_readfirstlane(lo_); h_ = lo_ >> 5; j_ = lo_ & 31; qb_ = __builtin_amdgcn_readfirstlane((v_ - pref[lo_]) * 128); cnt_ = __builtin_amdgcn_readfirstlane((int)CNT[lo_ * 16]); \
            lst_ = LIST + (size_t)h_ * MLIST_HEAD + moba_list_off(j_); } } while (0)
#define MOBA_LOADQ() do { const int q0_ = qb + F.wave * 16; \
        if (own) entA = ((j * 256 + q0_ + l15) << 2) | 3; else entA = (q0_ + l15 < cnt) ? lst[q0_ + l15] : -1; \
        const int tokA_ = entA >= 0 ? (entA >> 2) : 0; \
        _Pragma("unroll") for (int ks = 0; ks < 4; ++ks) qa[ks] = *(const v4u*)(ZM + (size_t)tokA_ * ZM_LD + h * MD + 32 * ks + 8 * g); \
        _Pragma("unroll") for (int i = 0; i < 8; ++i) { const int idx = F.tid + 512 * i; kx[i] = *(const v4u*)(ZM + (size_t)(j * 256 + (idx >> 4)) * ZM_LD + 2048 + h * MD + (idx & 15) * 8); } } while (0)
    int h = 0, j = 0, qb = 0, cnt = 0, own = 0; const int* lst = LIST; int entA = -1; v4u qa[4], kx[8];
    int stg, krd[4], vrd[2][8];
    { const int r0 = F.tid >> 4, chs = F.tid & 15; stg = 256 * r0 + 16 * (chs ^ (((r0 & 3) << 2) | ((r0 >> 2) & 3)));
      const int fk = ((l15 & 3) << 2) | ((l15 >> 2) & 3);
#pragma unroll
      for (int ks = 0; ks < 4; ++ks) krd[ks] = 256 * l15 + 16 * ((4 * ks + g) ^ fk);
      const int tq = l15 >> 2, tp = l15 & 3;
#pragma unroll
      for (int t = 0; t < 2; ++t) { const int fr = (tq << 2) | ((2 * g + t) & 3);
#pragma unroll
          for (int cc = 0; cc < 8; ++cc) vrd[t][cc] = 256 * (8 * g + 4 * t + tq) + 16 * ((2 * cc + (tp >> 1)) ^ fr) + 8 * (tp & 1); } }
    if (mb < U) { MOBA_DECODE(mb, h, j, qb, cnt, own, lst); MOBA_LOADQ(); }
    for (int u = mb; u < U; u += nmb) {
        const int ch = h, cj = j, cown = own; const bool active = qb + F.wave * 16 < cnt;
#pragma unroll
        for (int i = 0; i < 8; ++i) *(LAS v4u*)(kv + stg + 8192 * i) = kx[i];
        __syncthreads();
        v4u vst[8];
#pragma unroll
        for (int i = 0; i < 8; ++i) { const int idx = F.tid + 512 * i; vst[i] = *(const v4u*)(ZM + (size_t)(cj * 256 + (idx >> 4)) * ZM_LD + 4096 + ch * MD + (idx & 15) * 8); }
        float mrow[4], lrow[4]; int entR[4];
#pragma unroll
        for (int r = 0; r < 4; ++r) entR[r] = __shfl(entA, 4 * g + r);
        if (active) {
            f32x4 sacc[16];
#pragma unroll
            for (int nt = 0; nt < 16; ++nt) { sacc[nt] = (f32x4){0.f, 0.f, 0.f, 0.f};
#pragma unroll
                for (int ks = 0; ks < 4; ++ks) { const bf16x8 b = *(const LAS bf16x8*)(kv + krd[ks] + 4096 * nt);
                    sacc[nt] = __builtin_amdgcn_mfma_f32_16x16x32_bf16(__builtin_bit_cast(bf16x8, qa[ks]), b, sacc[nt], 0, 0, 0); } }
#pragma unroll
            for (int r = 0; r < 4; ++r) { const int tokr = entR[r] >> 2; float mx = -INFINITY;
#pragma unroll
                for (int nt = 0; nt < 16; ++nt) { float s = sacc[nt][r] * scale; if (cown && (cj * 256 + 16 * nt + l15) > tokr) s = -INFINITY; sacc[nt][r] = s; mx = fmaxf(mx, s); }
                mx = dpp_max16(mx); mrow[r] = mx; float sum = 0.f;
#pragma unroll
                for (int nt = 0; nt < 16; ++nt) { const float p = __expf(sacc[nt][r] - mx); sum += p; *(LAS bf16*)(pw + (4 * g + r) * 528 + (16 * nt + l15) * 2) = (bf16)f2bf(p); }
                lrow[r] = dpp_add16(sum); }
        }
        __syncthreads();
#pragma unroll
        for (int i = 0; i < 8; ++i) *(LAS v4u*)(kv + stg + 8192 * i) = vst[i];
        if (u + nmb < U) { MOBA_DECODE(u + nmb, h, j, qb, cnt, own, lst); MOBA_LOADQ(); }
        __syncthreads();
        if (active) {
            f32x4 oacc[8];
#pragma unroll
            for (int c = 0; c < 8; ++c) oacc[c] = (f32x4){0.f, 0.f, 0.f, 0.f};
#pragma unroll
            for (int ks = 0; ks < 8; ++ks) { const bf16x8 a = *(const LAS bf16x8*)(pw + l15 * 528 + (32 * ks + 8 * g) * 2);
#pragma unroll
                for (int c = 0; c < 8; ++c) {
                    const s16x4 t0 = __builtin_amdgcn_ds_read_tr16_b64_v4i16((LAS s16x4*)(kv + vrd[0][c] + 8192 * ks));
                    const s16x4 t1 = __builtin_amdgcn_ds_read_tr16_b64_v4i16((LAS s16x4*)(kv + vrd[1][c] + 8192 * ks));
                    const bf16x8 b = {t0.x, t0.y, t0.z, t0.w, t1.x, t1.y, t1.z, t1.w};
                    oacc[c] = __builtin_amdgcn_mfma_f32_16x16x32_bf16(a, b, oacc[c], 0, 0, 0); } }
#pragma unroll
            for (int r = 0; r < 4; ++r) if (entR[r] >= 0) { const int tok = entR[r] >> 2, slot = entR[r] & 3; const size_t base = ((size_t)(tok * MH + ch) * 4 + slot); const float inv = 1.0f / lrow[r];
#pragma unroll
                for (int c = 0; c < 8; ++c) PO[base * MD + 16 * c + l15] = (bf16)f2bf(oacc[c][r] * inv);
                if (l15 == 0) { PML[base * 2] = mrow[r]; PML[base * 2 + 1] = lrow[r]; } }
        }
        __syncthreads();
    }
#undef MOBA_DECODE
#undef MOBA_LOADQ
}
__device__ __forceinline__ void p6_moba_combine(Frame& F) {
    const bf16* PO = (const bf16*)(F.ws + WS_PARTO); const float* PML = (const float*)(F.ws + WS_PARTML); bf16* YB = (bf16*)(F.ws + WS_YB);
    for (int t = F.gw; t < S_; t += F.NGW) {
        const int h = F.lane >> 2, dq = F.lane & 3, blk = t >> 8, nsel = blk < 3 ? blk : 3; const size_t base = (size_t)(t * MH + h) * 4;
        const f32x4 ml0 = *(const f32x4*)(PML + base * 2), ml1 = *(const f32x4*)(PML + base * 2 + 4);
        v4u x[4][4];
#pragma unroll
        for (int s = 0; s < 4; ++s)
#pragma unroll
            for (int k = 0; k < 4; ++k) x[s][k] = *(const v4u*)(PO + (base + s) * MD + dq * 32 + k * 8);
        const float ms[4] = {ml0.x, ml0.z, ml1.x, ml1.z}, ls[4] = {ml0.y, ml0.w, ml1.y, ml1.w};
        float M = ms[3];
#pragma unroll
        for (int s = 0; s < 3; ++s) if (s < nsel) M = fmaxf(M, ms[s]);
        float wsum = 0.f, w[4];
#pragma unroll
        for (int s = 0; s < 4; ++s) { w[s] = (s == 3 || s < nsel) ? __expf(ms[s] - M) * ls[s] : 0.f; wsum += w[s]; }
        const float inv = 1.0f / wsum;
#pragma unroll
        for (int k = 0; k < 4; ++k) { float o[8] = {0.f, 0.f, 0.f, 0.f, 0.f, 0.f, 0.f, 0.f};
#pragma unroll
            for (int s = 0; s < 4; ++s) if (s == 3 || s < nsel) { const v4u v = x[s][k]; o[0] += w[s] * bflo(v.x); o[1] += w[s] * bfhi(v.x); o[2] += w[s] * bflo(v.y); o[3] += w[s] * bfhi(v.y); o[4] += w[s] * bflo(v.z); o[5] += w[s] * bfhi(v.z); o[6] += w[s] * bflo(v.w); o[7] += w[s] * bfhi(v.w); }
            const float i16 = inv * 16.0f; *(v2u*)((unsigned char*)YB + (size_t)t * RW + h * MD + dq * 32 + k * 8) = (v2u){pk4_fp8(o[0] * i16, o[1] * i16, o[2] * i16, o[3] * i16), pk4_fp8(o[4] * i16, o[5] * i16, o[6] * i16, o[7] * i16)}; }
    }
}

__device__ __forceinline__ void p6_rwkv_post(Frame& F) {
    const float* Y = (const float*)(F.ws + WS_Y); const bf16* GG = (const bf16*)(F.ws + WS_GG); const float* BC = (const float*)(F.ws + WS_BC);
    const unsigned char* SC = F.ws + WS_SCAN; bf16* YA = (bf16*)(F.ws + WS_YA);
    const float* gn_w = F.in[12]; const float* gn_b = F.in[13];
#pragma unroll 4
    for (int item = F.gw; item < S_ * 8; item += F.NGW) {
        const int t = item >> 3, hq = item & 7, c = hq * 256 + 4 * F.lane, h = hq * 4 + (F.lane >> 4), q = F.lane & 15;
        const f32x4 y = *(const f32x4*)(Y + (size_t)t * RW + c);
        const float mean = dpp_add16((y.x + y.y) + (y.z + y.w)) * (1.f / 64.f); const f32x4 d = y - mean;
        const float var = dpp_add16((d.x * d.x + d.y * d.y) + (d.z * d.z + d.w * d.w)) * (1.f / 64.f);
        const f32x4 yn = d * (1.0f / sqrtf(var + 64e-5f)) * *(const f32x4*)(gn_w + c) + *(const f32x4*)(gn_b + c);
        const f32x4 v = bf4(*(const v2u*)(SC + ((size_t)h * S_ + t) * SCAN_REC + 512 + 8 * q));
        const f32x4 o = (yn + BC[t * RH + h] * v) * bf4(*(const v2u*)(GG + (size_t)t * RW + c));
        *(v2u*)(YA + (size_t)t * RW + c) = (v2u){pk2(o.x, o.y), pk2(o.z, o.w)};
    }
}

__device__ __forceinline__ void p9_norm(Frame& F) {
    for (int m = F.gw; m < S_; m += F.NGW) rms_row_to_bf16((const float*)(F.ws + WS_H1R) + (size_t)m * D_, F.in[17], (bf16*)(F.ws + WS_HN) + (size_t)m * D_, F.lane);
}

__device__ __forceinline__ float uniq_key(float s, int n) { return __uint_as_float((__float_as_uint(s) & ~0xffu) | (unsigned)(255 - n)); }
#define INS16(A_, X_) do { float x_ = (X_); _Pragma("unroll") for (int i_ = 0; i_ < 16; ++i_) { const float hi_ = fmaxf(A_[i_], x_); x_ = fminf(A_[i_], x_); A_[i_] = hi_; } } while (0)
__device__ __forceinline__ void p11_route(Frame& F) {
    const bf16* QRY = (const bf16*)(F.ws + WS_QRY); const bf16* SK = (const bf16*)(F.ws + WS_SUBK);
    int* PIDX = (int*)(F.ws + WS_PIDX); float* PGT = (float*)(F.ws + WS_PG);
    LAS float* sc = (LAS float*)(F.lds + F.wave * 16640);
    LAS int* ptab = (LAS int*)(F.lds + 8 * 16640);
    if (F.tid < 50) { const int l = F.tid; const int ci = l < 16 ? 0 : l < 24 ? 1 : l < 29 ? 2 : l < 33 ? 3 : l < 36 ? 4 : l < 38 ? 5 : l < 40 ? 6 : l < 42 ? 7 : l - 34;
        const int cj = l < 16 ? l : l < 24 ? l - 16 : l < 29 ? l - 24 : l < 33 ? l - 29 : l < 36 ? l - 33 : l < 38 ? l - 36 : l < 40 ? l - 38 : l < 42 ? l - 40 : 0; ptab[l] = ci * 16 + cj; }
    __syncthreads();
    const int g = F.lane >> 4, l15 = F.lane & 15;
    for (int item = F.gw; item < (S_ / 16) * PH; item += F.NGW) {
        const int tile = item >> 3, h = item & 7, t0 = tile * 16;
#pragma unroll
        for (int c = 0; c < 2; ++c) {
            f32x4 acc[8];
#pragma unroll
            for (int nt = 0; nt < 8; ++nt) acc[nt] = (f32x4){0.f, 0.f, 0.f, 0.f};
#pragma unroll
            for (int ks = 0; ks < 4; ++ks) { const gbf16x8 a = *(const gbf16x8*)(QRY + (size_t)(t0 + l15) * 2048 + h * 256 + c * 128 + 32 * ks + 8 * g);
#pragma unroll
                for (int nt = 0; nt < 8; ++nt) acc[nt] = __builtin_amdgcn_mfma_f32_16x16x32_bf16(a, *(const gbf16x8*)(SK + ((size_t)(h * 2 + c) * PNK + 16 * nt + l15) * 128 + 32 * ks + 8 * g), acc[nt], 0, 0, 0); }
#pragma unroll
            for (int nt = 0; nt < 8; ++nt)
#pragma unroll
                for (int r = 0; r < 4; ++r) sc[(c * 16 + 4 * g + r) * 129 + 16 * nt + l15] = acc[nt][r];
        }
        if (F.lane < 32) {
            LAS float* row = sc + F.lane * 129; float a[16];
#pragma unroll
            for (int i = 0; i < 16; ++i) a[i] = -INFINITY;
#pragma unroll 4
            for (int n = 0; n < PNK; ++n) INS16(a, uniq_key(row[n], n));
            float tv[16]; int ti[16];
#pragma unroll
            for (int i = 0; i < 16; ++i) { ti[i] = 255 - (int)(__float_as_uint(a[i]) & 255u); tv[i] = row[ti[i]]; }
#pragma unroll
            for (int i = 0; i < 16; ++i) { row[i] = tv[i]; row[16 + i] = __int_as_float(ti[i]); }
        }
        if (F.lane < 16) {
            const LAS float* r0 = sc + F.lane * 129; const LAS float* r1 = sc + (16 + F.lane) * 129;
            float v0[16], v1[16];
#pragma unroll
            for (int i = 0; i < 16; ++i) { v0[i] = r0[i]; v1[i] = r1[i]; }
            float b[16];
#pragma unroll
            for (int i = 0; i < 16; ++i) b[i] = -INFINITY;
            { int p = 0;
#pragma unroll
              for (int i = 0; i < 16; ++i)
#pragma unroll
                  for (int j = 0; j < 16; ++j) if ((i + 1) * (j + 1) <= 16) { INS16(b, uniq_key(v0[i] + v1[j], p)); ++p; } }
            const int t = t0 + F.lane; float pv[16]; float den = 0.f; float mx = 0.f;
            float rsn; { const f32x4* pp = (const f32x4*)((const float*)(F.ws + WS_PSQ) + (size_t)t * 64); float q = 0.f;
#pragma unroll
              for (int k = 0; k < 16; ++k) { const f32x4 a4 = pp[k]; q += (a4.x + a4.y) + (a4.z + a4.w); }
              rsn = 1.0f / sqrtf(q * (1.f / D_) + 1e-6f); }
#pragma unroll
            for (int r = 0; r < 16; ++r) { const int p = 255 - (int)(__float_as_uint(b[r]) & 255u); const int ij = ptab[p]; const int ii = ij >> 4, jj = ij & 15;
                const float val = r0[ii] + r1[jj]; if (r == 0) mx = val; pv[r] = __expf((val - mx) * rsn); den += pv[r];
                PIDX[(size_t)t * 128 + h * PT + r] = __float_as_int(r0[16 + ii]) * PNK + __float_as_int(r1[16 + jj]); }
            const float inv = 1.0f / den;
#pragma unroll
            for (int r = 0; r < 16; ++r) PGT[(size_t)t * 128 + h * PT + r] = pv[r] * inv;
        }
    }
    __syncthreads();
}
#undef INS16

__device__ __forceinline__ float gelu_erf(float v) {
    const float av = fabsf(v), tt = __builtin_amdgcn_rcpf(av * 0.2316418882f + 1.0f);
    float q = tt * 0.5307027145f + (-0.7265760135f); q = q * tt + 0.7107068705f; q = q * tt + (-0.142248368f); q = q * tt + 0.127414796f; q = q * tt;
    const float e = __builtin_amdgcn_exp2f((v * v) * (-0.72134752044f));
    const float m = v * (q * e); return v < 0.f ? m : v - m;
}
__device__ __forceinline__ void p12_peer(Frame& F) {
    const bf16* HN = (const bf16*)(F.ws + WS_HN);
    const unsigned char* U4 = F.ws + WS_U8; const unsigned short* USS = (const unsigned short*)(F.ws + WS_USC); const unsigned char* V8 = F.ws + WS_V8; const float* VSC = (const float*)(F.ws + WS_VSC);
    const int* PIDX = (const int*)(F.ws + WS_PIDX); const float* PGT = (const float*)(F.ws + WS_PG); const float* PSQ = (const float*)(F.ws + WS_PSQ);
    const float* lnf = F.in[22];
    LAS unsigned char* XQ = F.lds + F.wave * 17408;
    LAS unsigned short* EL = (LAS unsigned short*)(XQ + 16384);
    LAS float* WL = (LAS float*)XQ;
    const int g8 = F.lane >> 3, k8 = F.lane & 7;
    float sx[4];
#pragma unroll
    for (int i = 0; i < 4; ++i) {
        const int t = F.gw + i * F.NGW; v4u xp[8]; float mxa = 0.f;
#pragma unroll
        for (int j = 0; j < 8; ++j) { xp[j] = ((const v4u*)(HN + (size_t)t * D_))[F.lane + 64 * j];
            mxa = fmaxf(fmaxf(fmaxf(mxa, fmaxf(fabsf(bflo(xp[j].x)), fabsf(bfhi(xp[j].x)))), fmaxf(fabsf(bflo(xp[j].y)), fabsf(bfhi(xp[j].y)))), fmaxf(fmaxf(fabsf(bflo(xp[j].z)), fabsf(bfhi(xp[j].z))), fmaxf(fabsf(bflo(xp[j].w)), fabsf(bfhi(xp[j].w))))); }
        mxa = wave_max(mxa); const float inv = mxa > 0.f ? 127.0f / mxa : 0.f;
        const float rsn = 1.0f / sqrtf(wave_sum(PSQ[(size_t)t * 64 + F.lane]) * (1.f / D_) + 1e-6f);
        sx[i] = mxa * rsn * (1.0f / 127.0f);
#pragma unroll
        for (int j = 0; j < 8; ++j) {
            const int q0 = (int)rintf(bflo(xp[j].x) * inv), q1 = (int)rintf(bfhi(xp[j].x) * inv), q2 = (int)rintf(bflo(xp[j].y) * inv), q3 = (int)rintf(bfhi(xp[j].y) * inv);
            const int q4 = (int)rintf(bflo(xp[j].z) * inv), q5 = (int)rintf(bfhi(xp[j].z) * inv), q6 = (int)rintf(bflo(xp[j].w) * inv), q7 = (int)rintf(bfhi(xp[j].w) * inv);
            *(LAS v2u*)(XQ + i * 4096 + 8 * (F.lane + 64 * j)) = (v2u){(unsigned)((q0 & 0xff) | ((q1 & 0xff) << 8) | ((q2 & 0xff) << 16) | (q3 << 24)), (unsigned)((q4 & 0xff) | ((q5 & 0xff) << 8) | ((q6 & 0xff) << 16) | (q7 << 24))}; }
        EL[i * 128 + F.lane] = (unsigned short)PIDX[(size_t)t * 128 + F.lane]; EL[i * 128 + 64 + F.lane] = (unsigned short)PIDX[(size_t)t * 128 + 64 + F.lane];
        asm volatile("" ::: "memory");
    }
    LDS_WAIT(); asm volatile("" ::: "memory");
    float psum[4][16];
#pragma unroll
    for (int i = 0; i < 4; ++i)
#pragma unroll
        for (int b = 0; b < 16; ++b) psum[i][b] = 0.f;
#define P12_U4(W_, XA_, XB_, ACC_) do { ACC_ = __builtin_amdgcn_sdot4((int)((W_) & 0x0F0F0F0Fu), (int)(XA_), ACC_, false); ACC_ = __builtin_amdgcn_sdot4((int)(((W_) >> 4) & 0x0F0F0F0Fu), (int)(XB_), ACC_, false); } while (0)
#define P12_ISSUE(c_, i_, h_, CW_, SC_) do { _Pragma("unroll") for (int bb = 0; bb < 8; ++bb) { const unsigned ro = (unsigned)(c_) * 16384u + (unsigned)EL[(i_) * 128 + ((h_) * 8 + bb) * 8 + g8]; \
        CW_[bb] = *(const v4u*)(U4 + (size_t)(ro * 128u + 16u * (unsigned)k8)); SC_[bb] = USS[(size_t)(ro * 8u + (unsigned)k8)]; } } while (0)
#define P12_XQ(c_, i_) do { xa = *(const LAS v4u*)(XQ + (i_) * 4096 + 256 * (c_) + 32 * k8); xb = *(const LAS v4u*)(XQ + (i_) * 4096 + 256 * (c_) + 32 * k8 + 16); \
        int xs = __builtin_amdgcn_sdot4((int)xa.x, 0x01010101, 0, false); xs = __builtin_amdgcn_sdot4((int)xa.y, 0x01010101, xs, false); xs = __builtin_amdgcn_sdot4((int)xa.z, 0x01010101, xs, false); xs = __builtin_amdgcn_sdot4((int)xa.w, 0x01010101, xs, false); \
        xs = __builtin_amdgcn_sdot4((int)xb.x, 0x01010101, xs, false); xs = __builtin_amdgcn_sdot4((int)xb.y, 0x01010101, xs, false); xs = __builtin_amdgcn_sdot4((int)xb.z, 0x01010101, xs, false); xs = __builtin_amdgcn_sdot4((int)xb.w, 0x01010101, xs, false); \
        xo = 8 * xs; } while (0)
#define P12_COMP(i_, h_, CW_, SC_) do { _Pragma("unroll") for (int bb = 0; bb < 8; ++bb) { int a0 = 0, a1 = 0; P12_U4(CW_[bb].x, xa.x, xa.y, a0); P12_U4(CW_[bb].y, xa.z, xa.w, a1); P12_U4(CW_[bb].z, xb.x, xb.y, a0); P12_U4(CW_[bb].w, xb.z, xb.w, a1); \
        psum[(i_)][(h_) * 8 + bb] += __uint_as_float(SC_[bb] << 16) * (float)((a0 + a1) - xo); } } while (0)
#define P12_BAR() asm volatile("" ::: "memory")
    { v4u cwA[8], cwB[8]; unsigned scA[8], scB[8]; v4u xa, xb; int xo;
      P12_ISSUE(0, 0, 0, cwA, scA);
_Pragma("nounroll")
      for (int c = 0; c < 16; ++c) { const int cn = c + 1 < 16 ? c + 1 : 15;
          P12_XQ(c, 0); P12_ISSUE(c, 0, 1, cwB, scB); P12_BAR(); P12_COMP(0, 0, cwA, scA); P12_ISSUE(c, 1, 0, cwA, scA); P12_BAR(); P12_COMP(0, 1, cwB, scB);
          P12_XQ(c, 1); P12_ISSUE(c, 1, 1, cwB, scB); P12_BAR(); P12_COMP(1, 0, cwA, scA); P12_ISSUE(c, 2, 0, cwA, scA); P12_BAR(); P12_COMP(1, 1, cwB, scB);
          P12_XQ(c, 2); P12_ISSUE(c, 2, 1, cwB, scB); P12_BAR(); P12_COMP(2, 0, cwA, scA); P12_ISSUE(c, 3, 0, cwA, scA); P12_BAR(); P12_COMP(2, 1, cwB, scB);
          P12_XQ(c, 3); P12_ISSUE(c, 3, 1, cwB, scB); P12_BAR(); P12_COMP(3, 0, cwA, scA); P12_ISSUE(cn, 0, 0, cwA, scA); P12_BAR(); P12_COMP(3, 1, cwB, scB);
      } }
#undef P12_ISSUE
#undef P12_XQ
#undef P12_COMP
#undef P12_BAR
#undef P12_U4
    asm volatile("" ::: "memory"); LDS_WAIT();
#pragma unroll
    for (int i = 0; i < 4; ++i) { const int t = F.gw + i * F.NGW;
#pragma unroll
        for (int b = 0; b < 16; ++b) { float d = psum[i][b];
            d += __builtin_bit_cast(float, __builtin_amdgcn_update_dpp(0, __builtin_bit_cast(int, d), 0xB1, 0xF, 0xF, false));
            d += __builtin_bit_cast(float, __builtin_amdgcn_update_dpp(0, __builtin_bit_cast(int, d), 0x4E, 0xF, 0xF, false));
            d += __builtin_bit_cast(float, __builtin_amdgcn_update_dpp(0, __builtin_bit_cast(int, d), 0x141, 0xF, 0xF, false));
            const int idx = b * 8 + g8; const float w = PGT[(size_t)t * 128 + idx] * gelu_erf(sx[i] * d) * VSC[EL[i * 128 + idx]];
            if (k8 == 0) WL[i * 128 + idx] = w; } }
    asm volatile("" ::: "memory"); LDS_WAIT();
#define P12_EID(s_) __builtin_amdgcn_readlane((s_) < 64 ? e_lo : e_hi, (s_) & 63)
_Pragma("nounroll")
    for (int i = 0; i < 4; ++i) { const int t = F.gw + i * F.NGW;
        float acc[64];
#pragma unroll
        for (int k = 0; k < 64; ++k) acc[k] = 0.f;
        const int e_lo = PIDX[(size_t)t * 128 + F.lane], e_hi = PIDX[(size_t)t * 128 + 64 + F.lane];
        const float w_lo = WL[i * 128 + F.lane], w_hi = WL[i * 128 + 64 + F.lane];
        typedef unsigned v3u_ __attribute__((ext_vector_type(3)));
        v3u_ vb[4], n1[4], n2[4], n3[4], n4[4], n5[4];
#define P12_VLOAD(DST_, s_) do { const unsigned char* vp_ = V8 + (size_t)P12_EID(s_) * 3072 + 12 * F.lane; _Pragma("unroll") for (int j = 0; j < 4; ++j) DST_[j] = *(const v3u_*)(vp_ + 768 * j); } while (0)
        P12_VLOAD(vb, 0); P12_VLOAD(n1, 1); P12_VLOAD(n2, 2); P12_VLOAD(n3, 3); P12_VLOAD(n4, 4); P12_VLOAD(n5, 5);
        for (int s = 0; s < 128; ++s) {
            const int s4 = s + 6 < 128 ? s + 6 : 127;
            v3u_ mv_[4]; P12_VLOAD(mv_, s4);
            const float w = rdlane((s) < 64 ? w_lo : w_hi, (s) & 63);
            { typedef unsigned v6u_ __attribute__((ext_vector_type(6))); typedef float v32f_ __attribute__((ext_vector_type(32)));
              const v32f_ f0 = __builtin_amdgcn_cvt_scalef32_pk32_f32_fp6((v6u_){vb[0].x, vb[0].y, vb[0].z, vb[1].x, vb[1].y, vb[1].z}, 1.0f);
              const v32f_ f1 = __builtin_amdgcn_cvt_scalef32_pk32_f32_fp6((v6u_){vb[2].x, vb[2].y, vb[2].z, vb[3].x, vb[3].y, vb[3].z}, 1.0f);
#pragma unroll
              for (int q = 0; q < 32; ++q) { acc[q] += w * f0[q]; acc[32 + q] += w * f1[q]; } }
#pragma unroll
            for (int j = 0; j < 4; ++j) { vb[j] = n1[j]; n1[j] = n2[j]; n2[j] = n3[j]; n3[j] = n4[j]; n4[j] = n5[j]; n5[j] = mv_[j]; }
        }
#undef P12_VLOAD
        float ss = 0.f;
#pragma unroll
        for (int j = 0; j < 4; ++j) { const v4u* hp = (const v4u*)(HN + (size_t)t * D_ + 1024 * j + 16 * F.lane);
#pragma unroll
            for (int k = 0; k < 2; ++k) { const v4u a = hp[k]; const int o = 16 * j + 8 * k;
                acc[o + 0] += bflo(a.x); acc[o + 1] += bfhi(a.x); acc[o + 2] += bflo(a.y); acc[o + 3] += bfhi(a.y); acc[o + 4] += bflo(a.z); acc[o + 5] += bfhi(a.z); acc[o + 6] += bflo(a.w); acc[o + 7] += bfhi(a.w);
#pragma unroll
                for (int e = 0; e < 8; ++e) ss += acc[o + e] * acc[o + e]; } }
        const float rs = 1.0f / sqrtf(wave_sum(ss) * (1.f / D_) + 1e-6f);
#pragma unroll
        for (int j = 0; j < 4; ++j) { const f32x4* gp = (const f32x4*)(lnf + 1024 * j + 16 * F.lane); f32x4* op = (f32x4*)(F.out + (size_t)t * D_ + 1024 * j + 16 * F.lane);
#pragma unroll
            for (int k = 0; k < 4; ++k) { const f32x4 gn = gp[k]; const int o = 16 * j + 4 * k;
                op[k] = (f32x4){acc[o] * rs * gn.x, acc[o + 1] * rs * gn.y, acc[o + 2] * rs * gn.z, acc[o + 3] * rs * gn.w}; } }
    }
#undef P12_EID
}

struct Args { const float* in[23]; float* out; unsigned char* ws; int ph_lo, ph_hi, li, pad; };
__global__ void __launch_bounds__(NWAVES * 64, 2) mk_fwd(Args args) {
    extern __shared__ __attribute__((aligned(16))) unsigned char lds[];
    Frame F;
    F.lds = (LAS unsigned char*)lds;
    F.tid = threadIdx.x; F.lane = F.tid & 63; F.wave = __builtin_amdgcn_readfirstlane(F.tid >> 6);
    F.G = gridDim.x; F.gw = blockIdx.x * NWAVES + F.wave; F.NGW = F.G * NWAVES;
    F.in = args.in; F.out = args.out; F.ws = args.ws;
    volatile LAS unsigned* MISC = (volatile LAS unsigned*)(F.lds + MISC_OFF);
    for (int u = F.tid; u < (LDS_BYTES - LDSCTL_OFF) / 4; u += NWAVES * 64) ((LAS unsigned*)(F.lds + LDSCTL_OFF))[u] = 0u;
    __syncthreads();
    unsigned* ctl = (unsigned*)(F.ws + WS_CTL);
    XcdBarrier bar; bar.bar = ctl + CW_BAR + args.li * XCD_BAR_WORDS; bar.x = 0; bar.st = nullptr;
    const int lo = args.ph_lo, hi = args.ph_hi;
    if (hi - lo > 1) bar = xcd_barrier_post(ctl + CW_BAR + args.li * XCD_BAR_WORDS, MISC + 8);
#define IN(k) ((lo <= (k) && (k) < hi) && (F.lane = fresh_lane(), F.tid = F.wave * 64 + F.lane, true))
#ifndef PROBE_DUP
#define PROBE_DUP 0
#endif
#define REP(k) _Pragma("unroll") for (int _r = 0; _r < ((((PROBE_DUP) >> (k)) & 1) ? 2 : 1); ++_r)
#define SEAM(k) do { if (IN(k) && IN((k) + 1)) xcd_barrier(bar); } while (0)

    if (IN(0)) { REP(0) { p0_prologue(F); __syncthreads(); } SEAM(0); }
    if (IN(1)) REP(1) {
        { pg8::Gemm g{(const pg8::bf16_t*)(F.ws + WS_XN8), (const pg8::bf16_t*)(F.ws + WS_WINT8), S_, 20992, D_ / 2}; pg8::StaticOrder S; S.init(S_, 20992, F.G, (int)blockIdx.x);
          pg8::EpiZ E{(bf16*)(F.ws + WS_ZR), (bf16*)(F.ws + WS_ZM), (bf16*)(F.ws + WS_ZG), 0};
          pg8::gemm_phase<pg8::EpiZ, pg8::StaticOrder, PG8_ALIGN, PG8_SP2, true>(F.lds, g, S, E, F.wave); }
        __syncthreads();
    }
    SEAM(1);
    if (IN(2)) { REP(2) { p2_prep(F); } SEAM(2); }
    if (IN(3)) REP(3) {
        pg8::Gemm g{(const pg8::bf16_t*)(F.ws + WS_LORAA), (const pg8::bf16_t*)(F.ws + WS_LORABT), S_, LORA_N, LORA_K}; pg8::StaticOrder S; S.init(S_, LORA_N, F.G, (int)blockIdx.x);
        pg8::EpiLora E{(float*)(F.ws + WS_WDEC), (float*)(F.ws + WS_ICLR), (float*)(F.ws + WS_GG), F.in[4], F.in[6]};
        pg8::gemm_phase<pg8::EpiLora, pg8::StaticOrder, PG8_ALIGN, PG8_SP2>(F.lds, g, S, E, F.wave);
        __syncthreads();
    }
    SEAM(3);
    if (IN(4)) { REP(4) { p4_rwkv_prep(F); } p4_moba_gate(F); SEAM(4); }
    if (IN(5)) {
        if (F.G >= 256) { if (blockIdx.x < 128) { p5_scan_block(F, blockIdx.x);
#if PROBE_DUP & 0x10000
            __syncthreads(); p5_scan_block(F, blockIdx.x);
#endif
            } else { p5_moba_units(F, blockIdx.x - 128, F.G - 128); __syncthreads(); late_prep(F, (blockIdx.x - 128) * NWAVES + F.wave, (F.G - 128) * NWAVES);
#if PROBE_DUP & 0x20000
            __syncthreads(); p5_moba_units(F, blockIdx.x - 128, F.G - 128);
#endif
            } __syncthreads(); }
        SEAM(5);
    }
    if (IN(6)) { REP(6) { p6_rwkv_post(F); p6_moba_combine(F); } SEAM(6); }
    if (IN(7)) REP(7) {
        pg8::StaticOrder S; S.init(S_, D_, F.G, (int)blockIdx.x);
        { pg8::Gemm g{(const pg8::bf16_t*)(F.ws + WS_YA), (const pg8::bf16_t*)(F.ws + WS_WPA), S_, D_, RW};
          pg8::EpiGateMul E{(bf16*)(F.ws + WS_TMP), D_, (const bf16*)(F.ws + WS_ZG), ZG_LD};
          pg8::gemm_phase<pg8::EpiGateMul, pg8::StaticOrder, PG8_ALIGN, PG8_SP2>(F.lds, g, S, E, F.wave); }
        __syncthreads();
        { pg8::Gemm g{(const pg8::bf16_t*)(F.ws + WS_YB), (const pg8::bf16_t*)(F.ws + WS_WPB), S_, D_, RW / 2};
          pg8::EpiGateAdd E{(const bf16*)(F.ws + WS_TMP), D_, (const bf16*)(F.ws + WS_ZG) + 4096, ZG_LD, (bf16*)(F.ws + WS_MERGED)};
          pg8::gemm_phase<pg8::EpiGateAdd, pg8::StaticOrder, PG8_ALIGN, PG8_SP2, true>(F.lds, g, S, E, F.wave); }
        __syncthreads();
    }
    SEAM(7);
    if (IN(8)) REP(8) {
        pg8::Gemm g{(const pg8::bf16_t*)(F.ws + WS_MERGED), (const pg8::bf16_t*)(F.ws + WS_WOUT), S_, D_, D_}; pg8::StaticOrder S; S.init(S_, D_, F.G, (int)blockIdx.x);
        pg8::EpiResNorm E{F.in[0], D_, (bf16*)(F.ws + WS_HN), (float*)(F.ws + WS_PSQ)};
        pg8::gemm_phase<pg8::EpiResNorm, pg8::StaticOrder, PG8_ALIGN, PG8_SP2>(F.lds, g, S, E, F.wave);
        __syncthreads();
    }
    SEAM(8);
    if (IN(10)) REP(10) {
        pg8::Gemm g{(const pg8::bf16_t*)(F.ws + WS_HN), (const pg8::bf16_t*)(F.ws + WS_WQ), S_, 2048, D_}; pg8::StaticOrder S; S.init(S_, 2048, F.G, (int)blockIdx.x);
        pg8::EpiBf16 E{(bf16*)(F.ws + WS_QRY), 2048};
        pg8::gemm_phase<pg8::EpiBf16, pg8::StaticOrder, PG8_ALIGN, PG8_SP2>(F.lds, g, S, E, F.wave);
        __syncthreads();
    }
    SEAM(10);
    if (IN(11)) { REP(11) { p11_route(F); } SEAM(11); }
    if (IN(12)) { REP(12) { p12_peer(F); } }
#undef IN
#undef SEAM
}

extern "C" void kernel_launch(void* const* d_in, const int* in_sizes, int n_in, void* d_out, int out_size, void* d_ws, size_t ws_size, hipStream_t stream) {
    static int grid = 0;
    if (grid == 0) {
        if (n_in != 23 || out_size != S_ * D_ || ws_size < WS_END) { fprintf(stderr, "kernel_launch: unexpected shapes: n_in %d out %d ws %zu (need %zu)\n", n_in, out_size, ws_size, (size_t)WS_END); grid = -1; return; }
        int dev = 0, cus = 0, per_cu = 0;
        if (hipGetDevice(&dev) != hipSuccess || hipDeviceGetAttribute(&cus, hipDeviceAttributeMultiprocessorCount, dev) != hipSuccess) { grid = -1; return; }
        if (hipFuncSetAttribute((const void*)mk_fwd, hipFuncAttributeMaxDynamicSharedMemorySize, LDS_BYTES) != hipSuccess) { fprintf(stderr, "kernel_launch: hipFuncSetAttribute failed\n"); grid = -1; return; }
        if (hipOccupancyMaxActiveBlocksPerMultiprocessor(&per_cu, (const void*)mk_fwd, NWAVES * 64, LDS_BYTES) != hipSuccess || per_cu < 1) { fprintf(stderr, "kernel_launch: occupancy query reports %d\n", per_cu); }
        (void)hipGetLastError();
        grid = cus;
        if (grid != 256) fprintf(stderr, "kernel_launch: %d CUs (built for 256)\n", grid);
    }
    if (grid < 0) return;
    if (hipMemsetAsync((char*)d_ws + WS_CTL, 0, CTL_ZERO_BYTES, stream) != hipSuccess) return;
    Args a{};
    for (int i = 0; i < 23; ++i) a.in[i] = (const float*)d_in[i];
    a.out = (float*)d_out; a.ws = (unsigned char*)d_ws;
#if MK_N_LAUNCHES == 1
    a.ph_lo = 0; a.ph_hi = N_PHASES; a.li = 0;
    hipLaunchKernelGGL(mk_fwd, dim3(grid), dim3(NWAVES * 64), LDS_BYTES, stream, a);
#else
    for (int p = 0; p < N_PHASES; ++p) { a.ph_lo = p; a.ph_hi = p + 1; a.li = 0; hipLaunchKernelGGL(mk_fwd, dim3(grid), dim3(NWAVES * 64), LDS_BYTES, stream, a); }
#endif
}
```

```cpp
#include <hip/hip_runtime.h>
#include <cstdio>
#include <cstdint>
__device__ __forceinline__ int fresh_lane() { int l; asm volatile("v_mbcnt_lo_u32_b32 %0, -1, 0\n\tv_mbcnt_hi_u32_b32 %0, -1, %0" : "=v"(l)); return l; }
namespace pg8 {
#define PG8_LAS __attribute__((address_space(3)))
typedef unsigned short bf16_t;
typedef short bf16x8 __attribute__((ext_vector_type(8)));
typedef float f32x4 __attribute__((ext_vector_type(4)));
typedef unsigned u32x4 __attribute__((ext_vector_type(4)));
constexpr int BM = 256, BK = 64, HALF = 128, HTB = HALF * BK * 2  , STAGE_BYTES = 8 * HTB, NXCD = 8, WGM = 8;

__host__ __device__ __forceinline__ int lds_byte(int r, int c) { const int st = (r >> 4) * 2 + (c >> 5), rr = r & 15, cc = c & 31, ob = rr * 64 + cc * 2; return st * 1024 + (ob ^ (((ob >> 9) & 1) << 5)); }
__host__ __device__ __forceinline__ void stage_rc(int b, int& R, int& C) { const int st = b / 1024, sb = b % 1024, swz = sb ^ (((sb >> 9) & 1) << 5); R = (st >> 1) * 16 + swz / 64; C = (st & 1) * 32 + (swz % 64) / 2; }
__host__ __device__ __forceinline__ int perm32(int rho) { const int n = rho >> 4, i = rho & 15; return 8 * (i >> 2) + 4 * n + (i & 3); }

struct Unit { int pm, pn; };
struct Gemm { const bf16_t* A; const bf16_t* Bt; int M, N, K; };

struct StaticOrder {
    int nM, nN, nwg, G, c;
    __host__ __device__ void init(int M, int N, int G_, int c_) { nM = M / BM; nN = N / BM; nwg = nM * nN; G = G_; c = c_; }
    __host__ __device__ bool next(int i, Unit& u) const {
        const long L = (long)i * G + c; if (L >= nwg) return false;
        int wgid = (int)L; { const int q = nwg / NXCD, r = nwg % NXCD, xcd = wgid % NXCD, off = wgid / NXCD; wgid = (xcd < r ? xcd * (q + 1) : r * (q + 1) + (xcd - r) * q) + off; }
        const int nig = WGM * nN, gid = wgid / nig, fm = gid * WGM, gsz = (nM - fm) < WGM ? (nM - fm) : WGM;
        u.pm = fm + ((wgid % nig) % gsz); u.pn = (wgid % nig) / gsz; return true;
    }
    __device__ __forceinline__ void a_ready(const Unit&) const {}
    __device__ __forceinline__ void done(const Unit&) const {}
};


__device__ __forceinline__ unsigned cvt_pk_bf16(float lo, float hi) { unsigned r; asm volatile("v_cvt_pk_bf16_f32 %0, %1, %2" : "=v"(r) : "v"(lo), "v"(hi)); return r; }
typedef float f32x2 __attribute__((ext_vector_type(2)));
typedef unsigned u32x2 __attribute__((ext_vector_type(2)));
__device__ __forceinline__ float fast_sigmoid(float x) { return __builtin_amdgcn_rcpf(1.0f + __builtin_amdgcn_exp2f(-1.44269504089f * x)); }
__device__ __forceinline__ float bf_lo(unsigned w) { return __uint_as_float(w << 16); }
__device__ __forceinline__ float bf_hi(unsigned w) { return __uint_as_float(w & 0xffff0000u); }

struct EpiBf16 {
    static constexpr bool PERM = true, AFTER_DRAIN = false;
    bf16_t* O; int ldc;
    __device__ __forceinline__ void operator()(const f32x4 (&acc)[2][2][4][2], const Unit& u, int wr, int wc, int fr_, int fq_) const {
        const int l_ = fresh_lane(), fr = l_ & 15, fq = l_ >> 4;
        const int row0 = u.pm * BM + wr * 64 + fr, col0 = u.pn * BM + wc * 32 + 8 * fq;
#pragma unroll
        for (int ai = 0; ai < 2; ++ai)
#pragma unroll
            for (int m = 0; m < 4; ++m) { bf16_t* rowp = O + (size_t)(row0 + ai * HALF + m * 16) * ldc + col0;
#pragma unroll
                for (int bj = 0; bj < 2; ++bj) { const f32x4 v0 = acc[ai][bj][m][0], v1 = acc[ai][bj][m][1];
                    u32x4 w; w.x = cvt_pk_bf16(v0[0], v0[1]); w.y = cvt_pk_bf16(v0[2], v0[3]); w.z = cvt_pk_bf16(v1[0], v1[1]); w.w = cvt_pk_bf16(v1[2], v1[3]);
                    *(u32x4*)(rowp + bj * HALF) = w; } }
    }
};
struct EpiZ {
    static constexpr bool PERM = true, AFTER_DRAIN = false;
    bf16_t *ZR, *ZM, *ZG; int pn0;
    __device__ __forceinline__ void operator()(const f32x4 (&acc)[2][2][4][2], const Unit& u, int wr, int wc, int fr_, int fq_) const {
        const int l_ = fresh_lane(), fr = l_ & 15, fq = l_ >> 4;
        bf16_t* base; int ldc, colt; bool sig = false; const int pn = u.pn + pn0;
        if (pn < 26) { base = ZR; ldc = 6656; colt = pn * BM; }
        else if (pn < 50) { base = ZM; ldc = 6144; colt = (pn - 26) * BM; }
        else { base = ZG; ldc = 8192; colt = (pn - 50) * BM; sig = true; }
        const int row0 = u.pm * BM + wr * 64 + fr, col0 = colt + wc * 32 + 8 * fq;
#pragma unroll
        for (int ai = 0; ai < 2; ++ai)
#pragma unroll
            for (int m = 0; m < 4; ++m) { bf16_t* rowp = base + (size_t)(row0 + ai * HALF + m * 16) * ldc + col0;
#pragma unroll
                for (int bj = 0; bj < 2; ++bj) { f32x4 v0 = acc[ai][bj][m][0], v1 = acc[ai][bj][m][1];
                    if (sig) {
#pragma unroll
                        for (int j = 0; j < 4; ++j) { v0[j] = fast_sigmoid(v0[j]); v1[j] = fast_sigmoid(v1[j]); } }
                    u32x4 w; w.x = cvt_pk_bf16(v0[0], v0[1]); w.y = cvt_pk_bf16(v0[2], v0[3]); w.z = cvt_pk_bf16(v1[0], v1[1]); w.w = cvt_pk_bf16(v1[2], v1[3]);
                    *(u32x4*)(rowp + bj * HALF) = w; } }
    }
};
struct EpiLora {
    static constexpr bool PERM = false, AFTER_DRAIN = false;
    float *WDEC, *ICLR, *GG; const float *w0, *a0;
    __device__ __forceinline__ void operator()(const f32x4 (&acc)[2][2][4][2], const Unit& u, int wr, int wc, int fr_, int fq_) const {
        const int l_ = fresh_lane(), fr = l_ & 15, fq = l_ >> 4;
        const int mode = u.pn >> 3; float* base = WDEC + (size_t)mode * ((size_t)8192 * 2048);
        bf16_t* baseh = (bf16_t*)base;
        const int row0 = u.pm * BM + wr * 64 + fr, col0 = (u.pn & 7) * BM + wc * 32 + 4 * fq;
        const float* bp = mode == 0 ? w0 : a0;
#pragma unroll
        for (int ai = 0; ai < 2; ++ai)
#pragma unroll
            for (int m = 0; m < 4; ++m) { const size_t ro = (size_t)(row0 + ai * HALF + m * 16) * 2048 + col0;
#pragma unroll
                for (int bj = 0; bj < 2; ++bj)
#pragma unroll
                    for (int n = 0; n < 2; ++n) { f32x4 v = acc[ai][bj][m][n];
                        if (mode < 2) v += *(const f32x4*)(bp + col0 + bj * HALF + n * 16);
                        if (mode == 0) {
#pragma unroll
                            for (int j = 0; j < 4; ++j) { const float x = -v[j]; const float sp = fmaxf(x, 0.f) + __logf(1.0f + __expf(-fabsf(x))); v[j] = __expf(-__expf(-sp - 0.5f)); } }
                        else if (mode == 1) {
#pragma unroll
                            for (int j = 0; j < 4; ++j) v[j] = fast_sigmoid(v[j]); }
                        if (mode == 0) *(f32x4*)(base + ro + bj * HALF + n * 16) = v;
                        else { u32x2 w; w.x = cvt_pk_bf16(v[0], v[1]); w.y = cvt_pk_bf16(v[2], v[3]); *(u32x2*)(baseh + ro + bj * HALF + n * 16) = w; } }
                asm volatile("" ::: "memory"); }
    }
};
struct EpiGateMul {
    static constexpr bool PERM = false, AFTER_DRAIN = false;
    bf16_t* T; int ldc; const bf16_t* G; int ldg;
    __device__ __forceinline__ void operator()(const f32x4 (&acc)[2][2][4][2], const Unit& u, int wr, int wc, int fr_, int fq_) const {
        const int l_ = fresh_lane(), fr = l_ & 15, fq = l_ >> 4;
        const int row0 = u.pm * BM + wr * 64 + fr, col0 = u.pn * BM + wc * 32 + 4 * fq;
#pragma unroll
        for (int ai = 0; ai < 2; ++ai)
#pragma unroll
            for (int m = 0; m < 4; ++m) { const size_t r = (size_t)(row0 + ai * HALF + m * 16);
#pragma unroll
                for (int bj = 0; bj < 2; ++bj)
#pragma unroll
                    for (int n = 0; n < 2; ++n) { const u32x2 g = *(const u32x2*)(G + r * ldg + col0 + bj * HALF + n * 16); const f32x4 a = acc[ai][bj][m][n];
                        u32x2 w; w.x = cvt_pk_bf16(a[0] * bf_lo(g.x), a[1] * bf_hi(g.x)); w.y = cvt_pk_bf16(a[2] * bf_lo(g.y), a[3] * bf_hi(g.y)); *(u32x2*)(T + r * ldc + col0 + bj * HALF + n * 16) = w; } }
    }
};
struct EpiGateAdd {
    static constexpr bool PERM = false, AFTER_DRAIN = false;
    const bf16_t* T; int ldc; const bf16_t* G; int ldg; bf16_t* O;
    __device__ __forceinline__ void operator()(const f32x4 (&acc)[2][2][4][2], const Unit& u, int wr, int wc, int fr_, int fq_) const {
        const int l_ = fresh_lane(), fr = l_ & 15, fq = l_ >> 4;
        const int row0 = u.pm * BM + wr * 64 + fr, col0 = u.pn * BM + wc * 32 + 4 * fq;
#pragma unroll
        for (int ai = 0; ai < 2; ++ai)
#pragma unroll
            for (int m = 0; m < 4; ++m) { const size_t r = (size_t)(row0 + ai * HALF + m * 16);
#pragma unroll
                for (int bj = 0; bj < 2; ++bj)
#pragma unroll
                    for (int n = 0; n < 2; ++n) { const u32x2 g = *(const u32x2*)(G + r * ldg + col0 + bj * HALF + n * 16); const f32x4 a = acc[ai][bj][m][n];
                        const u32x2 t = *(const u32x2*)(T + r * ldc + col0 + bj * HALF + n * 16);
                        u32x2 w; w.x = cvt_pk_bf16(bf_lo(t.x) + a[0] * bf_lo(g.x), bf_hi(t.x) + a[1] * bf_hi(g.x)); w.y = cvt_pk_bf16(bf_lo(t.y) + a[2] * bf_lo(g.y), bf_hi(t.y) + a[3] * bf_hi(g.y));
                        *(u32x2*)(O + r * ldc + col0 + bj * HALF + n * 16) = w; }
                asm volatile("" ::: "memory"); }
    }
};
struct EpiRes {
    static constexpr bool PERM = false, AFTER_DRAIN = false;
    float* C; const float* R; int ldc;
    __device__ __forceinline__ void operator()(const f32x4 (&acc)[2][2][4][2], const Unit& u, int wr, int wc, int fr_, int fq_) const {
        const int l_ = fresh_lane(), fr = l_ & 15, fq = l_ >> 4;
        const int row0 = u.pm * BM + wr * 64 + fr, col0 = u.pn * BM + wc * 32 + 4 * fq;
#pragma unroll
        for (int ai = 0; ai < 2; ++ai)
#pragma unroll
            for (int m = 0; m < 4; ++m) { const size_t r = (size_t)(row0 + ai * HALF + m * 16);
#pragma unroll
                for (int bj = 0; bj < 2; ++bj)
#pragma unroll
                    for (int n = 0; n < 2; ++n) { const size_t o = r * ldc + col0 + bj * HALF + n * 16; *(f32x4*)(C + o) = *(const f32x4*)(R + o) + acc[ai][bj][m][n]; } }
    }
};

struct EpiResNorm {
    static constexpr bool PERM = false, AFTER_DRAIN = false;
    const float* R; int ldc; bf16_t* HB; float* PSQ;
    __device__ __forceinline__ void operator()(const f32x4 (&acc)[2][2][4][2], const Unit& u, int wr, int wc, int fr_, int fq_) const {
        const int l_ = fresh_lane(), fr = l_ & 15, fq = l_ >> 4;
        const int row0 = u.pm * BM + wr * 64 + fr, col0 = u.pn * BM + wc * 32 + 4 * fq;
#pragma unroll
        for (int ai = 0; ai < 2; ++ai)
#pragma unroll
            for (int m = 0; m < 4; ++m) { const size_t r = (size_t)(row0 + ai * HALF + m * 16); float ss = 0.f;
#pragma unroll
                for (int bj = 0; bj < 2; ++bj)
#pragma unroll
                    for (int n = 0; n < 2; ++n) { const size_t o = r * ldc + col0 + bj * HALF + n * 16; const f32x4 c = *(const f32x4*)(R + o) + acc[ai][bj][m][n];
                        ss += (c[0] * c[0] + c[1] * c[1]) + (c[2] * c[2] + c[3] * c[3]);
                        u32x2 w; w.x = cvt_pk_bf16(c[0], c[1]); w.y = cvt_pk_bf16(c[2], c[3]); *(u32x2*)(HB + o) = w; }
                ss += __builtin_bit_cast(float, __builtin_amdgcn_ds_bpermute((l_ ^ 16) << 2, __builtin_bit_cast(int, ss)));
                ss += __builtin_bit_cast(float, __builtin_amdgcn_ds_bpermute((l_ ^ 32) << 2, __builtin_bit_cast(int, ss)));
                if (fq == 0) PSQ[r * 64 + u.pn * 4 + wc] = ss;
                asm volatile("" ::: "memory"); }
    }
};

typedef int i32x8 __attribute__((ext_vector_type(8)));
typedef int i32x4 __attribute__((ext_vector_type(4)));
template <class Epi, class Sched, bool ALIGN_EPI = false, bool SP2 = false, bool F8 = false>
__device__ __forceinline__ void gemm_phase(PG8_LAS unsigned char* lds, const Gemm g, const Sched& S, const Epi& E, int wid_) {
    const int wid = __builtin_amdgcn_readfirstlane(wid_), lane = fresh_lane(), tid = wid * 64 + lane, wr = wid >> 2, wc = wid & 3, fr = lane & 15, fq = lane >> 4;
    const int K = g.K, nt = K / BK;
    unsigned voffA, voffB;
    { int R, C; stage_rc(tid * 16, R, C); const int Rb = Epi::PERM ? ((R & ~31) + perm32(R & 31)) : R; voffA = (unsigned)(R * K + C) * 2u; voffB = (unsigned)(Rb * K + C) * 2u; }
    const size_t rstep64 = (size_t)64 * K * 2;
    const size_t kstep = (size_t)(BK * 2);
    const size_t hstep = (size_t)HALF * K * 2;
    const size_t tstep = 2 * hstep;
    const unsigned ldsw = (unsigned)wid * 1024u;
    const int aoff = lds_byte(wr * 64 + fr, fq * 8), boff = lds_byte(wc * 32 + fr, fq * 8);
#define PG8_SA(b, h) (((b) * 2 + (h)) * HTB)
#define PG8_SB(b, h) ((4 + (b) * 2 + (h)) * HTB)
#define PG8_STAGE(bufoff, gbase, voff) do { _Pragma("unroll") for (int _i = 0; _i < 2; ++_i) \
        __builtin_amdgcn_global_load_lds((const unsigned*)((const char*)(gbase) + _i * rstep64 + (voff)), (PG8_LAS unsigned*)(lds + (bufoff) + ldsw + _i * 8192), 16, 0, 0); } while (0)
#define PG8_LDA(dst, b, h) do { _Pragma("unroll") for (int m = 0; m < 4; ++m) { if constexpr (F8) { const i32x4 _lo = *(const PG8_LAS i32x4*)(lds + PG8_SA(b, h) + aoff + m * 2048), _hi = *(const PG8_LAS i32x4*)(lds + PG8_SA(b, h) + aoff + m * 2048 + 1024); dst##8[m] = __builtin_shufflevector(_lo, _hi, 0, 1, 2, 3, 4, 5, 6, 7); } \
        else { _Pragma("unroll") for (int k = 0; k < 2; ++k) dst[m][k] = *(const PG8_LAS bf16x8*)(lds + PG8_SA(b, h) + aoff + m * 2048 + k * 1024); } } } while (0)
#define PG8_LDB(dst, b, h) do { _Pragma("unroll") for (int n = 0; n < 2; ++n) { if constexpr (F8) { const i32x4 _lo = *(const PG8_LAS i32x4*)(lds + PG8_SB(b, h) + boff + n * 2048), _hi = *(const PG8_LAS i32x4*)(lds + PG8_SB(b, h) + boff + n * 2048 + 1024); dst##8[n] = __builtin_shufflevector(_lo, _hi, 0, 1, 2, 3, 4, 5, 6, 7); } \
        else { _Pragma("unroll") for (int k = 0; k < 2; ++k) dst[n][k] = *(const PG8_LAS bf16x8*)(lds + PG8_SB(b, h) + boff + n * 2048 + k * 1024); } } } while (0)
#define PG8_MMA(ai, bj, At, Bt) do { __builtin_amdgcn_s_setprio(1); _Pragma("unroll") for (int m = 0; m < 4; ++m) _Pragma("unroll") for (int n = 0; n < 2; ++n) { \
        if constexpr (F8) acc[ai][bj][m][n] = __builtin_amdgcn_mfma_scale_f32_16x16x128_f8f6f4(Bt##8[n], At##8[m], acc[ai][bj][m][n], 0, 0, 0, 0x7b77, 1, 0x7b77); \
        else { _Pragma("unroll") for (int k = 0; k < 2; ++k) acc[ai][bj][m][n] = __builtin_amdgcn_mfma_f32_16x16x32_bf16(Bt[n][k], At[m][k], acc[ai][bj][m][n], 0, 0, 0); } } __builtin_amdgcn_s_setprio(0); } while (0)
#define PG8_WAIT_V(n) asm volatile("s_waitcnt vmcnt(" #n ")" ::: "memory")
#define PG8_WAIT_L(n) asm volatile("s_waitcnt lgkmcnt(" #n ")" ::: "memory")
#define PG8_BAR __builtin_amdgcn_s_barrier()
#define PG8_SCHED __builtin_amdgcn_sched_barrier(0)
    Unit cur, nxt; int ui = 0;
    if (!S.next(0, cur)) return;
    f32x4 acc[2][2][4][2];
#pragma unroll
    for (int a = 0; a < 2; ++a)
#pragma unroll
        for (int b = 0; b < 2; ++b)
#pragma unroll
            for (int m = 0; m < 4; ++m)
#pragma unroll
                for (int n = 0; n < 2; ++n) acc[a][b][m][n] = (f32x4){0.f, 0.f, 0.f, 0.f};
    bf16x8 At[4][2], B0[2][2], B1[2][2]; i32x8 At8[4], B08[2], B18[2];
    const char* cA = (const char*)g.A + (size_t)cur.pm * tstep; const char* cB = (const char*)g.Bt + (size_t)cur.pn * tstep;
    S.a_ready(cur);
    if constexpr (SP2) {
        PG8_STAGE(PG8_SB(0, 0), cB, voffB); PG8_STAGE(PG8_SB(0, 1), cB + hstep, voffB); PG8_STAGE(PG8_SA(0, 0), cA, voffA); PG8_STAGE(PG8_SA(0, 1), cA + hstep, voffA);
        if (wr == 1) PG8_BAR;
        PG8_WAIT_V(2); PG8_BAR;
        PG8_STAGE(PG8_SB(1, 0), cB + kstep, voffB); PG8_STAGE(PG8_SA(1, 0), cA + kstep, voffA); PG8_STAGE(PG8_SB(1, 1), cB + hstep + kstep, voffB);
        PG8_WAIT_V(6); PG8_BAR;
    } else {
        PG8_STAGE(PG8_SB(0, 0), cB, voffB); PG8_STAGE(PG8_SA(0, 0), cA, voffA); PG8_STAGE(PG8_SB(0, 1), cB + hstep, voffB); PG8_STAGE(PG8_SA(0, 1), cA + hstep, voffA);
        if (wr == 1) PG8_BAR;
        PG8_WAIT_V(4); PG8_BAR;
        PG8_STAGE(PG8_SB(1, 0), cB + kstep, voffB); PG8_STAGE(PG8_SA(1, 0), cA + kstep, voffA); PG8_STAGE(PG8_SB(1, 1), cB + hstep + kstep, voffB);
        PG8_WAIT_V(6); PG8_BAR;
    }
    for (;;) {
        const bool has_next = S.next(ui + 1, nxt);
        const char* nA = has_next ? (const char*)g.A + (size_t)nxt.pm * tstep : cA; const char* nB = has_next ? (const char*)g.Bt + (size_t)nxt.pn * tstep : cB;
        for (int t = 0; t < nt; t += 2) {
            const bool last = (t == nt - 2);
            const char* a1 = cA + (size_t)(t + 1) * kstep;
            const char* a2 = last ? nA : cA + (size_t)(t + 2) * kstep; const char* b2 = last ? nB : cB + (size_t)(t + 2) * kstep;
            const char* a3 = a2 + kstep; const char* b3 = b2 + kstep;
            if (last && has_next) S.a_ready(nxt);
            if constexpr (SP2) {
            PG8_LDB(B0, 0, 0); PG8_LDB(B1, 0, 1); PG8_SCHED; PG8_LDA(At, 0, 0); PG8_STAGE(PG8_SA(1, 1), a1 + hstep, voffA);
            PG8_WAIT_V(8); PG8_WAIT_L(0); PG8_BAR; PG8_MMA(0, 0, At, B0); PG8_MMA(0, 1, At, B1); PG8_BAR; PG8_SCHED;
            PG8_LDA(At, 0, 1); PG8_STAGE(PG8_SB(0, 0), b2, voffB); PG8_STAGE(PG8_SB(0, 1), b2 + hstep, voffB); PG8_STAGE(PG8_SA(0, 0), a2, voffA);
            PG8_WAIT_V(8); PG8_WAIT_L(0); PG8_BAR; PG8_MMA(1, 0, At, B0); PG8_MMA(1, 1, At, B1); PG8_BAR; PG8_SCHED;
            PG8_LDB(B0, 1, 0); PG8_LDB(B1, 1, 1); PG8_SCHED; PG8_LDA(At, 1, 0); PG8_STAGE(PG8_SA(0, 1), a2 + hstep, voffA);
            PG8_WAIT_V(8); PG8_WAIT_L(0); PG8_BAR; PG8_MMA(0, 0, At, B0); PG8_MMA(0, 1, At, B1); PG8_BAR; PG8_SCHED;
            PG8_LDA(At, 1, 1); PG8_STAGE(PG8_SB(1, 0), b3, voffB); PG8_STAGE(PG8_SB(1, 1), b3 + hstep, voffB); PG8_STAGE(PG8_SA(1, 0), a3, voffA);
            PG8_WAIT_V(8); PG8_WAIT_L(0); PG8_BAR; PG8_MMA(1, 0, At, B0); PG8_MMA(1, 1, At, B1); PG8_BAR; PG8_SCHED;
            } else {
            PG8_LDB(B0, 0, 0); PG8_SCHED; PG8_LDA(At, 0, 0); PG8_STAGE(PG8_SA(1, 1), a1 + hstep, voffA);
            PG8_WAIT_L(8); PG8_BAR; PG8_WAIT_L(0); PG8_MMA(0, 0, At, B0); PG8_BAR; PG8_SCHED;
            PG8_LDB(B1, 0, 1); PG8_STAGE(PG8_SB(0, 0), b2, voffB);
            PG8_BAR; PG8_WAIT_L(0); PG8_MMA(0, 1, At, B1); PG8_BAR;
            PG8_LDA(At, 0, 1); PG8_STAGE(PG8_SA(0, 0), a2, voffA);
            PG8_BAR; PG8_WAIT_L(0); PG8_MMA(1, 0, At, B0); PG8_BAR; PG8_SCHED;
            PG8_STAGE(PG8_SB(0, 1), b2 + hstep, voffB);
            PG8_WAIT_V(6); PG8_BAR; PG8_MMA(1, 1, At, B1); PG8_BAR;
            PG8_LDB(B0, 1, 0); PG8_SCHED; PG8_LDA(At, 1, 0); PG8_STAGE(PG8_SA(0, 1), a2 + hstep, voffA);
            PG8_WAIT_L(8); PG8_BAR; PG8_WAIT_L(0); PG8_MMA(0, 0, At, B0); PG8_BAR; PG8_SCHED;
            PG8_LDB(B1, 1, 1); PG8_STAGE(PG8_SB(1, 0), b3, voffB);
            PG8_BAR; PG8_WAIT_L(0); PG8_MMA(0, 1, At, B1); PG8_BAR;
            PG8_LDA(At, 1, 1); PG8_STAGE(PG8_SA(1, 0), a3, voffA);
            PG8_BAR; PG8_WAIT_L(0); PG8_MMA(1, 0, At, B0); PG8_BAR; PG8_SCHED;
            PG8_STAGE(PG8_SB(1, 1), b3 + hstep, voffB);
            PG8_WAIT_V(6); PG8_BAR; PG8_MMA(1, 1, At, B1); PG8_BAR;
            }
        }
        if constexpr (ALIGN_EPI) { if (wr == 0) PG8_BAR; }
        if constexpr (!Epi::AFTER_DRAIN) { E(acc, cur, wr, wc, fr, fq); S.done(cur); }
        if (!has_next) break;
#pragma unroll
        for (int a = 0; a < 2; ++a)
#pragma unroll
            for (int b = 0; b < 2; ++b)
#pragma unroll
                for (int m = 0; m < 4; ++m)
#pragma unroll
                    for (int n = 0; n < 2; ++n) acc[a][b][m][n] = (f32x4){0.f, 0.f, 0.f, 0.f};
        cur = nxt; cA = nA; cB = nB; ++ui;
        if constexpr (ALIGN_EPI) { if (wr == 1) PG8_BAR; }
    }
    PG8_WAIT_V(0);
    if constexpr (!ALIGN_EPI) { if (wr == 0) PG8_BAR; }
    PG8_BAR;
    if constexpr (Epi::AFTER_DRAIN) { E.fused(acc, cur, wr, wc, fr, fq, lds, wid, lane); S.done(cur); }
#undef PG8_SA
#undef PG8_SB
#undef PG8_STAGE
#undef PG8_LDA
#undef PG8_LDB
#undef PG8_MMA
#undef PG8_WAIT_V
#undef PG8_WAIT_L
#undef PG8_BAR
#undef PG8_SCHED
}
}

#ifndef PG8_SP2
#define PG8_SP2 true
#endif
#ifndef PG8_ALIGN
#define PG8_ALIGN true
#endif

constexpr int S_ = 8192, D_ = 4096;
constexpr int RW = 2048, RH = 32, RN = 64;
constexpr int IN_COLS = 20864, RWKV_COLS = 6528;
constexpr int ZR_LD = 6656, ZM_LD = 6144, ZG_LD = 8192, ZN = ZR_LD + ZM_LD + ZG_LD;
constexpr int MH = 16, MD = 128, MBS = 256, MNB = 32;
constexpr int PH = 8, PNK = 128, PE = 16384, PT = 16;
constexpr int LORA_K = 384, LORA_N = 6144;
constexpr int SCAN_REC = 896;
constexpr int NWAVES = 8;
constexpr int N_PHASES = 13;
#ifndef MK_N_LAUNCHES
#define MK_N_LAUNCHES 1
#endif

constexpr size_t MiB = 1u << 20;
constexpr size_t WS_CTL = 0, CTL_ZERO_BYTES = 1 * MiB;
constexpr size_t WS_KMEAN = 1 * MiB;
constexpr size_t WS_SUBK = 2 * MiB;
constexpr size_t WS_LORABT = 3 * MiB;
constexpr size_t WS_LORAA = 8 * MiB;
constexpr size_t WS_PIDX = 14 * MiB;
constexpr size_t WS_PG = 18 * MiB;
constexpr size_t WS_BC = 22 * MiB;
constexpr size_t WS_WPA = 32 * MiB;
constexpr size_t WS_WPB = 48 * MiB;
constexpr size_t WS_WOUT = 64 * MiB;
constexpr size_t WS_WQ = 96 * MiB;
constexpr size_t WS_U8 = 112 * MiB;
constexpr size_t WS_V8 = 176 * MiB;
constexpr size_t WS_VSC = 240 * MiB;
constexpr size_t WS_USC = 244 * MiB;
constexpr size_t WS_PSQ = 8 * MiB;
constexpr size_t WS_WINT = 368 * MiB;
constexpr size_t WS_WINT8 = 368 * MiB;
constexpr size_t WS_XN8 = 476 * MiB;
constexpr size_t WS_XN = 532 * MiB;
constexpr size_t WS_WDEC = 432 * MiB;
constexpr size_t WS_ICLR = 496 * MiB;
constexpr size_t WS_GG = 560 * MiB;
constexpr size_t WS_PARTO = 432 * MiB;
constexpr size_t WS_PARTML = 692 * MiB;
constexpr size_t WS_MLIST = 23 * MiB;
constexpr size_t WS_YA = 368 * MiB;
constexpr size_t WS_YB = 400 * MiB;
constexpr size_t WS_HN8 = 368 * MiB;
constexpr size_t WS_HN = 564 * MiB;
constexpr size_t WS_ZR = 628 * MiB;
constexpr size_t WS_Y = 628 * MiB;
constexpr size_t WS_QRY = 692 * MiB;
constexpr size_t WS_ZM = 732 * MiB;
constexpr size_t WS_ZG = 828 * MiB;
constexpr size_t WS_SCAN = 956 * MiB;
constexpr size_t WS_TMP = 956 * MiB;
constexpr size_t WS_MERGED = 1084 * MiB;
constexpr size_t WS_END = 1180 * MiB;
constexpr size_t WS_H1R = 732 * MiB;

constexpr int CW_BAR = 4096;
constexpr int CW_MCNT = 16384;

constexpr int RING_BYTES = 131072;
constexpr int LDS_BYTES = 147456;
constexpr int LDSCTL_OFF = LDS_BYTES - 1024, MISC_OFF = LDSCTL_OFF + 320;

#define GAS __attribute__((address_space(1)))
#define LAS __attribute__((address_space(3)))
typedef unsigned short bf16;
typedef unsigned v4u __attribute__((ext_vector_type(4)));
typedef unsigned v2u __attribute__((ext_vector_type(2)));
typedef float f32x4 __attribute__((ext_vector_type(4)));
typedef float f32x2 __attribute__((ext_vector_type(2)));
typedef __bf16 bf2_t __attribute__((ext_vector_type(2)));
#define LDS_WAIT() asm volatile("s_waitcnt lgkmcnt(0)" ::: "memory")
#define VM_WAIT() asm volatile("s_waitcnt vmcnt(0)" ::: "memory")
__device__ __forceinline__ unsigned f2bf(float f) { unsigned u = __builtin_bit_cast(unsigned, f); return (u + 0x7fffu + ((u >> 16) & 1u)) >> 16; }
__device__ __forceinline__ unsigned pk2(float lo, float hi) { return f2bf(lo) | (f2bf(hi) << 16); }
__device__ __forceinline__ float bflo(unsigned w) { return __uint_as_float(w << 16); }
__device__ __forceinline__ float bfhi(unsigned w) { return __uint_as_float(w & 0xffff0000u); }
__device__ __forceinline__ f32x4 bf4(v2u w) { return (f32x4){bflo(w.x), bfhi(w.x), bflo(w.y), bfhi(w.y)}; }
__device__ __forceinline__ float bf1(bf16 h) { return __uint_as_float(((unsigned)h) << 16); }
__device__ __forceinline__ float dot2bf(unsigned a, unsigned b, float c) { return __builtin_amdgcn_fdot2_f32_bf16(__builtin_bit_cast(bf2_t, a), __builtin_bit_cast(bf2_t, b), c, false); }
__device__ __forceinline__ float sigmoidf_(float x) { return 1.0f / (1.0f + __expf(-x)); }

#define XB_TMO      128
#define XB_XCNT(j)  (256  + 64 * (j))
#define XB_XSUB(j)  (1280 + 64 * (j))
#define XB_XGEN(j)  (2304 + 64 * (j))
#define XB_TOP      3328
#define XB_TOPGEN   3392
#define XCD_BAR_WORDS 3456
#define XB_SPIN_CAP (1u << 18)
__device__ __forceinline__ unsigned xb_ld(unsigned* p)              { return __hip_atomic_load(p, __ATOMIC_RELAXED, __HIP_MEMORY_SCOPE_AGENT); }
__device__ __forceinline__ unsigned xb_add(unsigned* p, unsigned v) { return __hip_atomic_fetch_add(p, v, __ATOMIC_RELAXED, __HIP_MEMORY_SCOPE_AGENT); }
__device__ __forceinline__ unsigned xb_xcc_id() { return (unsigned)__builtin_amdgcn_s_getreg((3 << 11) | 20) & 0xFu; }
#define XB_SPIN(cond, bar) do { unsigned _sp = 0; while (cond) { __builtin_amdgcn_s_sleep(1); \
    if ((++_sp & 255u) == 0u) { if (xb_ld(&(bar)[XB_TMO])) break; if (_sp > XB_SPIN_CAP) { atomicAdd(&(bar)[XB_TMO], 1u); break; } } } } while (0)
struct XcdBarrier { unsigned* bar; unsigned x; volatile LAS unsigned* st; };
__device__ __forceinline__ XcdBarrier xcd_barrier_post(unsigned* bar, volatile LAS unsigned* st) {
    XcdBarrier b; b.bar = bar; b.x = xb_xcc_id(); b.st = st;
    if (threadIdx.x == 0) (void)xb_add(&bar[XB_XCNT(b.x)], 1u);
    return b;
}
__device__ __forceinline__ void xcd_barrier_complete(unsigned* bar, unsigned x, unsigned& nloc, unsigned& nx) {
    const unsigned G = gridDim.x * gridDim.y * gridDim.z;
    unsigned sum, cnt, mine, sp = 0u;
    for (;;) {
        sum = 0u; cnt = 0u; mine = 0u;
#pragma unroll
        for (unsigned j = 0; j < 16; ++j) { const unsigned c = xb_ld(&bar[XB_XCNT(j)]); sum += c; cnt += (c > 0u) ? 1u : 0u; mine = (j == x) ? c : mine; }
        if (sum == G) break;
        __builtin_amdgcn_s_sleep(1);
        if ((++sp & 255u) == 0u) { if (xb_ld(&bar[XB_TMO])) break; if (sp > XB_SPIN_CAP) { atomicAdd(&bar[XB_TMO], 1u); break; } }
    }
    nloc = mine > 0u ? mine : 1u; nx = cnt > 0u ? cnt : 1u;
}
__device__ __forceinline__ void xcd_barrier(const XcdBarrier& b) {
    asm volatile("s_waitcnt vmcnt(0)" ::: "memory");
    __syncthreads();
    if (threadIdx.x == 0) {
        unsigned* bar = b.bar;
        __builtin_amdgcn_s_waitcnt(0);
        unsigned nloc = b.st[0], nx = b.st[1];
        if (nloc == 0u) { xcd_barrier_complete(bar, b.x, nloc, nx); b.st[0] = nloc; b.st[1] = nx; }
        const unsigned old = xb_add(&bar[XB_XSUB(b.x)], 1u);
        const unsigned gen = old / nloc;
        if (old + 1u == (gen + 1u) * nloc) {
            __builtin_amdgcn_fence(__ATOMIC_RELEASE, "agent");
            asm volatile("s_waitcnt vmcnt(0)" ::: "memory");
            const unsigned og = xb_add(&bar[XB_TOP], 1u);
            const unsigned tg = og / nx;
            if (og + 1u == (tg + 1u) * nx) xb_add(&bar[XB_TOPGEN], 1u);
            else XB_SPIN(xb_ld(&bar[XB_TOPGEN]) == tg, bar);
            __builtin_amdgcn_fence(__ATOMIC_ACQUIRE, "agent");
            xb_add(&bar[XB_XGEN(b.x)], 1u);
            asm volatile("s_waitcnt vmcnt(0)" ::: "memory");
        } else {
            XB_SPIN(xb_ld(&bar[XB_XGEN(b.x)]) == gen, bar);
            __builtin_amdgcn_fence(__ATOMIC_ACQUIRE, "agent");
            asm volatile("s_waitcnt vmcnt(0)" ::: "memory");
        }
    }
    __syncthreads();
}

struct Frame {
    LAS unsigned char* lds;
    int tid, lane, wave, G, gw, NGW;
    const float* const* in;
    float* out;
    unsigned char* ws;
};
__device__ __forceinline__ float dpp_add16(float v) {
    v += __builtin_bit_cast(float, __builtin_amdgcn_update_dpp(0, __builtin_bit_cast(int, v), 0xB1, 0xF, 0xF, false));
    v += __builtin_bit_cast(float, __builtin_amdgcn_update_dpp(0, __builtin_bit_cast(int, v), 0x4E, 0xF, 0xF, false));
    v += __builtin_bit_cast(float, __builtin_amdgcn_update_dpp(0, __builtin_bit_cast(int, v), 0x141, 0xF, 0xF, false));
    v += __builtin_bit_cast(float, __builtin_amdgcn_update_dpp(0, __builtin_bit_cast(int, v), 0x140, 0xF, 0xF, false));
    return v;
}
__device__ __forceinline__ float dpp_max16(float v) {
    v = fmaxf(v, __builtin_bit_cast(float, __builtin_amdgcn_update_dpp(0, __builtin_bit_cast(int, v), 0xB1, 0xF, 0xF, false)));
    v = fmaxf(v, __builtin_bit_cast(float, __builtin_amdgcn_update_dpp(0, __builtin_bit_cast(int, v), 0x4E, 0xF, 0xF, false)));
    v = fmaxf(v, __builtin_bit_cast(float, __builtin_amdgcn_update_dpp(0, __builtin_bit_cast(int, v), 0x141, 0xF, 0xF, false)));
    v = fmaxf(v, __builtin_bit_cast(float, __builtin_amdgcn_update_dpp(0, __builtin_bit_cast(int, v), 0x140, 0xF, 0xF, false)));
    return v;
}
__device__ __forceinline__ float rdlane(float v, int l) { return __builtin_bit_cast(float, __builtin_amdgcn_readlane(__builtin_bit_cast(int, v), l)); }
__device__ __forceinline__ float wave_sum(float v) { v = dpp_add16(v); return (rdlane(v, 0) + rdlane(v, 16)) + (rdlane(v, 32) + rdlane(v, 48)); }
__device__ __forceinline__ float wave_max(float v) { v = dpp_max16(v); return fmaxf(fmaxf(rdlane(v, 0), rdlane(v, 16)), fmaxf(rdlane(v, 32), rdlane(v, 48))); }

__device__ __forceinline__ void p0_transpose_item(const float* W, int K, int N, bf16* WT, int row_add, LAS float* scr, int item, int lane, const float* kscale = nullptr) {
    const int nblk = N / 32, kb = item / nblk, nb = item % nblk, k0 = 64 * kb, n0 = 32 * nb;
#pragma unroll
    for (int i = 0; i < 32; ++i) { const int kk = 2 * i + (lane >> 5); const float wv = W[(size_t)(k0 + kk) * N + n0 + (lane & 31)]; scr[kk * 33 + (lane & 31)] = kscale ? wv * kscale[k0 + kk] : wv; }
    LDS_WAIT(); asm volatile("" ::: "memory");
    const int c = lane & 7;
#pragma unroll
    for (int j = 0; j < 4; ++j) { const int n = (lane >> 3) + 8 * j; const LAS float* s = scr + (8 * c) * 33 + n;
        v4u o; o.x = pk2(s[0 * 33], s[1 * 33]); o.y = pk2(s[2 * 33], s[3 * 33]); o.z = pk2(s[4 * 33], s[5 * 33]); o.w = pk2(s[6 * 33], s[7 * 33]);
        *(v4u*)(WT + (size_t)(row_add + n0 + n) * K + k0 + 8 * c) = o; }
    LDS_WAIT(); asm volatile("" ::: "memory");
}
__device__ __forceinline__ void rms_row_to_bf16(const float* xrow, const float* g, bf16* orow, int lane) {
    const f32x4* xr = (const f32x4*)xrow + lane; const f32x4* gr = (const f32x4*)g + lane;
    f32x4 v[16]; float s = 0.f;
#pragma unroll
    for (int j = 0; j < 16; ++j) { v[j] = xr[64 * j]; s += (v[j].x * v[j].x + v[j].y * v[j].y) + (v[j].z * v[j].z + v[j].w * v[j].w); }
    const float rs = 1.0f / sqrtf(wave_sum(s) * (1.f / D_) + 1e-6f);
    v2u* o8 = (v2u*)orow + lane;
#pragma unroll
    for (int j = 0; j < 16; ++j) { const f32x4 gg = gr[64 * j]; v2u w; w.x = pk2(v[j].x * rs * gg.x, v[j].y * rs * gg.y); w.y = pk2(v[j].z * rs * gg.z, v[j].w * rs * gg.w); o8[64 * j] = w; }
}
__device__ __forceinline__ unsigned pk4_fp8(float a, float b, float c, float d) { int w = 0; w = __builtin_amdgcn_cvt_pk_fp8_f32(a, b, w, false); w = __builtin_amdgcn_cvt_pk_fp8_f32(c, d, w, true); return (unsigned)w; }
__device__ __forceinline__ void rms_row_to_fp8(const float* xrow, const float* g, unsigned char* orow, int lane) {
    const f32x4* xr = (const f32x4*)xrow + lane; const f32x4* gr = (const f32x4*)g + lane;
    f32x4 v[16]; float s = 0.f;
#pragma unroll
    for (int j = 0; j < 16; ++j) { v[j] = xr[64 * j]; s += (v[j].x * v[j].x + v[j].y * v[j].y) + (v[j].z * v[j].z + v[j].w * v[j].w); }
    const float rs = 16.0f / sqrtf(wave_sum(s) * (1.f / D_) + 1e-6f);
    unsigned* o4 = (unsigned*)orow + lane;
#pragma unroll
    for (int j = 0; j < 16; ++j) { const f32x4 gg = gr[64 * j]; o4[64 * j] = pk4_fp8(v[j].x * rs * gg.x, v[j].y * rs * gg.y, v[j].z * rs * gg.z, v[j].w * rs * gg.w); }
}
__device__ __forceinline__ void rms_row_to_both(const float* xrow, const float* g, bf16* orow, unsigned char* orow8, int lane) {
    const f32x4* xr = (const f32x4*)xrow + lane; const f32x4* gr = (const f32x4*)g + lane;
    f32x4 v[16]; float s = 0.f;
#pragma unroll
    for (int j = 0; j < 16; ++j) { v[j] = xr[64 * j]; s += (v[j].x * v[j].x + v[j].y * v[j].y) + (v[j].z * v[j].z + v[j].w * v[j].w); }
    const float rs = 1.0f / sqrtf(wave_sum(s) * (1.f / D_) + 1e-6f);
    unsigned* o4 = (unsigned*)orow8 + lane; (void)orow;
#pragma unroll
    for (int j = 0; j < 16; ++j) { const f32x4 y = v[j] * rs * gr[64 * j]; o4[64 * j] = pk4_fp8(y.x * 16.f, y.y * 16.f, y.z * 16.f, y.w * 16.f); }
}
__device__ __forceinline__ void p0_transpose_item_fp8(const float* W, int K, int N, unsigned char* WT, int row_add, LAS float* scr, int item, int lane) {
    const int nblk = N / 32, kb = item / nblk, nb = item % nblk, k0 = 64 * kb, n0 = 32 * nb;
#pragma unroll
    for (int i = 0; i < 32; ++i) { const int kk = 2 * i + (lane >> 5); scr[kk * 33 + (lane & 31)] = W[(size_t)(k0 + kk) * N + n0 + (lane & 31)]; }
    LDS_WAIT(); asm volatile("" ::: "memory");
    const int c = lane & 3;
#pragma unroll
    for (int j = 0; j < 2; ++j) { const int n = (lane >> 2) + 16 * j; const LAS float* s = scr + (16 * c) * 33 + n; v4u o;
        o.x = pk4_fp8(s[0 * 33] * 256.f, s[1 * 33] * 256.f, s[2 * 33] * 256.f, s[3 * 33] * 256.f); o.y = pk4_fp8(s[4 * 33] * 256.f, s[5 * 33] * 256.f, s[6 * 33] * 256.f, s[7 * 33] * 256.f);
        o.z = pk4_fp8(s[8 * 33] * 256.f, s[9 * 33] * 256.f, s[10 * 33] * 256.f, s[11 * 33] * 256.f); o.w = pk4_fp8(s[12 * 33] * 256.f, s[13 * 33] * 256.f, s[14 * 33] * 256.f, s[15 * 33] * 256.f);
        *(v4u*)(WT + (size_t)(row_add + n0 + n) * K + k0 + 16 * c) = o; }
    LDS_WAIT(); asm volatile("" ::: "memory");
}
__device__ __forceinline__ void cvt_straight(const float* src, bf16* dst, size_t n, size_t gt, size_t ngt) {
    for (size_t i = gt; i < n / 8; i += ngt) { const f32x4 a = ((const f32x4*)src)[2 * i], b = ((const f32x4*)src)[2 * i + 1];
        v4u o; o.x = pk2(a.x, a.y); o.y = pk2(a.z, a.w); o.z = pk2(b.x, b.y); o.w = pk2(b.z, b.w); ((v4u*)dst)[i] = o; }
}

__device__ __forceinline__ void quant_rows(const float* src, unsigned char* dst, float* scales, int nrows, int gw, int ngw, int lane) {
    for (int r = gw; r < nrows; r += ngw) {
        const f32x4* s4 = (const f32x4*)(src + (size_t)r * D_) + lane; f32x4 v[16]; float m = 0.f;
#pragma unroll
        for (int j = 0; j < 16; ++j) { v[j] = s4[64 * j]; m = fmaxf(fmaxf(m, fmaxf(fabsf(v[j].x), fabsf(v[j].y))), fmaxf(fabsf(v[j].z), fabsf(v[j].w))); }
        m = wave_max(m); const float inv = m > 0.f ? 127.0f / m : 0.f;
        unsigned* d4 = (unsigned*)(dst + (size_t)r * D_) + lane;
#pragma unroll
        for (int j = 0; j < 16; ++j) { const unsigned q0 = (unsigned)((int)rintf(v[j].x * inv) + 128), q1 = (unsigned)((int)rintf(v[j].y * inv) + 128), q2 = (unsigned)((int)rintf(v[j].z * inv) + 128), q3 = (unsigned)((int)rintf(v[j].w * inv) + 128);
            d4[64 * j] = q0 | (q1 << 8) | (q2 << 16) | (q3 << 24); }
        if (lane == 0) scales[r] = m * (1.0f / 127.0f);
    }
}
__device__ __forceinline__ unsigned fp6_code(float y) {
    const float a = fminf(fabsf(y), 7.5f);
    const int m = a < 2.0f ? (int)rintf(a * 8.0f) : (a < 4.0f ? 16 + (int)rintf((a - 2.0f) * 4.0f) : 24 + (int)rintf((a - 4.0f) * 2.0f));
    return (unsigned)m | (y < 0.f ? 32u : 0u);
}
__device__ __forceinline__ void quant_rows_fp6(const float* src, unsigned char* dst, float* scales, int nrows, int gw, int ngw, int lane) {
    for (int r = gw; r < nrows; r += ngw) {
        const f32x4* s4 = (const f32x4*)(src + (size_t)r * D_) + lane; f32x4 v[16]; float m = 0.f;
#pragma unroll
        for (int j = 0; j < 16; ++j) { v[j] = s4[64 * j]; m = fmaxf(fmaxf(m, fmaxf(fabsf(v[j].x), fabsf(v[j].y))), fmaxf(fabsf(v[j].z), fabsf(v[j].w))); }
        m = wave_max(m); const float inv = m > 0.f ? 7.5f / m : 0.f;
        const int k = lane & 3;
        unsigned* d4 = (unsigned*)(dst + (size_t)r * 3072) + ((lane >> 4) * 12 + ((lane & 15) >> 2) * 3 + k);
#pragma unroll
        for (int j = 0; j < 16; ++j) {
            const unsigned P = fp6_code(v[j].x * inv) | (fp6_code(v[j].y * inv) << 6) | (fp6_code(v[j].z * inv) << 12) | (fp6_code(v[j].w * inv) << 18);
            const unsigned P0 = (unsigned)__builtin_amdgcn_update_dpp(0, (int)P, 0x00, 0xF, 0xF, false), P1 = (unsigned)__builtin_amdgcn_update_dpp(0, (int)P, 0x55, 0xF, 0xF, false);
            const unsigned P2 = (unsigned)__builtin_amdgcn_update_dpp(0, (int)P, 0xAA, 0xF, 0xF, false), P3 = (unsigned)__builtin_amdgcn_update_dpp(0, (int)P, 0xFF, 0xF, 0xF, false);
            const unsigned d0 = P0 | (P1 << 24), d1 = (P1 >> 8) | (P2 << 16), d2 = (P2 >> 16) | (P3 << 8);
            if (k < 3) d4[48 * j] = k == 0 ? d0 : (k == 1 ? d1 : d2);
        }
        if (lane == 0) scales[r] = m * (1.0f / 7.5f);
    }
}
__device__ __forceinline__ void quant_rows4(const float* src, const float* cscale, unsigned char* dst, bf16* bscale, int nrows, int gw, int ngw, int lane) {
    for (int r = gw; r < nrows; r += ngw) {
        const f32x4* s4 = (const f32x4*)(src + (size_t)r * D_) + lane;
        unsigned* d4 = (unsigned*)(dst + (size_t)r * 128) + (lane >> 1);
        f32x4 vv[16];
#pragma unroll
        for (int j = 0; j < 16; ++j) vv[j] = s4[64 * j] * ((const f32x4*)cscale)[lane + 64 * j];
#pragma unroll
        for (int j = 0; j < 16; ++j) {
            const f32x4 v = vv[j];
            float m = fmaxf(fmaxf(fabsf(v.x), fabsf(v.y)), fmaxf(fabsf(v.z), fabsf(v.w)));
            m = fmaxf(m, __builtin_bit_cast(float, __builtin_amdgcn_update_dpp(0, __builtin_bit_cast(int, m), 0xB1, 0xF, 0xF, false)));
            m = fmaxf(m, __builtin_bit_cast(float, __builtin_amdgcn_update_dpp(0, __builtin_bit_cast(int, m), 0x4E, 0xF, 0xF, false)));
            m = fmaxf(m, __builtin_bit_cast(float, __builtin_amdgcn_update_dpp(0, __builtin_bit_cast(int, m), 0x141, 0xF, 0xF, false)));
            const unsigned sb = f2bf(m * (1.0f / 7.0f)); const float s = __uint_as_float(sb << 16); const float inv = s > 0.f ? 1.0f / s : 0.f;
            const int q0 = min(max((int)rintf(v.x * inv), -7), 7), q1 = min(max((int)rintf(v.y * inv), -7), 7), q2 = min(max((int)rintf(v.z * inv), -7), 7), q3 = min(max((int)rintf(v.w * inv), -7), 7);
            const unsigned P = (unsigned)(q0 + 8) | ((unsigned)(q1 + 8) << 8) | ((unsigned)(q2 + 8) << 16) | ((unsigned)(q3 + 8) << 24);
            const unsigned Q = (unsigned)__builtin_amdgcn_update_dpp(0, (int)P, 0xB1, 0xF, 0xF, false);
            if ((lane & 1) == 0) d4[(size_t)j * (16384 * 32)] = P | (Q << 4);
            if ((lane & 7) == 0) bscale[((size_t)j * 16384 + r) * 8 + (lane >> 3)] = (bf16)sb;
        }
    }
}
__device__ __forceinline__ void p0_prologue(Frame& F) {
    LAS float* scr = (LAS float*)(F.lds + F.wave * 16384);
    const float* w_in = F.in[2];
    constexpr int I_IN = (D_ / 64) * (IN_COLS / 32);
    for (int it = F.gw; it < I_IN; it += F.NGW) { const int n0 = (it % (IN_COLS / 32)) * 32;
        p0_transpose_item_fp8(w_in, D_, IN_COLS, F.ws + WS_WINT8, (n0 >= RWKV_COLS ? 128 : 0), scr, it, F.lane); }
    const size_t gt = (size_t)blockIdx.x * 512 + F.tid, ngt = (size_t)F.G * 512;
    { v4u* p = (v4u*)(F.ws + WS_WINT8 + (size_t)RWKV_COLS * D_); const v4u z = {0u, 0u, 0u, 0u}; for (size_t i = gt; i < (size_t)128 * D_ / 16; i += ngt) p[i] = z; }
    { bf16* LB = (bf16*)(F.ws + WS_LORABT); const float* w2 = F.in[5]; const float* a2 = F.in[7]; const float* g2 = F.in[8];
      for (size_t i = gt; i < (size_t)LORA_N * LORA_K; i += ngt) { const int row = (int)(i / LORA_K), col = (int)(i % LORA_K); const int seg = row >> 11, n = row & 2047; float v = 0.f;
          if (seg == 0 && col < 64) v = w2[(size_t)col * RW + n]; else if (seg == 1 && col >= 64 && col < 128) v = a2[(size_t)(col - 64) * RW + n]; else if (seg == 2 && col >= 128) v = g2[(size_t)(col - 128) * RW + n];
          LB[i] = (bf16)f2bf(v); } }
    for (int m = F.gw; m < S_; m += F.NGW) rms_row_to_both(F.in[0] + (size_t)m * D_, F.in[1], (bf16*)(F.ws + WS_XN) + (size_t)m * D_, F.ws + WS_XN8 + (size_t)m * D_, F.lane);
}

constexpr int QROWS_EARLY = 4096;
__device__ __forceinline__ void late_prep(Frame& F, int mgw, int mngw) {
    LAS float* scr = (LAS float*)(F.lds + F.wave * 16384);
    constexpr int I_PA = (RW / 64) * (D_ / 32), I_OUT = (D_ / 64) * (D_ / 32), I_Q = (D_ / 64) * (2048 / 32);
    for (int it = mgw; it < 2 * I_PA + I_OUT + I_Q; it += mngw) {
        int r = it;
        if (r < I_PA) { p0_transpose_item(F.in[14], RW, D_, (bf16*)(F.ws + WS_WPA), 0, scr, r, F.lane); continue; } r -= I_PA;
        if (r < I_PA) { p0_transpose_item_fp8(F.in[15], RW, D_, F.ws + WS_WPB, 0, scr, r, F.lane); continue; } r -= I_PA;
        if (r < I_OUT) { p0_transpose_item(F.in[16], D_, D_, (bf16*)(F.ws + WS_WOUT), 0, scr, r, F.lane); continue; } r -= I_OUT;
        p0_transpose_item(F.in[18], D_, 2048, (bf16*)(F.ws + WS_WQ), 0, scr, r, F.lane, F.in[17]);
    }
    quant_rows4(F.in[20], F.in[17], F.ws + WS_U8, (bf16*)(F.ws + WS_USC), PE, QROWS_EARLY + mgw, mngw, F.lane);
    quant_rows_fp6(F.in[21], F.ws + WS_V8, (float*)(F.ws + WS_VSC), PE, QROWS_EARLY + mgw, mngw, F.lane);
    cvt_straight(F.in[19], (bf16*)(F.ws + WS_SUBK), (size_t)16 * 128 * 128, (size_t)mgw * 64 + F.lane, (size_t)mngw * 64);
}

__device__ __forceinline__ void p2_prep(Frame& F) {
    const size_t gt = (size_t)blockIdx.x * 512 + F.tid, ngt = (size_t)F.G * 512;
    const bf16* ZR = (const bf16*)(F.ws + WS_ZR); const float* mu = F.in[3]; bf16* LA = (bf16*)(F.ws + WS_LORAA);
    for (size_t i = gt; i < (size_t)S_ * LORA_K; i += ngt) { const int t = (int)(i / LORA_K), c = (int)(i % LORA_K);
        const float zc = bf1(ZR[(size_t)t * ZR_LD + 6144 + c]), zp = t > 0 ? bf1(ZR[(size_t)(t - 1) * ZR_LD + 6144 + c]) : 0.f;
        const float zs = zc + (zp - zc) * mu[6144 + c];
        const float v = c < 64 ? tanhf(zs) : (c < 128 ? zs : sigmoidf_(zs));
        LA[i] = (bf16)f2bf(v); }
    const bf16* ZM = (const bf16*)(F.ws + WS_ZM); bf16* KMH = (bf16*)(F.ws + WS_KMEAN); bf16* KML = (bf16*)(F.ws + WS_KMEAN + 262144);
    LAS float* red = (LAS float*)F.lds;
    for (int item = blockIdx.x; item < MNB * 8; item += F.G) {
        const int j = item >> 3, cg = item & 7, col = cg * 256 + 4 * F.lane; f32x4 s = {0.f, 0.f, 0.f, 0.f};
        const bf16* zp = ZM + (size_t)(j * MBS + F.wave * 32) * ZM_LD + 2048 + col;
#pragma unroll 8
        for (int r = 0; r < 32; ++r) s += bf4(*(const v2u*)(zp + (size_t)r * ZM_LD));
        *(LAS f32x4*)(red + F.wave * 256 + 4 * F.lane) = s;
        __syncthreads();
        if (F.tid < 256) { float a = 0.f;
#pragma unroll
            for (int w = 0; w < 8; ++w) a += red[w * 256 + F.tid];
            a *= (1.0f / MBS); const int cc = cg * 256 + F.tid; const size_t o = ((size_t)(cc >> 7) * MNB + j) * MD + (cc & 127);
            const unsigned hi = f2bf(a); KMH[o] = (bf16)hi; KML[o] = (bf16)f2bf(a - __uint_as_float(hi << 16)); }
        __syncthreads();
    }
}

__device__ __forceinline__ void p4_rwkv_prep(Frame& F) {
    const bf16* ZR = (const bf16*)(F.ws + WS_ZR); const float* mu = F.in[3];
    const float* WDEC = (const float*)(F.ws + WS_WDEC); const bf16* ICLR = (const bf16*)(F.ws + WS_ICLR);
    const float* k_k = F.in[9]; const float* k_a = F.in[10]; const float* r_k = F.in[11];
    unsigned char* SC = F.ws + WS_SCAN; float* BC = (float*)(F.ws + WS_BC);
#pragma unroll 4
    for (int item = F.gw; item < S_ * 8; item += F.NGW) {
        const int t = item >> 3, hq = item & 7, c = hq * 256 + 4 * F.lane, h = hq * 4 + (F.lane >> 4), q = F.lane & 15;
        const bf16* zc = ZR + (size_t)t * ZR_LD + c; const bf16* zp = zc - ZR_LD;
        const f32x4 rc = bf4(*(const v2u*)zc), kc = bf4(*(const v2u*)(zc + 2048)), vc = bf4(*(const v2u*)(zc + 4096));
        f32x4 rp = {0.f, 0.f, 0.f, 0.f}, kp = rp, vp = rp;
        if (t > 0) { rp = bf4(*(const v2u*)zp); kp = bf4(*(const v2u*)(zp + 2048)); vp = bf4(*(const v2u*)(zp + 4096)); }
        const f32x4 r = rc + (rp - rc) * *(const f32x4*)(mu + c), k = kc + (kp - kc) * *(const f32x4*)(mu + 2048 + c), v = vc + (vp - vc) * *(const f32x4*)(mu + 4096 + c);
        const f32x4 iclr = bf4(*(const v2u*)(ICLR + (size_t)t * RW + c)), w = *(const f32x4*)(WDEC + (size_t)t * RW + c);
        f32x4 kk = k * *(const f32x4*)(k_k + c);
        const float ss = dpp_add16((kk.x * kk.x + kk.y * kk.y) + (kk.z * kk.z + kk.w * kk.w)); kk = kk * (1.0f / sqrtf(ss + 1e-12f));
        const f32x4 km = k * (1.0f + (iclr - 1.0f) * *(const f32x4*)(k_a + c));
        const f32x4 rkr = r * km * *(const f32x4*)(r_k + c);
        const float bc = dpp_add16((rkr.x + rkr.y) + (rkr.z + rkr.w));
        unsigned char* rec = SC + ((size_t)h * S_ + t) * SCAN_REC;
        *(f32x4*)(rec + 16 * q) = w;
        const f32x4 a = -kk, b = kk * iclr;
        *(v2u*)(rec + 256 + 8 * q) = (v2u){pk2(r.x, r.y), pk2(r.z, r.w)};
        *(v2u*)(rec + 384 + 8 * q) = (v2u){pk2(km.x, km.y), pk2(km.z, km.w)};
        *(v2u*)(rec + 512 + 8 * q) = (v2u){pk2(v.x, v.y), pk2(v.z, v.w)};
        *(v2u*)(rec + 640 + 8 * q) = (v2u){pk2(a.x, a.y), pk2(a.z, a.w)};
        *(v2u*)(rec + 768 + 8 * q) = (v2u){pk2(b.x, b.y), pk2(b.z, b.w)};
        if (q == 0) BC[t * RH + h] = bc;
    }
}

constexpr int SC_T = 32;
#define SCAN_ISSUE(c_) do { const unsigned char* g_ = src + (size_t)(c_) * SC_T * SCAN_REC; _Pragma("unroll") for (int i = 0; i < 7; ++i) sx[i] = *(const v4u*)(g_ + (size_t)(pt + 256 * i) * 16); } while (0)
#define SCAN_COMMIT(c_) do { LAS float* dst_ = inb + ((c_) & 1) * (SC_T * 384); \
    _Pragma("unroll") for (int i = 0; i < 7; ++i) { const int p_ = pt + 256 * i, s_ = p_ / 56, pi_ = p_ % 56; LAS float* d_ = dst_ + s_ * 384; \
        if (pi_ < 16) *(LAS v4u*)(d_ + pi_ * 4) = sx[i]; \
        else { LAS float* dd_ = d_ + 64 + (pi_ - 16) * 8; \
            *(LAS f32x4*)dd_ = (f32x4){bflo(sx[i].x), bfhi(sx[i].x), bflo(sx[i].y), bfhi(sx[i].y)}; *(LAS f32x4*)(dd_ + 4) = (f32x4){bflo(sx[i].z), bfhi(sx[i].z), bflo(sx[i].w), bfhi(sx[i].w)}; } } } while (0)
__device__ __forceinline__ void scan_flush_y(const LAS float* yb, float* Y, int c, int pt, int colbase) {
    const LAS float* s = yb + (c & 1) * (SC_T * 16);
#pragma unroll
    for (int i = 0; i < 2; ++i) { const int idx = pt + 256 * i, st = idx >> 4, rr = idx & 15; Y[(size_t)(c * SC_T + st) * RW + colbase + rr] = s[idx]; }
}
__device__ __forceinline__ void p5_scan_block(Frame& F, int sb) {
    const int h = sb >> 2, rg = sb & 3;
    LAS float* inb = (LAS float*)F.lds;
    LAS float* yb = (LAS float*)(F.lds + 98304);
    const unsigned char* src = F.ws + WS_SCAN + (size_t)h * S_ * SCAN_REC;
    float* Y = (float*)(F.ws + WS_Y);
    const int pt = F.tid - 256, colbase = h * 64 + rg * 16;
    constexpr int NCH = S_ / SC_T;
    v4u sx[7];
    if (F.wave >= 4) { SCAN_ISSUE(0); SCAN_COMMIT(0); SCAN_ISSUE(1); }
    __syncthreads();
    const int q = F.lane & 15, rloc = 4 * F.wave + (F.lane >> 4);
    const bool b0 = (q & 1) != 0, b1 = (q & 2) != 0, b2 = (q & 4) != 0, b3 = (q & 8) != 0;
    const int qidx = (b0 ? 8 : 0) | (b1 ? 4 : 0) | (b2 ? 2 : 0) | (b3 ? 1 : 0);
    f32x2 Sa = {0.f, 0.f}, Sb = {0.f, 0.f};
    for (int c = 0; c < NCH; ++c) {
        if (F.wave < 4) {
            const LAS float* p = inb + (c & 1) * (SC_T * 384) + 4 * q; LAS float* yo = yb + (c & 1) * (SC_T * 16) + rloc;
            const LAS float* pv = inb + (c & 1) * (SC_T * 384) + 192 + rg * 16 + rloc;
            f32x4 w4 = *(const LAS f32x4*)(p), r4 = *(const LAS f32x4*)(p + 64), k4 = *(const LAS f32x4*)(p + 128), a4 = *(const LAS f32x4*)(p + 256), b4 = *(const LAS f32x4*)(p + 320); float vv = pv[0];
            f32x4 w5 = *(const LAS f32x4*)(p + 384), r5 = *(const LAS f32x4*)(p + 384 + 64), k5 = *(const LAS f32x4*)(p + 384 + 128), a5 = *(const LAS f32x4*)(p + 384 + 256), b5 = *(const LAS f32x4*)(p + 384 + 320); float v5 = pv[384];
            float yp[16];
#pragma unroll
            for (int s = 0; s < SC_T; ++s) {
                f32x4 nw = w5, nr = r5, nk = k5, na = a5, nb = b5; float nv = v5;
                if (s + 2 < SC_T) { nw = *(const LAS f32x4*)(p + (s + 2) * 384); nr = *(const LAS f32x4*)(p + (s + 2) * 384 + 64); nk = *(const LAS f32x4*)(p + (s + 2) * 384 + 128);
                    na = *(const LAS f32x4*)(p + (s + 2) * 384 + 256); nb = *(const LAS f32x4*)(p + (s + 2) * 384 + 320); nv = pv[(s + 2) * 384]; }
                const f32x2 pa = Sa * a4.lo + Sb * a4.hi;
                float sa = pa.x + pa.y;
                const f32x2 ta = Sa * w4.lo + k4.lo * vv, tb = Sb * w4.hi + k4.hi * vv;
                sa = dpp_add16(sa);
                Sa = ta + b4.lo * sa; Sb = tb + b4.hi * sa;
                const f32x2 py = Sa * r4.lo + Sb * r4.hi;
                yp[s & 15] = py.x + py.y;
                if ((s & 15) == 15) {
#define SCAN_RS(N_, SEL_, CTRL_) _Pragma("unroll") for (int i = 0; i < (N_); ++i) { const float keep = (SEL_) ? yp[2 * i + 1] : yp[2 * i], send = (SEL_) ? yp[2 * i] : yp[2 * i + 1]; \
                        yp[i] = keep + __builtin_bit_cast(float, __builtin_amdgcn_update_dpp(0, __builtin_bit_cast(int, send), (CTRL_), 0xF, 0xF, false)); }
                    SCAN_RS(8, b3, 0x128) SCAN_RS(4, b2, 0x141) SCAN_RS(2, b1, 0x1B) SCAN_RS(1, b0, 0xB1)
#undef SCAN_RS
                    yo[((s & 16) + qidx) * 16] = yp[0];
                }
                w4 = w5; r4 = r5; k4 = k5; a4 = a5; b4 = b5; vv = v5; w5 = nw; r5 = nr; k5 = nk; a5 = na; b5 = nb; v5 = nv;
            }
        } else {
            if (c + 1 < NCH) SCAN_COMMIT(c + 1);
            if (c + 2 < NCH) SCAN_ISSUE(c + 2);
            if (c > 0) scan_flush_y(yb, Y, c - 1, pt, colbase);
        }
        __syncthreads();
    }
    if (F.wave >= 4) scan_flush_y(yb, Y, NCH - 1, pt, colbase);
}

__device__ __forceinline__ int moba_list_off(int j) { return 8192 * j - 128 * j * (j + 1); }
constexpr int MLIST_HEAD = 126976;
__device__ __forceinline__ int dpp_min16i(int v) {
    v = min(v, __builtin_amdgcn_update_dpp(0, v, 0xB1, 0xF, 0xF, false));
    v = min(v, __builtin_amdgcn_update_dpp(0, v, 0x4E, 0xF, 0xF, false));
    v = min(v, __builtin_amdgcn_update_dpp(0, v, 0x141, 0xF, 0xF, false));
    v = min(v, __builtin_amdgcn_update_dpp(0, v, 0x140, 0xF, 0xF, false));
    return v;
}
typedef short gbf16x8 __attribute__((ext_vector_type(8)));
__device__ __forceinline__ void p4_moba_gate(Frame& F) {
    const bf16* ZM = (const bf16*)(F.ws + WS_ZM); const bf16* KMH = (const bf16*)(F.ws + WS_KMEAN); const bf16* KML = (const bf16*)(F.ws + WS_KMEAN + 262144);
    unsigned* CNT = (unsigned*)(F.ws + WS_CTL) + CW_MCNT; int* LIST = (int*)(F.ws + WS_MLIST);
    const int g = F.lane >> 4, l15 = F.lane & 15;
    for (int item = F.gw + 16 * MH; item < (S_ / 16) * MH; item += F.NGW) {
        const int tile = item >> 4, h = item & 15, t0 = tile * 16, blk = t0 >> 8;
        f32x4 acc[2] = {{0.f, 0.f, 0.f, 0.f}, {0.f, 0.f, 0.f, 0.f}};
#pragma unroll
        for (int ks = 0; ks < 4; ++ks) { const gbf16x8 a = *(const gbf16x8*)(ZM + (size_t)(t0 + l15) * ZM_LD + h * MD + 32 * ks + 8 * g);
#pragma unroll
            for (int nt = 0; nt < 2; ++nt) { const size_t o = ((size_t)h * MNB + l15 + 16 * nt) * MD + 32 * ks + 8 * g;
                acc[nt] = __builtin_amdgcn_mfma_f32_16x16x32_bf16(a, *(const gbf16x8*)(KMH + o), acc[nt], 0, 0, 0);
                acc[nt] = __builtin_amdgcn_mfma_f32_16x16x32_bf16(a, *(const gbf16x8*)(KML + o), acc[nt], 0, 0, 0); } }
#pragma unroll
        for (int r4 = 0; r4 < 4; ++r4) {
            float s0 = l15 < blk ? acc[0][r4] : -INFINITY, s1 = l15 + 16 < blk ? acc[1][r4] : -INFINITY;
            const int t = t0 + 4 * g + r4;
#pragma unroll
            for (int r = 0; r < 3; ++r) { const float m = dpp_max16(fmaxf(s0, s1));
                const int jm = (s0 == m) ? l15 : ((s1 == m) ? l15 + 16 : 99); const int jw = dpp_min16i(jm);
                if (m > -INFINITY && jm == jw) { const unsigned pos = atomicAdd(&CNT[(h * 32 + jw) * 16], 1u); LIST[(size_t)h * MLIST_HEAD + moba_list_off(jw) + pos] = t * 4 + r;
                    if (jw < 16) s0 = -INFINITY; else s1 = -INFINITY; } }
        }
    }
}
__device__ __forceinline__ int moba_off(int row, int ch) { return 256 * row + 16 * (ch ^ (((row & 3) << 2) | ((row >> 2) & 3))); }
typedef short bf16x8 __attribute__((ext_vector_type(8)));
typedef short s16x4 __attribute__((ext_vector_type(4)));
__device__ __forceinline__ void p5_moba_units(Frame& F, int mb, int nmb) {
    const bf16* ZM = (const bf16*)(F.ws + WS_ZM);
    const unsigned* CNT = (const unsigned*)(F.ws + WS_CTL) + CW_MCNT; const int* LIST = (const int*)(F.ws + WS_MLIST);
    bf16* PO = (bf16*)(F.ws + WS_PARTO); float* PML = (float*)(F.ws + WS_PARTML);
    LAS unsigned char* kv = F.lds;
    LAS unsigned char* pw = F.lds + 65536 + F.wave * 8448;
    LAS int* pref = (LAS int*)(F.lds + 133120);
    LAS int* nchs = pref + 520;
    if (F.tid < 512) nchs[F.tid] = (int)((CNT[F.tid * 16] + 127u) >> 7);
    __syncthreads();
    if (F.tid < 512) { int s = 0; for (int i = 0; i < F.tid; ++i) s += nchs[i]; pref[F.tid] = s; if (F.tid == 511) pref[512] = s + nchs[511]; }
    __syncthreads();
    const int U = 1024 + pref[512];
    const int g = F.lane >> 4, l15 = F.lane & 15;
    const float scale = 0.08838834764831845f;
#define MOBA_DECODE(u_, h_, j_, qb_, cnt_, own_, lst_) do { \
        if ((u_) < 1024) { own_ = 1; h_ = (u_) >> 6; j_ = ((u_) >> 1) & 31; qb_ = ((u_) & 1) * 128; cnt_ = 256; lst_ = LIST; } \
        else { own_ = 0; const int v_ = (u_) - 1024; int lo_ = 0, hi_ = 512; \
            while (hi_ - lo_ > 1) { const int mid_ = (lo_ + hi_) >> 1; if (pref[mid_] <= v_) lo_ = mid_; else hi_ = mid_; } \
            lo_ = __builtin_amdgcn_readfirstlane(lo_); h_ = lo_ >> 5; j_ = lo_ & 31; qb_ = __builtin_amdgcn_readfirstlane((v_ - pref[lo_]) * 128); cnt_ = __builtin_amdgcn_readfirstlane((int)CNT[lo_ * 16]); \
            lst_ = LIST + (size_t)h_ * MLIST_HEAD + moba_list_off(j_); } } while (0)
#define MOBA_LOADQ() do { const int q0_ = qb + F.wave * 16; \
        if (own) entA = ((j * 256 + q0_ + l15) << 2) | 3; else entA = (q0_ + l15 < cnt) ? lst[q0_ + l15] : -1; \
        const int tokA_ = entA >= 0 ? (entA >> 2) : 0; \
        _Pragma("unroll") for (int ks = 0; ks < 4; ++ks) qa[ks] = *(const v4u*)(ZM + (size_t)tokA_ * ZM_LD + h * MD + 32 * ks + 8 * g); \
        _Pragma("unroll") for (int i = 0; i < 8; ++i) { const int idx = F.tid + 512 * i; kx[i] = *(const v4u*)(ZM + (size_t)(j * 256 + (idx >> 4)) * ZM_LD + 2048 + h * MD + (idx & 15) * 8); } } while (0)
    int h = 0, j = 0, qb = 0, cnt = 0, own = 0; const int* lst = LIST; int entA = -1; v4u qa[4], kx[8];
    int stg, krd[4], vrd[2][8];
    { const int r0 = F.tid >> 4, chs = F.tid & 15; stg = 256 * r0 + 16 * (chs ^ (((r0 & 3) << 2) | ((r0 >> 2) & 3)));
      const int fk = ((l15 & 3) << 2) | ((l15 >> 2) & 3);
#pragma unroll
      for (int ks = 0; ks < 4; ++ks) krd[ks] = 256 * l15 + 16 * ((4 * ks + g) ^ fk);
      const int tq = l15 >> 2, tp = l15 & 3;
#pragma unroll
      for (int t = 0; t < 2; ++t) { const int fr = (tq << 2) | ((2 * g + t) & 3);
#pragma unroll
          for (int cc = 0; cc < 8; ++cc) vrd[t][cc] = 256 * (8 * g + 4 * t + tq) + 16 * ((2 * cc + (tp >> 1)) ^ fr) + 8 * (tp & 1); } }
    if (mb < U) { MOBA_DECODE(mb, h, j, qb, cnt, own, lst); MOBA_LOADQ(); }
    for (int u = mb; u < U; u += nmb) {
        const int ch = h, cj = j, cown = own; const bool active = qb + F.wave * 16 < cnt;
#pragma unroll
        for (int i = 0; i < 8; ++i) *(LAS v4u*)(kv + stg + 8192 * i) = kx[i];
        __syncthreads();
        v4u vst[8];
#pragma unroll
        for (int i = 0; i < 8; ++i) { const int idx = F.tid + 512 * i; vst[i] = *(const v4u*)(ZM + (size_t)(cj * 256 + (idx >> 4)) * ZM_LD + 4096 + ch * MD + (idx & 15) * 8); }
        float mrow[4], lrow[4]; int entR[4];
#pragma unroll
        for (int r = 0; r < 4; ++r) entR[r] = __shfl(entA, 4 * g + r);
        if (active) {
            f32x4 sacc[16];
#pragma unroll
            for (int nt = 0; nt < 16; ++nt) { sacc[nt] = (f32x4){0.f, 0.f, 0.f, 0.f};
#pragma unroll
                for (int ks = 0; ks < 4; ++ks) { const bf16x8 b = *(const LAS bf16x8*)(kv + krd[ks] + 4096 * nt);
                    sacc[nt] = __builtin_amdgcn_mfma_f32_16x16x32_bf16(__builtin_bit_cast(bf16x8, qa[ks]), b, sacc[nt], 0, 0, 0); } }
#pragma unroll
            for (int r = 0; r < 4; ++r) { const int tokr = entR[r] >> 2; float mx = -INFINITY;
#pragma unroll
                for (int nt = 0; nt < 16; ++nt) { float s = sacc[nt][r] * scale; if (cown && (cj * 256 + 16 * nt + l15) > tokr) s = -INFINITY; sacc[nt][r] = s; mx = fmaxf(mx, s); }
                mx = dpp_max16(mx); mrow[r] = mx; float sum = 0.f;
#pragma unroll
                for (int nt = 0; nt < 16; ++nt) { const float p = __expf(sacc[nt][r] - mx); sum += p; *(LAS bf16*)(pw + (4 * g + r) * 528 + (16 * nt + l15) * 2) = (bf16)f2bf(p); }
                lrow[r] = dpp_add16(sum); }
        }
        __syncthreads();
#pragma unroll
        for (int i = 0; i < 8; ++i) *(LAS v4u*)(kv + stg + 8192 * i) = vst[i];
        if (u + nmb < U) { MOBA_DECODE(u + nmb, h, j, qb, cnt, own, lst); MOBA_LOADQ(); }
        __syncthreads();
        if (active) {
            f32x4 oacc[8];
#pragma unroll
            for (int c = 0; c < 8; ++c) oacc[c] = (f32x4){0.f, 0.f, 0.f, 0.f};
#pragma unroll
            for (int ks = 0; ks < 8; ++ks) { const bf16x8 a = *(const LAS bf16x8*)(pw + l15 * 528 + (32 * ks + 8 * g) * 2);
#pragma unroll
                for (int c = 0; c < 8; ++c) {
                    const s16x4 t0 = __builtin_amdgcn_ds_read_tr16_b64_v4i16((LAS s16x4*)(kv + vrd[0][c] + 8192 * ks));
                    const s16x4 t1 = __builtin_amdgcn_ds_read_tr16_b64_v4i16((LAS s16x4*)(kv + vrd[1][c] + 8192 * ks));
                    const bf16x8 b = {t0.x, t0.y, t0.z, t0.w, t1.x, t1.y, t1.z, t1.w};
                    oacc[c] = __builtin_amdgcn_mfma_f32_16x16x32_bf16(a, b, oacc[c], 0, 0, 0); } }
#pragma unroll
            for (int r = 0; r < 4; ++r) if (entR[r] >= 0) { const int tok = entR[r] >> 2, slot = entR[r] & 3; const size_t base = ((size_t)(tok * MH + ch) * 4 + slot); const float inv = 1.0f / lrow[r];
#pragma unroll
                for (int c = 0; c < 8; ++c) PO[base * MD + 16 * c + l15] = (bf16)f2bf(oacc[c][r] * inv);
                if (l15 == 0) { PML[base * 2] = mrow[r]; PML[base * 2 + 1] = lrow[r]; } }
        }
        __syncthreads();
    }
#undef MOBA_DECODE
#undef MOBA_LOADQ
}
__device__ __forceinline__ void p6_moba_combine(Frame& F) {
    const bf16* PO = (const bf16*)(F.ws + WS_PARTO); const float* PML = (const float*)(F.ws + WS_PARTML); bf16* YB = (bf16*)(F.ws + WS_YB);
    for (int t = F.gw; t < S_; t += F.NGW) {
        const int h = F.lane >> 2, dq = F.lane & 3, blk = t >> 8, nsel = blk < 3 ? blk : 3; const size_t base = (size_t)(t * MH + h) * 4;
        const f32x4 ml0 = *(const f32x4*)(PML + base * 2), ml1 = *(const f32x4*)(PML + base * 2 + 4);
        v4u x[4][4];
#pragma unroll
        for (int s = 0; s < 4; ++s)
#pragma unroll
            for (int k = 0; k < 4; ++k) x[s][k] = *(const v4u*)(PO + (base + s) * MD + dq * 32 + k * 8);
        const float ms[4] = {ml0.x, ml0.z, ml1.x, ml1.z}, ls[4] = {ml0.y, ml0.w, ml1.y, ml1.w};
        float M = ms[3];
#pragma unroll
        for (int s = 0; s < 3; ++s) if (s < nsel) M = fmaxf(M, ms[s]);
        float wsum = 0.f, w[4];
#pragma unroll
        for (int s = 0; s < 4; ++s) { w[s] = (s == 3 || s < nsel) ? __expf(ms[s] - M) * ls[s] : 0.f; wsum += w[s]; }
        const float inv = 1.0f / wsum;
#pragma unroll
        for (int k = 0; k < 4; ++k) { float o[8] = {0.f, 0.f, 0.f, 0.f, 0.f, 0.f, 0.f, 0.f};
#pragma unroll
            for (int s = 0; s < 4; ++s) if (s == 3 || s < nsel) { const v4u v = x[s][k]; o[0] += w[s] * bflo(v.x); o[1] += w[s] * bfhi(v.x); o[2] += w[s] * bflo(v.y); o[3] += w[s] * bfhi(v.y); o[4] += w[s] * bflo(v.z); o[5] += w[s] * bfhi(v.z); o[6] += w[s] * bflo(v.w); o[7] += w[s] * bfhi(v.w); }
            const float i16 = inv * 16.0f; *(v2u*)((unsigned char*)YB + (size_t)t * RW + h * MD + dq * 32 + k * 8) = (v2u){pk4_fp8(o[0] * i16, o[1] * i16, o[2] * i16, o[3] * i16), pk4_fp8(o[4] * i16, o[5] * i16, o[6] * i16, o[7] * i16)}; }
    }
}

__device__ __forceinline__ void p6_rwkv_post(Frame& F) {
    const float* Y = (const float*)(F.ws + WS_Y); const bf16* GG = (const bf16*)(F.ws + WS_GG); const float* BC = (const float*)(F.ws + WS_BC);
    const unsigned char* SC = F.ws + WS_SCAN; bf16* YA = (bf16*)(F.ws + WS_YA);
    const float* gn_w = F.in[12]; const float* gn_b = F.in[13];
#pragma unroll 4
    for (int item = F.gw; item < S_ * 8; item += F.NGW) {
        const int t = item >> 3, hq = item & 7, c = hq * 256 + 4 * F.lane, h = hq * 4 + (F.lane >> 4), q = F.lane & 15;
        const f32x4 y = *(const f32x4*)(Y + (size_t)t * RW + c);
        const float mean = dpp_add16((y.x + y.y) + (y.z + y.w)) * (1.f / 64.f); const f32x4 d = y - mean;
        const float var = dpp_add16((d.x * d.x + d.y * d.y) + (d.z * d.z + d.w * d.w)) * (1.f / 64.f);
        const f32x4 yn = d * (1.0f / sqrtf(var + 64e-5f)) * *(const f32x4*)(gn_w + c) + *(const f32x4*)(gn_b + c);
        const f32x4 v = bf4(*(const v2u*)(SC + ((size_t)h * S_ + t) * SCAN_REC + 512 + 8 * q));
        const f32x4 o = (yn + BC[t * RH + h] * v) * bf4(*(const v2u*)(GG + (size_t)t * RW + c));
        *(v2u*)(YA + (size_t)t * RW + c) = (v2u){pk2(o.x, o.y), pk2(o.z, o.w)};
    }
}

__device__ __forceinline__ void p9_norm(Frame& F) {
    for (int m = F.gw; m < S_; m += F.NGW) rms_row_to_bf16((const float*)(F.ws + WS_H1R) + (size_t)m * D_, F.in[17], (bf16*)(F.ws + WS_HN) + (size_t)m * D_, F.lane);
}

__device__ __forceinline__ float uniq_key(float s, int n) { return __uint_as_float((__float_as_uint(s) & ~0xffu) | (unsigned)(255 - n)); }
#define INS16(A_, X_) do { float x_ = (X_); _Pragma("unroll") for (int i_ = 0; i_ < 16; ++i_) { const float hi_ = fmaxf(A_[i_], x_); x_ = fminf(A_[i_], x_); A_[i_] = hi_; } } while (0)
__device__ __forceinline__ void p11_route(Frame& F) {
    const bf16* QRY = (const bf16*)(F.ws + WS_QRY); const bf16* SK = (const bf16*)(F.ws + WS_SUBK);
    int* PIDX = (int*)(F.ws + WS_PIDX); float* PGT = (float*)(F.ws + WS_PG);
    LAS float* sc = (LAS float*)(F.lds + F.wave * 16640);
    LAS int* ptab = (LAS int*)(F.lds + 8 * 16640);
    if (F.tid < 50) { const int l = F.tid; const int ci = l < 16 ? 0 : l < 24 ? 1 : l < 29 ? 2 : l < 33 ? 3 : l < 36 ? 4 : l < 38 ? 5 : l < 40 ? 6 : l < 42 ? 7 : l - 34;
        const int cj = l < 16 ? l : l < 24 ? l - 16 : l < 29 ? l - 24 : l < 33 ? l - 29 : l < 36 ? l - 33 : l < 38 ? l - 36 : l < 40 ? l - 38 : l < 42 ? l - 40 : 0; ptab[l] = ci * 16 + cj; }
    __syncthreads();
    const int g = F.lane >> 4, l15 = F.lane & 15;
    for (int item = F.gw; item < (S_ / 16) * PH; item += F.NGW) {
        const int tile = item >> 3, h = item & 7, t0 = tile * 16;
#pragma unroll
        for (int c = 0; c < 2; ++c) {
            f32x4 acc[8];
#pragma unroll
            for (int nt = 0; nt < 8; ++nt) acc[nt] = (f32x4){0.f, 0.f, 0.f, 0.f};
#pragma unroll
            for (int ks = 0; ks < 4; ++ks) { const gbf16x8 a = *(const gbf16x8*)(QRY + (size_t)(t0 + l15) * 2048 + h * 256 + c * 128 + 32 * ks + 8 * g);
#pragma unroll
                for (int nt = 0; nt < 8; ++nt) acc[nt] = __builtin_amdgcn_mfma_f32_16x16x32_bf16(a, *(const gbf16x8*)(SK + ((size_t)(h * 2 + c) * PNK + 16 * nt + l15) * 128 + 32 * ks + 8 * g), acc[nt], 0, 0, 0); }
#pragma unroll
            for (int nt = 0; nt < 8; ++nt)
#pragma unroll
                for (int r = 0; r < 4; ++r) sc[(c * 16 + 4 * g + r) * 129 + 16 * nt + l15] = acc[nt][r];
        }
        if (F.lane < 32) {
            LAS float* row = sc + F.lane * 129; float a[16];
#pragma unroll
            for (int i = 0; i < 16; ++i) a[i] = -INFINITY;
#pragma unroll 4
            for (int n = 0; n < PNK; ++n) INS16(a, uniq_key(row[n], n));
            float tv[16]; int ti[16];
#pragma unroll
            for (int i = 0; i < 16; ++i) { ti[i] = 255 - (int)(__float_as_uint(a[i]) & 255u); tv[i] = row[ti[i]]; }
#pragma unroll
            for (int i = 0; i < 16; ++i) { row[i] = tv[i]; row[16 + i] = __int_as_float(ti[i]); }
        }
        if (F.lane < 16) {
            const LAS float* r0 = sc + F.lane * 129; const LAS float* r1 = sc + (16 + F.lane) * 129;
            float v0[16], v1[16];
#pragma unroll
            for (int i = 0; i < 16; ++i) { v0[i] = r0[i]; v1[i] = r1[i]; }
            float b[16];
#pragma unroll
            for (int i = 0; i < 16; ++i) b[i] = -INFINITY;
            { int p = 0;
#pragma unroll
              for (int i = 0; i < 16; ++i)
#pragma unroll
                  for (int j = 0; j < 16; ++j) if ((i + 1) * (j + 1) <= 16) { INS16(b, uniq_key(v0[i] + v1[j], p)); ++p; } }
            const int t = t0 + F.lane; float pv[16]; float den = 0.f; float mx = 0.f;
            float rsn; { const f32x4* pp = (const f32x4*)((const float*)(F.ws + WS_PSQ) + (size_t)t * 64); float q = 0.f;
#pragma unroll
              for (int k = 0; k < 16; ++k) { const f32x4 a4 = pp[k]; q += (a4.x + a4.y) + (a4.z + a4.w); }
              rsn = 1.0f / sqrtf(q * (1.f / D_) + 1e-6f); }
#pragma unroll
            for (int r = 0; r < 16; ++r) { const int p = 255 - (int)(__float_as_uint(b[r]) & 255u); const int ij = ptab[p]; const int ii = ij >> 4, jj = ij & 15;
                const float val = r0[ii] + r1[jj]; if (r == 0) mx = val; pv[r] = __expf((val - mx) * rsn); den += pv[r];
                PIDX[(size_t)t * 128 + h * PT + r] = __float_as_int(r0[16 + ii]) * PNK + __float_as_int(r1[16 + jj]); }
            const float inv = 1.0f / den;
#pragma unroll
            for (int r = 0; r < 16; ++r) PGT[(size_t)t * 128 + h * PT + r] = pv[r] * inv;
        }
    }
    __syncthreads();
}
#undef INS16

__device__ __forceinline__ float gelu_erf(float v) {
    const float av = fabsf(v), tt = __builtin_amdgcn_rcpf(av * 0.2316418882f + 1.0f);
    float q = tt * 0.5307027145f + (-0.7265760135f); q = q * tt + 0.7107068705f; q = q * tt + (-0.142248368f); q = q * tt + 0.127414796f; q = q * tt;
    const float e = __builtin_amdgcn_exp2f((v * v) * (-0.72134752044f));
    const float m = v * (q * e); return v < 0.f ? m : v - m;
}
__device__ __forceinline__ void p12_peer(Frame& F) {
    const bf16* HN = (const bf16*)(F.ws + WS_HN);
    const unsigned char* U4 = F.ws + WS_U8; const unsigned short* USS = (const unsigned short*)(F.ws + WS_USC); const unsigned char* V8 = F.ws + WS_V8; const float* VSC = (const float*)(F.ws + WS_VSC);
    const int* PIDX = (const int*)(F.ws + WS_PIDX); const float* PGT = (const float*)(F.ws + WS_PG); const float* PSQ = (const float*)(F.ws + WS_PSQ);
    const float* lnf = F.in[22];
    LAS unsigned char* XQ = F.lds + F.wave * 17408;
    LAS unsigned short* EL = (LAS unsigned short*)(XQ + 16384);
    LAS float* WL = (LAS float*)XQ;
    const int g8 = F.lane >> 3, k8 = F.lane & 7;
    float sx[4];
#pragma unroll
    for (int i = 0; i < 4; ++i) {
        const int t = F.gw + i * F.NGW; v4u xp[8]; float mxa = 0.f;
#pragma unroll
        for (int j = 0; j < 8; ++j) { xp[j] = ((const v4u*)(HN + (size_t)t * D_))[F.lane + 64 * j];
            mxa = fmaxf(fmaxf(fmaxf(mxa, fmaxf(fabsf(bflo(xp[j].x)), fabsf(bfhi(xp[j].x)))), fmaxf(fabsf(bflo(xp[j].y)), fabsf(bfhi(xp[j].y)))), fmaxf(fmaxf(fabsf(bflo(xp[j].z)), fabsf(bfhi(xp[j].z))), fmaxf(fabsf(bflo(xp[j].w)), fabsf(bfhi(xp[j].w))))); }
        mxa = wave_max(mxa); const float inv = mxa > 0.f ? 127.0f / mxa : 0.f;
        const float rsn = 1.0f / sqrtf(wave_sum(PSQ[(size_t)t * 64 + F.lane]) * (1.f / D_) + 1e-6f);
        sx[i] = mxa * rsn * (1.0f / 127.0f);
#pragma unroll
        for (int j = 0; j < 8; ++j) {
            const int q0 = (int)rintf(bflo(xp[j].x) * inv), q1 = (int)rintf(bfhi(xp[j].x) * inv), q2 = (int)rintf(bflo(xp[j].y) * inv), q3 = (int)rintf(bfhi(xp[j].y) * inv);
            const int q4 = (int)rintf(bflo(xp[j].z) * inv), q5 = (int)rintf(bfhi(xp[j].z) * inv), q6 = (int)rintf(bflo(xp[j].w) * inv), q7 = (int)rintf(bfhi(xp[j].w) * inv);
            *(LAS v2u*)(XQ + i * 4096 + 8 * (F.lane + 64 * j)) = (v2u){(unsigned)((q0 & 0xff) | ((q1 & 0xff) << 8) | ((q2 & 0xff) << 16) | (q3 << 24)), (unsigned)((q4 & 0xff) | ((q5 & 0xff) << 8) | ((q6 & 0xff) << 16) | (q7 << 24))}; }
        EL[i * 128 + F.lane] = (unsigned short)PIDX[(size_t)t * 128 + F.lane]; EL[i * 128 + 64 + F.lane] = (unsigned short)PIDX[(size_t)t * 128 + 64 + F.lane];
        asm volatile("" ::: "memory");
    }
    LDS_WAIT(); asm volatile("" ::: "memory");
    float psum[4][16];
#pragma unroll
    for (int i = 0; i < 4; ++i)
#pragma unroll
        for (int b = 0; b < 16; ++b) psum[i][b] = 0.f;
#define P12_U4(W_, XA_, XB_, ACC_) do { ACC_ = __builtin_amdgcn_sdot4((int)((W_) & 0x0F0F0F0Fu), (int)(XA_), ACC_, false); ACC_ = __builtin_amdgcn_sdot4((int)(((W_) >> 4) & 0x0F0F0F0Fu), (int)(XB_), ACC_, false); } while (0)
#define P12_ISSUE(c_, i_, h_, CW_, SC_) do { _Pragma("unroll") for (int bb = 0; bb < 8; ++bb) { const unsigned ro = (unsigned)(c_) * 16384u + (unsigned)EL[(i_) * 128 + ((h_) * 8 + bb) * 8 + g8]; \
        CW_[bb] = *(const v4u*)(U4 + (size_t)(ro * 128u + 16u * (unsigned)k8)); SC_[bb] = USS[(size_t)(ro * 8u + (unsigned)k8)]; } } while (0)
#define P12_XQ(c_, i_) do { xa = *(const LAS v4u*)(XQ + (i_) * 4096 + 256 * (c_) + 32 * k8); xb = *(const LAS v4u*)(XQ + (i_) * 4096 + 256 * (c_) + 32 * k8 + 16); \
        int xs = __builtin_amdgcn_sdot4((int)xa.x, 0x01010101, 0, false); xs = __builtin_amdgcn_sdot4((int)xa.y, 0x01010101, xs, false); xs = __builtin_amdgcn_sdot4((int)xa.z, 0x01010101, xs, false); xs = __builtin_amdgcn_sdot4((int)xa.w, 0x01010101, xs, false); \
        xs = __builtin_amdgcn_sdot4((int)xb.x, 0x01010101, xs, false); xs = __builtin_amdgcn_sdot4((int)xb.y, 0x01010101, xs, false); xs = __builtin_amdgcn_sdot4((int)xb.z, 0x01010101, xs, false); xs = __builtin_amdgcn_sdot4((int)xb.w, 0x01010101, xs, false); \
        xo = 8 * xs; } while (0)
#define P12_COMP(i_, h_, CW_, SC_) do { _Pragma("unroll") for (int bb = 0; bb < 8; ++bb) { int a0 = 0, a1 = 0; P12_U4(CW_[bb].x, xa.x, xa.y, a0); P12_U4(CW_[bb].y, xa.z, xa.w, a1); P12_U4(CW_[bb].z, xb.x, xb.y, a0); P12_U4(CW_[bb].w, xb.z, xb.w, a1); \
        psum[(i_)][(h_) * 8 + bb] += __uint_as_float(SC_[bb] << 16) * (float)((a0 + a1) - xo); } } while (0)
#define P12_BAR() asm volatile("" ::: "memory")
    { v4u cwA[8], cwB[8]; unsigned scA[8], scB[8]; v4u xa, xb; int xo;
      P12_ISSUE(0, 0, 0, cwA, scA);
_Pragma("nounroll")
      for (int c = 0; c < 16; ++c) { const int cn = c + 1 < 16 ? c + 1 : 15;
          P12_XQ(c, 0); P12_ISSUE(c, 0, 1, cwB, scB); P12_BAR(); P12_COMP(0, 0, cwA, scA); P12_ISSUE(c, 1, 0, cwA, scA); P12_BAR(); P12_COMP(0, 1, cwB, scB);
          P12_XQ(c, 1); P12_ISSUE(c, 1, 1, cwB, scB); P12_BAR(); P12_COMP(1, 0, cwA, scA); P12_ISSUE(c, 2, 0, cwA, scA); P12_BAR(); P12_COMP(1, 1, cwB, scB);
          P12_XQ(c, 2); P12_ISSUE(c, 2, 1, cwB, scB); P12_BAR(); P12_COMP(2, 0, cwA, scA); P12_ISSUE(c, 3, 0, cwA, scA); P12_BAR(); P12_COMP(2, 1, cwB, scB);
          P12_XQ(c, 3); P12_ISSUE(c, 3, 1, cwB, scB); P12_BAR(); P12_COMP(3, 0, cwA, scA); P12_ISSUE(cn, 0, 0, cwA, scA); P12_BAR(); P12_COMP(3, 1, cwB, scB);
      } }
#undef P12_ISSUE
#undef P12_XQ
#undef P12_COMP
#undef P12_BAR
#undef P12_U4
    asm volatile("" ::: "memory"); LDS_WAIT();
#pragma unroll
    for (int i = 0; i < 4; ++i) { const int t = F.gw + i * F.NGW;
#pragma unroll
        for (int b = 0; b < 16; ++b) { float d = psum[i][b];
            d += __builtin_bit_cast(float, __builtin_amdgcn_update_dpp(0, __builtin_bit_cast(int, d), 0xB1, 0xF, 0xF, false));
            d += __builtin_bit_cast(float, __builtin_amdgcn_update_dpp(0, __builtin_bit_cast(int, d), 0x4E, 0xF, 0xF, false));
            d += __builtin_bit_cast(float, __builtin_amdgcn_update_dpp(0, __builtin_bit_cast(int, d), 0x141, 0xF, 0xF, false));
            const int idx = b * 8 + g8; const float w = PGT[(size_t)t * 128 + idx] * gelu_erf(sx[i] * d) * VSC[EL[i * 128 + idx]];
            if (k8 == 0) WL[i * 128 + idx] = w; } }
    asm volatile("" ::: "memory"); LDS_WAIT();
#define P12_EID(s_) __builtin_amdgcn_readlane((s_) < 64 ? e_lo : e_hi, (s_) & 63)
_Pragma("nounroll")
    for (int i = 0; i < 4; ++i) { const int t = F.gw + i * F.NGW;
        float acc[64];
#pragma unroll
        for (int k = 0; k < 64; ++k) acc[k] = 0.f;
        const int e_lo = PIDX[(size_t)t * 128 + F.lane], e_hi = PIDX[(size_t)t * 128 + 64 + F.lane];
        const float w_lo = WL[i * 128 + F.lane], w_hi = WL[i * 128 + 64 + F.lane];
        typedef unsigned v3u_ __attribute__((ext_vector_type(3)));
        v3u_ vb[4], n1[4], n2[4], n3[4], n4[4], n5[4];
#define P12_VLOAD(DST_, s_) do { const unsigned char* vp_ = V8 + (size_t)P12_EID(s_) * 3072 + 12 * F.lane; _Pragma("unroll") for (int j = 0; j < 4; ++j) DST_[j] = *(const v3u_*)(vp_ + 768 * j); } while (0)
        P12_VLOAD(vb, 0); P12_VLOAD(n1, 1); P12_VLOAD(n2, 2); P12_VLOAD(n3, 3); P12_VLOAD(n4, 4); P12_VLOAD(n5, 5);
        for (int s = 0; s < 128; ++s) {
            const int s4 = s + 6 < 128 ? s + 6 : 127;
            v3u_ mv_[4]; P12_VLOAD(mv_, s4);
            const float w = rdlane((s) < 64 ? w_lo : w_hi, (s) & 63);
            { typedef unsigned v6u_ __attribute__((ext_vector_type(6))); typedef float v32f_ __attribute__((ext_vector_type(32)));
              const v32f_ f0 = __builtin_amdgcn_cvt_scalef32_pk32_f32_fp6((v6u_){vb[0].x, vb[0].y, vb[0].z, vb[1].x, vb[1].y, vb[1].z}, 1.0f);
              const v32f_ f1 = __builtin_amdgcn_cvt_scalef32_pk32_f32_fp6((v6u_){vb[2].x, vb[2].y, vb[2].z, vb[3].x, vb[3].y, vb[3].z}, 1.0f);
#pragma unroll
              for (int q = 0; q < 32; ++q) { acc[q] += w * f0[q]; acc[32 + q] += w * f1[q]; } }
#pragma unroll
            for (int j = 0; j < 4; ++j) { vb[j] = n1[j]; n1[j] = n2[j]; n2[j] = n3[j]; n3[j] = n4[j]; n4[j] = n5[j]; n5[j] = mv_[j]; }
        }
#undef P12_VLOAD
        float ss = 0.f;
#pragma unroll
        for (int j = 0; j < 4; ++j) { const v4u* hp = (const v4u*)(HN + (size_t)t * D_ + 1024 * j + 16 * F.lane);
#pragma unroll
            for (int k = 0; k < 2; ++k) { const v4u a = hp[k]; const int o = 16 * j + 8 * k;
                acc[o + 0] += bflo(a.x); acc[o + 1] += bfhi(a.x); acc[o + 2] += bflo(a.y); acc[o + 3] += bfhi(a.y); acc[o + 4] += bflo(a.z); acc[o + 5] += bfhi(a.z); acc[o + 6] += bflo(a.w); acc[o + 7] += bfhi(a.w);
#pragma unroll
                for (int e = 0; e < 8; ++e) ss += acc[o + e] * acc[o + e]; } }
        const float rs = 1.0f / sqrtf(wave_sum(ss) * (1.f / D_) + 1e-6f);
#pragma unroll
        for (int j = 0; j < 4; ++j) { const f32x4* gp = (const f32x4*)(lnf + 1024 * j + 16 * F.lane); f32x4* op = (f32x4*)(F.out + (size_t)t * D_ + 1024 * j + 16 * F.lane);
#pragma unroll
            for (int k = 0; k < 4; ++k) { const f32x4 gn = gp[k]; const int o = 16 * j + 4 * k;
                op[k] = (f32x4){acc[o] * rs * gn.x, acc[o + 1] * rs * gn.y, acc[o + 2] * rs * gn.z, acc[o + 3] * rs * gn.w}; } }
    }
#undef P12_EID
}

struct Args { const float* in[23]; float* out; unsigned char* ws; int ph_lo, ph_hi, li, pad; };
__global__ void __launch_bounds__(NWAVES * 64, 2) mk_fwd(Args args) {
    extern __shared__ __attribute__((aligned(16))) unsigned char lds[];
    Frame F;
    F.lds = (LAS unsigned char*)lds;
    F.tid = threadIdx.x; F.lane = F.tid & 63; F.wave = __builtin_amdgcn_readfirstlane(F.tid >> 6);
    F.G = gridDim.x; F.gw = blockIdx.x * NWAVES + F.wave; F.NGW = F.G * NWAVES;
    F.in = args.in; F.out = args.out; F.ws = args.ws;
    volatile LAS unsigned* MISC = (volatile LAS unsigned*)(F.lds + MISC_OFF);
    for (int u = F.tid; u < (LDS_BYTES - LDSCTL_OFF) / 4; u += NWAVES * 64) ((LAS unsigned*)(F.lds + LDSCTL_OFF))[u] = 0u;
    __syncthreads();
    unsigned* ctl = (unsigned*)(F.ws + WS_CTL);
    XcdBarrier bar; bar.bar = ctl + CW_BAR + args.li * XCD_BAR_WORDS; bar.x = 0; bar.st = nullptr;
    const int lo = args.ph_lo, hi = args.ph_hi;
    if (hi - lo > 1) bar = xcd_barrier_post(ctl + CW_BAR + args.li * XCD_BAR_WORDS, MISC + 8);
#define IN(k) ((lo <= (k) && (k) < hi) && (F.lane = fresh_lane(), F.tid = F.wave * 64 + F.lane, true))
#ifndef PROBE_DUP
#define PROBE_DUP 0
#endif
#define REP(k) _Pragma("unroll") for (int _r = 0; _r < ((((PROBE_DUP) >> (k)) & 1) ? 2 : 1); ++_r)
#define SEAM(k) do { if (IN(k) && IN((k) + 1)) xcd_barrier(bar); } while (0)

    if (IN(0)) { REP(0) { p0_prologue(F); __syncthreads(); } SEAM(0); }
    if (IN(1)) REP(1) {
        { pg8::Gemm g{(const pg8::bf16_t*)(F.ws + WS_XN8), (const pg8::bf16_t*)(F.ws + WS_WINT8), S_, 20992, D_ / 2}; pg8::StaticOrder S; S.init(S_, 20992, F.G, (int)blockIdx.x);
          pg8::EpiZ E{(bf16*)(F.ws + WS_ZR), (bf16*)(F.ws + WS_ZM), (bf16*)(F.ws + WS_ZG), 0};
          pg8::gemm_phase<pg8::EpiZ, pg8::StaticOrder, PG8_ALIGN, PG8_SP2, true>(F.lds, g, S, E, F.wave); }
        __syncthreads();
        if (F.G == 256 && blockIdx.x >= 64) {
            F.lane = fresh_lane(); const int qw = ((int)blockIdx.x - 64) * NWAVES + F.wave, qn = 192 * NWAVES;
            quant_rows4(F.in[20], F.in[17], F.ws + WS_U8, (bf16*)(F.ws + WS_USC), QROWS_EARLY, qw, qn, F.lane);
            quant_rows_fp6(F.in[21], F.ws + WS_V8, (float*)(F.ws + WS_VSC), QROWS_EARLY, qw, qn, F.lane);
        } else if (F.G != 256 && blockIdx.x == 0) { for (int w = F.wave; w < NWAVES; w += NWAVES) { quant_rows4(F.in[20], F.in[17], F.ws + WS_U8, (bf16*)(F.ws + WS_USC), QROWS_EARLY, w, NWAVES, F.lane); quant_rows_fp6(F.in[21], F.ws + WS_V8, (float*)(F.ws + WS_VSC), QROWS_EARLY, w, NWAVES, F.lane); } }
    }
    SEAM(1);
    if (IN(2)) { REP(2) { p2_prep(F); } SEAM(2); }
    if (IN(3)) REP(3) {
        pg8::Gemm g{(const pg8::bf16_t*)(F.ws + WS_LORAA), (const pg8::bf16_t*)(F.ws + WS_LORABT), S_, LORA_N, LORA_K}; pg8::StaticOrder S; S.init(S_, LORA_N, F.G, (int)blockIdx.x);
        pg8::EpiLora E{(float*)(F.ws + WS_WDEC), (float*)(F.ws + WS_ICLR), (float*)(F.ws + WS_GG), F.in[4], F.in[6]};
        pg8::gemm_phase<pg8::EpiLora, pg8::StaticOrder, PG8_ALIGN, PG8_SP2>(F.lds, g, S, E, F.wave);
        __syncthreads();
    }
    SEAM(3);
    if (IN(4)) { REP(4) { p4_rwkv_prep(F); } p4_moba_gate(F); SEAM(4); }
    if (IN(5)) {
        if (F.G >= 256) { if (blockIdx.x < 128) { p5_scan_block(F, blockIdx.x);
#if PROBE_DUP & 0x10000
            __syncthreads(); p5_scan_block(F, blockIdx.x);
#endif
            } else { p5_moba_units(F, blockIdx.x - 128, F.G - 128); __syncthreads(); late_prep(F, (blockIdx.x - 128) * NWAVES + F.wave, (F.G - 128) * NWAVES);
#if PROBE_DUP & 0x20000
            __syncthreads(); p5_moba_units(F, blockIdx.x - 128, F.G - 128);
#endif
            } __syncthreads(); }
        SEAM(5);
    }
    if (IN(6)) { REP(6) { p6_rwkv_post(F); p6_moba_combine(F); } SEAM(6); }
    if (IN(7)) REP(7) {
        pg8::StaticOrder S; S.init(S_, D_, F.G, (int)blockIdx.x);
        { pg8::Gemm g{(const pg8::bf16_t*)(F.ws + WS_YA), (const pg8::bf16_t*)(F.ws + WS_WPA), S_, D_, RW};
          pg8::EpiGateMul E{(bf16*)(F.ws + WS_TMP), D_, (const bf16*)(F.ws + WS_ZG), ZG_LD};
          pg8::gemm_phase<pg8::EpiGateMul, pg8::StaticOrder, PG8_ALIGN, PG8_SP2>(F.lds, g, S, E, F.wave); }
        __syncthreads();
        { pg8::Gemm g{(const pg8::bf16_t*)(F.ws + WS_YB), (const pg8::bf16_t*)(F.ws + WS_WPB), S_, D_, RW / 2};
          pg8::EpiGateAdd E{(const bf16*)(F.ws + WS_TMP), D_, (const bf16*)(F.ws + WS_ZG) + 4096, ZG_LD, (bf16*)(F.ws + WS_MERGED)};
          pg8::gemm_phase<pg8::EpiGateAdd, pg8::StaticOrder, PG8_ALIGN, PG8_SP2, true>(F.lds, g, S, E, F.wave); }
        __syncthreads();
    }
    SEAM(7);
    if (IN(8)) REP(8) {
        pg8::Gemm g{(const pg8::bf16_t*)(F.ws + WS_MERGED), (const pg8::bf16_t*)(F.ws + WS_WOUT), S_, D_, D_}; pg8::StaticOrder S; S.init(S_, D_, F.G, (int)blockIdx.x);
        pg8::EpiResNorm E{F.in[0], D_, (bf16*)(F.ws + WS_HN), (float*)(F.ws + WS_PSQ)};
        pg8::gemm_phase<pg8::EpiResNorm, pg8::StaticOrder, PG8_ALIGN, PG8_SP2>(F.lds, g, S, E, F.wave);
        __syncthreads();
    }
    SEAM(8);
    if (IN(10)) REP(10) {
        pg8::Gemm g{(const pg8::bf16_t*)(F.ws + WS_HN), (const pg8::bf16_t*)(F.ws + WS_WQ), S_, 2048, D_}; pg8::StaticOrder S; S.init(S_, 2048, F.G, (int)blockIdx.x);
        pg8::EpiBf16 E{(bf16*)(F.ws + WS_QRY), 2048};
        pg8::gemm_phase<pg8::EpiBf16, pg8::StaticOrder, PG8_ALIGN, PG8_SP2>(F.lds, g, S, E, F.wave);
        __syncthreads();
    }
    SEAM(10);
    if (IN(11)) { REP(11) { p11_route(F); } SEAM(11); }
    if (IN(12)) { REP(12) { p12_peer(F); } }
#undef IN
#undef SEAM
}

extern "C" void kernel_launch(void* const* d_in, const int* in_sizes, int n_in, void* d_out, int out_size, void* d_ws, size_t ws_size, hipStream_t stream) {
    static int grid = 0;
    if (grid == 0) {
        if (n_in != 23 || out_size != S_ * D_ || ws_size < WS_END) { fprintf(stderr, "kernel_launch: unexpected shapes: n_in %d out %d ws %zu (need %zu)\n", n_in, out_size, ws_size, (size_t)WS_END); grid = -1; return; }
        int dev = 0, cus = 0, per_cu = 0;
        if (hipGetDevice(&dev) != hipSuccess || hipDeviceGetAttribute(&cus, hipDeviceAttributeMultiprocessorCount, dev) != hipSuccess) { grid = -1; return; }
        if (hipFuncSetAttribute((const void*)mk_fwd, hipFuncAttributeMaxDynamicSharedMemorySize, LDS_BYTES) != hipSuccess) { fprintf(stderr, "kernel_launch: hipFuncSetAttribute failed\n"); grid = -1; return; }
        if (hipOccupancyMaxActiveBlocksPerMultiprocessor(&per_cu, (const void*)mk_fwd, NWAVES * 64, LDS_BYTES) != hipSuccess || per_cu < 1) { fprintf(stderr, "kernel_launch: occupancy query reports %d\n", per_cu); }
        (void)hipGetLastError();
        grid = cus;
        if (grid != 256) fprintf(stderr, "kernel_launch: %d CUs (built for 256)\n", grid);
    }
    if (grid < 0) return;
    if (hipMemsetAsync((char*)d_ws + WS_CTL, 0, CTL_ZERO_BYTES, stream) != hipSuccess) return;
    Args a{};
    for (int i = 0; i < 23; ++i) a.in[i] = (const float*)d_in[i];
    a.out = (float*)d_out; a.ws = (unsigned char*)d_ws;
#if MK_N_LAUNCHES == 1
    a.ph_lo = 0; a.ph_hi = N_PHASES; a.li = 0;
    hipLaunchKernelGGL(mk_fwd, dim3(grid), dim3(NWAVES * 64), LDS_BYTES, stream, a);
#else
    for (int p = 0; p < N_PHASES; ++p) { a.ph_lo = p; a.ph_hi = p + 1; a.li = 0; hipLaunchKernelGGL(mk_fwd, dim3(grid), dim3(NWAVES * 64), LDS_BYTES, stream, a); }
#endif
}
```

```cpp
#include <hip/hip_runtime.h>
#include <cstdio>
#include <cstdint>
__device__ __forceinline__ int fresh_lane() { int l; asm volatile("v_mbcnt_lo_u32_b32 %0, -1, 0\n\tv_mbcnt_hi_u32_b32 %0, -1, %0" : "=v"(l)); return l; }
namespace pg8 {
#define PG8_LAS __attribute__((address_space(3)))
typedef unsigned short bf16_t;
typedef short bf16x8 __attribute__((ext_vector_type(8)));
typedef float f32x4 __attribute__((ext_vector_type(4)));
typedef unsigned u32x4 __attribute__((ext_vector_type(4)));
constexpr int BM = 256, BK = 64, HALF = 128, HTB = HALF * BK * 2  , STAGE_BYTES = 8 * HTB, NXCD = 8, WGM = 8;

__host__ __device__ __forceinline__ int lds_byte(int r, int c) { const int st = (r >> 4) * 2 + (c >> 5), rr = r & 15, cc = c & 31, ob = rr * 64 + cc * 2; return st * 1024 + (ob ^ (((ob >> 9) & 1) << 5)); }
__host__ __device__ __forceinline__ void stage_rc(int b, int& R, int& C) { const int st = b / 1024, sb = b % 1024, swz = sb ^ (((sb >> 9) & 1) << 5); R = (st >> 1) * 16 + swz / 64; C = (st & 1) * 32 + (swz % 64) / 2; }
__host__ __device__ __forceinline__ int perm32(int rho) { const int n = rho >> 4, i = rho & 15; return 8 * (i >> 2) + 4 * n + (i & 3); }

struct Unit { int pm, pn; };
struct Gemm { const bf16_t* A; const bf16_t* Bt; int M, N, K; };

struct StaticOrder {
    int nM, nN, nwg, G, c;
    __host__ __device__ void init(int M, int N, int G_, int c_) { nM = M / BM; nN = N / BM; nwg = nM * nN; G = G_; c = c_; }
    __host__ __device__ bool next(int i, Unit& u) const {
        const long L = (long)i * G + c; if (L >= nwg) return false;
        int wgid = (int)L; { const int q = nwg / NXCD, r = nwg % NXCD, xcd = wgid % NXCD, off = wgid / NXCD; wgid = (xcd < r ? xcd * (q + 1) : r * (q + 1) + (xcd - r) * q) + off; }
        const int nig = WGM * nN, gid = wgid / nig, fm = gid * WGM, gsz = (nM - fm) < WGM ? (nM - fm) : WGM;
        u.pm = fm + ((wgid % nig) % gsz); u.pn = (wgid % nig) / gsz; return true;
    }
    __device__ __forceinline__ void a_ready(const Unit&) const {}
    __device__ __forceinline__ void done(const Unit&) const {}
};


__device__ __forceinline__ unsigned cvt_pk_bf16(float lo, float hi) { unsigned r; asm volatile("v_cvt_pk_bf16_f32 %0, %1, %2" : "=v"(r) : "v"(lo), "v"(hi)); return r; }
typedef float f32x2 __attribute__((ext_vector_type(2)));
typedef unsigned u32x2 __attribute__((ext_vector_type(2)));
__device__ __forceinline__ float fast_sigmoid(float x) { return __builtin_amdgcn_rcpf(1.0f + __builtin_amdgcn_exp2f(-1.44269504089f * x)); }
__device__ __forceinline__ float bf_lo(unsigned w) { return __uint_as_float(w << 16); }
__device__ __forceinline__ float bf_hi(unsigned w) { return __uint_as_float(w & 0xffff0000u); }

struct EpiBf16 {
    static constexpr bool PERM = true, AFTER_DRAIN = false;
    bf16_t* O; int ldc;
    __device__ __forceinline__ void operator()(const f32x4 (&acc)[2][2][4][2], const Unit& u, int wr, int wc, int fr_, int fq_) const {
        const int l_ = fresh_lane(), fr = l_ & 15, fq = l_ >> 4;
        const int row0 = u.pm * BM + wr * 64 + fr, col0 = u.pn * BM + wc * 32 + 8 * fq;
#pragma unroll
        for (int ai = 0; ai < 2; ++ai)
#pragma unroll
            for (int m = 0; m < 4; ++m) { bf16_t* rowp = O + (size_t)(row0 + ai * HALF + m * 16) * ldc + col0;
#pragma unroll
                for (int bj = 0; bj < 2; ++bj) { const f32x4 v0 = acc[ai][bj][m][0], v1 = acc[ai][bj][m][1];
                    u32x4 w; w.x = cvt_pk_bf16(v0[0], v0[1]); w.y = cvt_pk_bf16(v0[2], v0[3]); w.z = cvt_pk_bf16(v1[0], v1[1]); w.w = cvt_pk_bf16(v1[2], v1[3]);
                    *(u32x4*)(rowp + bj * HALF) = w; } }
    }
};
struct EpiZ {
    static constexpr bool PERM = true, AFTER_DRAIN = false;
    bf16_t *ZR, *ZM, *ZG; int pn0;
    __device__ __forceinline__ void operator()(const f32x4 (&acc)[2][2][4][2], const Unit& u, int wr, int wc, int fr_, int fq_) const {
        const int l_ = fresh_lane(), fr = l_ & 15, fq = l_ >> 4;
        bf16_t* base; int ldc, colt; bool sig = false; const int pn = u.pn + pn0;
        if (pn < 26) { base = ZR; ldc = 6656; colt = pn * BM; }
        else if (pn < 50) { base = ZM; ldc = 6144; colt = (pn - 26) * BM; }
        else { base = ZG; ldc = 8192; colt = (pn - 50) * BM; sig = true; }
        const int row0 = u.pm * BM + wr * 64 + fr, col0 = colt + wc * 32 + 8 * fq;
#pragma unroll
        for (int ai = 0; ai < 2; ++ai)
#pragma unroll
            for (int m = 0; m < 4; ++m) { bf16_t* rowp = base + (size_t)(row0 + ai * HALF + m * 16) * ldc + col0;
#pragma unroll
                for (int bj = 0; bj < 2; ++bj) { f32x4 v0 = acc[ai][bj][m][0], v1 = acc[ai][bj][m][1];
                    if (sig) {
#pragma unroll
                        for (int j = 0; j < 4; ++j) { v0[j] = fast_sigmoid(v0[j]); v1[j] = fast_sigmoid(v1[j]); } }
                    u32x4 w; w.x = cvt_pk_bf16(v0[0], v0[1]); w.y = cvt_pk_bf16(v0[2], v0[3]); w.z = cvt_pk_bf16(v1[0], v1[1]); w.w = cvt_pk_bf16(v1[2], v1[3]);
                    *(u32x4*)(rowp + bj * HALF) = w; } }
    }
};
struct EpiLora {
    static constexpr bool PERM = false, AFTER_DRAIN = false;
    float *WDEC, *ICLR, *GG; const float *w0, *a0;
    __device__ __forceinline__ void operator()(const f32x4 (&acc)[2][2][4][2], const Unit& u, int wr, int wc, int fr_, int fq_) const {
        const int l_ = fresh_lane(), fr = l_ & 15, fq = l_ >> 4;
        const int mode = u.pn >> 3; float* base = WDEC + (size_t)mode * ((size_t)8192 * 2048);
        bf16_t* baseh = (bf16_t*)base;
        const int row0 = u.pm * BM + wr * 64 + fr, col0 = (u.pn & 7) * BM + wc * 32 + 4 * fq;
        const float* bp = mode == 0 ? w0 : a0;
#pragma unroll
        for (int ai = 0; ai < 2; ++ai)
#pragma unroll
            for (int m = 0; m < 4; ++m) { const size_t ro = (size_t)(row0 + ai * HALF + m * 16) * 2048 + col0;
#pragma unroll
                for (int bj = 0; bj < 2; ++bj)
#pragma unroll
                    for (int n = 0; n < 2; ++n) { f32x4 v = acc[ai][bj][m][n];
                        if (mode < 2) v += *(const f32x4*)(bp + col0 + bj * HALF + n * 16);
                        if (mode == 0) {
#pragma unroll
                            for (int j = 0; j < 4; ++j) { const float x = -v[j]; const float sp = fmaxf(x, 0.f) + __logf(1.0f + __expf(-fabsf(x))); v[j] = __expf(-__expf(-sp - 0.5f)); } }
                        else if (mode == 1) {
#pragma unroll
                            for (int j = 0; j < 4; ++j) v[j] = fast_sigmoid(v[j]); }
                        if (mode == 0) *(f32x4*)(base + ro + bj * HALF + n * 16) = v;
                        else { u32x2 w; w.x = cvt_pk_bf16(v[0], v[1]); w.y = cvt_pk_bf16(v[2], v[3]); *(u32x2*)(baseh + ro + bj * HALF + n * 16) = w; } }
                asm volatile("" ::: "memory"); }
    }
};
struct EpiGateMul {
    static constexpr bool PERM = false, AFTER_DRAIN = false;
    bf16_t* T; int ldc; const bf16_t* G; int ldg;
    __device__ __forceinline__ void operator()(const f32x4 (&acc)[2][2][4][2], const Unit& u, int wr, int wc, int fr_, int fq_) const {
        const int l_ = fresh_lane(), fr = l_ & 15, fq = l_ >> 4;
        const int row0 = u.pm * BM + wr * 64 + fr, col0 = u.pn * BM + wc * 32 + 4 * fq;
#pragma unroll
        for (int ai = 0; ai < 2; ++ai)
#pragma unroll
            for (int m = 0; m < 4; ++m) { const size_t r = (size_t)(row0 + ai * HALF + m * 16);
#pragma unroll
                for (int bj = 0; bj < 2; ++bj)
#pragma unroll
                    for (int n = 0; n < 2; ++n) { const u32x2 g = *(const u32x2*)(G + r * ldg + col0 + bj * HALF + n * 16); const f32x4 a = acc[ai][bj][m][n];
                        u32x2 w; w.x = cvt_pk_bf16(a[0] * bf_lo(g.x), a[1] * bf_hi(g.x)); w.y = cvt_pk_bf16(a[2] * bf_lo(g.y), a[3] * bf_hi(g.y)); *(u32x2*)(T + r * ldc + col0 + bj * HALF + n * 16) = w; } }
    }
};
struct EpiGateAdd {
    static constexpr bool PERM = false, AFTER_DRAIN = false;
    const bf16_t* T; int ldc; const bf16_t* G; int ldg; bf16_t* O;
    __device__ __forceinline__ void operator()(const f32x4 (&acc)[2][2][4][2], const Unit& u, int wr, int wc, int fr_, int fq_) const {
        const int l_ = fresh_lane(), fr = l_ & 15, fq = l_ >> 4;
        const int row0 = u.pm * BM + wr * 64 + fr, col0 = u.pn * BM + wc * 32 + 4 * fq;
#pragma unroll
        for (int ai = 0; ai < 2; ++ai)
#pragma unroll
            for (int m = 0; m < 4; ++m) { const size_t r = (size_t)(row0 + ai * HALF + m * 16);
#pragma unroll
                for (int bj = 0; bj < 2; ++bj)
#pragma unroll
                    for (int n = 0; n < 2; ++n) { const u32x2 g = *(const u32x2*)(G + r * ldg + col0 + bj * HALF + n * 16); const f32x4 a = acc[ai][bj][m][n];
                        const u32x2 t = *(const u32x2*)(T + r * ldc + col0 + bj * HALF + n * 16);
                        u32x2 w; w.x = cvt_pk_bf16(bf_lo(t.x) + a[0] * bf_lo(g.x), bf_hi(t.x) + a[1] * bf_hi(g.x)); w.y = cvt_pk_bf16(bf_lo(t.y) + a[2] * bf_lo(g.y), bf_hi(t.y) + a[3] * bf_hi(g.y));
                        *(u32x2*)(O + r * ldc + col0 + bj * HALF + n * 16) = w; }
                asm volatile("" ::: "memory"); }
    }
};
struct EpiRes {
    static constexpr bool PERM = false, AFTER_DRAIN = false;
    float* C; const float* R; int ldc;
    __device__ __forceinline__ void operator()(const f32x4 (&acc)[2][2][4][2], const Unit& u, int wr, int wc, int fr_, int fq_) const {
        const int l_ = fresh_lane(), fr = l_ & 15, fq = l_ >> 4;
        const int row0 = u.pm * BM + wr * 64 + fr, col0 = u.pn * BM + wc * 32 + 4 * fq;
#pragma unroll
        for (int ai = 0; ai < 2; ++ai)
#pragma unroll
            for (int m = 0; m < 4; ++m) { const size_t r = (size_t)(row0 + ai * HALF + m * 16);
#pragma unroll
                for (int bj = 0; bj < 2; ++bj)
#pragma unroll
                    for (int n = 0; n < 2; ++n) { const size_t o = r * ldc + col0 + bj * HALF + n * 16; *(f32x4*)(C + o) = *(const f32x4*)(R + o) + acc[ai][bj][m][n]; } }
    }
};

struct EpiResNorm {
    static constexpr bool PERM = false, AFTER_DRAIN = false;
    const float* R; int ldc; bf16_t* HB; float* PSQ;
    __device__ __forceinline__ void operator()(const f32x4 (&acc)[2][2][4][2], const Unit& u, int wr, int wc, int fr_, int fq_) const {
        const int l_ = fresh_lane(), fr = l_ & 15, fq = l_ >> 4;
        const int row0 = u.pm * BM + wr * 64 + fr, col0 = u.pn * BM + wc * 32 + 4 * fq;
#pragma unroll
        for (int ai = 0; ai < 2; ++ai)
#pragma unroll
            for (int m = 0; m < 4; ++m) { const size_t r = (size_t)(row0 + ai * HALF + m * 16); float ss = 0.f;
#pragma unroll
                for (int bj = 0; bj < 2; ++bj)
#pragma unroll
                    for (int n = 0; n < 2; ++n) { const size_t o = r * ldc + col0 + bj * HALF + n * 16; const f32x4 c = *(const f32x4*)(R + o) + acc[ai][bj][m][n];
                        ss += (c[0] * c[0] + c[1] * c[1]) + (c[2] * c[2] + c[3] * c[3]);
                        u32x2 w; w.x = cvt_pk_bf16(c[0], c[1]); w.y = cvt_pk_bf16(c[2], c[3]); *(u32x2*)(HB + o) = w; }
                ss += __builtin_bit_cast(float, __builtin_amdgcn_ds_bpermute((l_ ^ 16) << 2, __builtin_bit_cast(int, ss)));
                ss += __builtin_bit_cast(float, __builtin_amdgcn_ds_bpermute((l_ ^ 32) << 2, __builtin_bit_cast(int, ss)));
                if (fq == 0) PSQ[r * 64 + u.pn * 4 + wc] = ss;
                asm volatile("" ::: "memory"); }
    }
};

typedef int i32x8 __attribute__((ext_vector_type(8)));
typedef int i32x4 __attribute__((ext_vector_type(4)));
template <class Epi, class Sched, bool ALIGN_EPI = false, bool SP2 = false, bool F8 = false>
__device__ __forceinline__ void gemm_phase(PG8_LAS unsigned char* lds, const Gemm g, const Sched& S, const Epi& E, int wid_) {
    const int wid = __builtin_amdgcn_readfirstlane(wid_), lane = fresh_lane(), tid = wid * 64 + lane, wr = wid >> 2, wc = wid & 3, fr = lane & 15, fq = lane >> 4;
    const int K = g.K, nt = K / BK;
    unsigned voffA, voffB;
    { int R, C; stage_rc(tid * 16, R, C); const int Rb = Epi::PERM ? ((R & ~31) + perm32(R & 31)) : R; voffA = (unsigned)(R * K + C) * 2u; voffB = (unsigned)(Rb * K + C) * 2u; }
    const size_t rstep64 = (size_t)64 * K * 2;
    const size_t kstep = (size_t)(BK * 2);
    const size_t hstep = (size_t)HALF * K * 2;
    const size_t tstep = 2 * hstep;
    const unsigned ldsw = (unsigned)wid * 1024u;
    const int aoff = lds_byte(wr * 64 + fr, fq * 8), boff = lds_byte(wc * 32 + fr, fq * 8);
#define PG8_SA(b, h) (((b) * 2 + (h)) * HTB)
#define PG8_SB(b, h) ((4 + (b) * 2 + (h)) * HTB)
#define PG8_STAGE(bufoff, gbase, voff) do { _Pragma("unroll") for (int _i = 0; _i < 2; ++_i) \
        __builtin_amdgcn_global_load_lds((const unsigned*)((const char*)(gbase) + _i * rstep64 + (voff)), (PG8_LAS unsigned*)(lds + (bufoff) + ldsw + _i * 8192), 16, 0, 0); } while (0)
#define PG8_LDA(dst, b, h) do { _Pragma("unroll") for (int m = 0; m < 4; ++m) { if constexpr (F8) { const i32x4 _lo = *(const PG8_LAS i32x4*)(lds + PG8_SA(b, h) + aoff + m * 2048), _hi = *(const PG8_LAS i32x4*)(lds + PG8_SA(b, h) + aoff + m * 2048 + 1024); dst##8[m] = __builtin_shufflevector(_lo, _hi, 0, 1, 2, 3, 4, 5, 6, 7); } \
        else { _Pragma("unroll") for (int k = 0; k < 2; ++k) dst[m][k] = *(const PG8_LAS bf16x8*)(lds + PG8_SA(b, h) + aoff + m * 2048 + k * 1024); } } } while (0)
#define PG8_LDB(dst, b, h) do { _Pragma("unroll") for (int n = 0; n < 2; ++n) { if constexpr (F8) { const i32x4 _lo = *(const PG8_LAS i32x4*)(lds + PG8_SB(b, h) + boff + n * 2048), _hi = *(const PG8_LAS i32x4*)(lds + PG8_SB(b, h) + boff + n * 2048 + 1024); dst##8[n] = __builtin_shufflevector(_lo, _hi, 0, 1, 2, 3, 4, 5, 6, 7); } \
        else { _Pragma("unroll") for (int k = 0; k < 2; ++k) dst[n][k] = *(const PG8_LAS bf16x8*)(lds + PG8_SB(b, h) + boff + n * 2048 + k * 1024); } } } while (0)
#define PG8_MMA(ai, bj, At, Bt) do { __builtin_amdgcn_s_setprio(1); _Pragma("unroll") for (int m = 0; m < 4; ++m) _Pragma("unroll") for (int n = 0; n < 2; ++n) { \
        if constexpr (F8) acc[ai][bj][m][n] = __builtin_amdgcn_mfma_scale_f32_16x16x128_f8f6f4(Bt##8[n], At##8[m], acc[ai][bj][m][n], 0, 0, 0, 0x7b77, 1, 0x7b77); \
        else { _Pragma("unroll") for (int k = 0; k < 2; ++k) acc[ai][bj][m][n] = __builtin_amdgcn_mfma_f32_16x16x32_bf16(Bt[n][k], At[m][k], acc[ai][bj][m][n], 0, 0, 0); } } __builtin_amdgcn_s_setprio(0); } while (0)
#define PG8_WAIT_V(n) asm volatile("s_waitcnt vmcnt(" #n ")" ::: "memory")
#define PG8_WAIT_L(n) asm volatile("s_waitcnt lgkmcnt(" #n ")" ::: "memory")
#define PG8_BAR __builtin_amdgcn_s_barrier()
#define PG8_SCHED __builtin_amdgcn_sched_barrier(0)
    Unit cur, nxt; int ui = 0;
    if (!S.next(0, cur)) return;
    f32x4 acc[2][2][4][2];
#pragma unroll
    for (int a = 0; a < 2; ++a)
#pragma unroll
        for (int b = 0; b < 2; ++b)
#pragma unroll
            for (int m = 0; m < 4; ++m)
#pragma unroll
                for (int n = 0; n < 2; ++n) acc[a][b][m][n] = (f32x4){0.f, 0.f, 0.f, 0.f};
    bf16x8 At[4][2], B0[2][2], B1[2][2]; i32x8 At8[4], B08[2], B18[2];
    const char* cA = (const char*)g.A + (size_t)cur.pm * tstep; const char* cB = (const char*)g.Bt + (size_t)cur.pn * tstep;
    S.a_ready(cur);
    if constexpr (SP2) {
        PG8_STAGE(PG8_SB(0, 0), cB, voffB); PG8_STAGE(PG8_SB(0, 1), cB + hstep, voffB); PG8_STAGE(PG8_SA(0, 0), cA, voffA); PG8_STAGE(PG8_SA(0, 1), cA + hstep, voffA);
        if (wr == 1) PG8_BAR;
        PG8_WAIT_V(2); PG8_BAR;
        PG8_STAGE(PG8_SB(1, 0), cB + kstep, voffB); PG8_STAGE(PG8_SA(1, 0), cA + kstep, voffA); PG8_STAGE(PG8_SB(1, 1), cB + hstep + kstep, voffB);
        PG8_WAIT_V(6); PG8_BAR;
    } else {
        PG8_STAGE(PG8_SB(0, 0), cB, voffB); PG8_STAGE(PG8_SA(0, 0), cA, voffA); PG8_STAGE(PG8_SB(0, 1), cB + hstep, voffB); PG8_STAGE(PG8_SA(0, 1), cA + hstep, voffA);
        if (wr == 1) PG8_BAR;
        PG8_WAIT_V(4); PG8_BAR;
        PG8_STAGE(PG8_SB(1, 0), cB + kstep, voffB); PG8_STAGE(PG8_SA(1, 0), cA + kstep, voffA); PG8_STAGE(PG8_SB(1, 1), cB + hstep + kstep, voffB);
        PG8_WAIT_V(6); PG8_BAR;
    }
    for (;;) {
        const bool has_next = S.next(ui + 1, nxt);
        const char* nA = has_next ? (const char*)g.A + (size_t)nxt.pm * tstep : cA; const char* nB = has_next ? (const char*)g.Bt + (size_t)nxt.pn * tstep : cB;
        for (int t = 0; t < nt; t += 2) {
            const bool last = (t == nt - 2);
            const char* a1 = cA + (size_t)(t + 1) * kstep;
            const char* a2 = last ? nA : cA + (size_t)(t + 2) * kstep; const char* b2 = last ? nB : cB + (size_t)(t + 2) * kstep;
            const char* a3 = a2 + kstep; const char* b3 = b2 + kstep;
            if (last && has_next) S.a_ready(nxt);
            if constexpr (SP2) {
            PG8_LDB(B0, 0, 0); PG8_LDB(B1, 0, 1); PG8_SCHED; PG8_LDA(At, 0, 0); PG8_STAGE(PG8_SA(1, 1), a1 + hstep, voffA);
            PG8_WAIT_V(8); PG8_WAIT_L(0); PG8_BAR; PG8_MMA(0, 0, At, B0); PG8_MMA(0, 1, At, B1); PG8_BAR; PG8_SCHED;
            PG8_LDA(At, 0, 1); PG8_STAGE(PG8_SB(0, 0), b2, voffB); PG8_STAGE(PG8_SB(0, 1), b2 + hstep, voffB); PG8_STAGE(PG8_SA(0, 0), a2, voffA);
            PG8_WAIT_V(8); PG8_WAIT_L(0); PG8_BAR; PG8_MMA(1, 0, At, B0); PG8_MMA(1, 1, At, B1); PG8_BAR; PG8_SCHED;
            PG8_LDB(B0, 1, 0); PG8_LDB(B1, 1, 1); PG8_SCHED; PG8_LDA(At, 1, 0); PG8_STAGE(PG8_SA(0, 1), a2 + hstep, voffA);
            PG8_WAIT_V(8); PG8_WAIT_L(0); PG8_BAR; PG8_MMA(0, 0, At, B0); PG8_MMA(0, 1, At, B1); PG8_BAR; PG8_SCHED;
            PG8_LDA(At, 1, 1); PG8_STAGE(PG8_SB(1, 0), b3, voffB); PG8_STAGE(PG8_SB(1, 1), b3 + hstep, voffB); PG8_STAGE(PG8_SA(1, 0), a3, voffA);
            PG8_WAIT_V(8); PG8_WAIT_L(0); PG8_BAR; PG8_MMA(1, 0, At, B0); PG8_MMA(1, 1, At, B1); PG8_BAR; PG8_SCHED;
            } else {
            PG8_LDB(B0, 0, 0); PG8_SCHED; PG8_LDA(At, 0, 0); PG8_STAGE(PG8_SA(1, 1), a1 + hstep, voffA);
            PG8_WAIT_L(8); PG8_BAR; PG8_WAIT_L(0); PG8_MMA(0, 0, At, B0); PG8_BAR; PG8_SCHED;
            PG8_LDB(B1, 0, 1); PG8_STAGE(PG8_SB(0, 0), b2, voffB);
            PG8_BAR; PG8_WAIT_L(0); PG8_MMA(0, 1, At, B1); PG8_BAR;
            PG8_LDA(At, 0, 1); PG8_STAGE(PG8_SA(0, 0), a2, voffA);
            PG8_BAR; PG8_WAIT_L(0); PG8_MMA(1, 0, At, B0); PG8_BAR; PG8_SCHED;
            PG8_STAGE(PG8_SB(0, 1), b2 + hstep, voffB);
            PG8_WAIT_V(6); PG8_BAR; PG8_MMA(1, 1, At, B1); PG8_BAR;
            PG8_LDB(B0, 1, 0); PG8_SCHED; PG8_LDA(At, 1, 0); PG8_STAGE(PG8_SA(0, 1), a2 + hstep, voffA);
            PG8_WAIT_L(8); PG8_BAR; PG8_WAIT_L(0); PG8_MMA(0, 0, At, B0); PG8_BAR; PG8_SCHED;
            PG8_LDB(B1, 1, 1); PG8_STAGE(PG8_SB(1, 0), b3, voffB);
            PG8_BAR; PG8_WAIT_L(0); PG8_MMA(0, 1, At, B1); PG8_BAR;
            PG8_LDA(At, 1, 1); PG8_STAGE(PG8_SA(1, 0), a3, voffA);
            PG8_BAR; PG8_WAIT_L(0); PG8_MMA(1, 0, At, B0); PG8_BAR; PG8_SCHED;
            PG8_STAGE(PG8_SB(1, 1), b3 + hstep, voffB);
            PG8_WAIT_V(6); PG8_BAR; PG8_MMA(1, 1, At, B1); PG8_BAR;
            }
        }
        if constexpr (ALIGN_EPI) { if (wr == 0) PG8_BAR; }
        if constexpr (!Epi::AFTER_DRAIN) { E(acc, cur, wr, wc, fr, fq); S.done(cur); }
        if (!has_next) break;
#pragma unroll
        for (int a = 0; a < 2; ++a)
#pragma unroll
            for (int b = 0; b < 2; ++b)
#pragma unroll
                for (int m = 0; m < 4; ++m)
#pragma unroll
                    for (int n = 0; n < 2; ++n) acc[a][b][m][n] = (f32x4){0.f, 0.f, 0.f, 0.f};
        cur = nxt; cA = nA; cB = nB; ++ui;
        if constexpr (ALIGN_EPI) { if (wr == 1) PG8_BAR; }
    }
    PG8_WAIT_V(0);
    if constexpr (!ALIGN_EPI) { if (wr == 0) PG8_BAR; }
    PG8_BAR;
    if constexpr (Epi::AFTER_DRAIN) { E.fused(acc, cur, wr, wc, fr, fq, lds, wid, lane); S.done(cur); }
#undef PG8_SA
#undef PG8_SB
#undef PG8_STAGE
#undef PG8_LDA
#undef PG8_LDB
#undef PG8_MMA
#undef PG8_WAIT_V
#undef PG8_WAIT_L
#undef PG8_BAR
#undef PG8_SCHED
}
}

#ifndef PG8_SP2
#define PG8_SP2 true
#endif
#ifndef PG8_ALIGN
#define PG8_ALIGN true
#endif

constexpr int S_ = 8192, D_ = 4096;
constexpr int RW = 2048, RH = 32, RN = 64;
constexpr int IN_COLS = 20864, RWKV_COLS = 6528;
constexpr int ZR_LD = 6656, ZM_LD = 6144, ZG_LD = 8192, ZN = ZR_LD + ZM_LD + ZG_LD;
constexpr int MH = 16, MD = 128, MBS = 256, MNB = 32;
constexpr int PH = 8, PNK = 128, PE = 16384, PT = 16;
constexpr int LORA_K = 384, LORA_N = 6144;
constexpr int SCAN_REC = 896;
constexpr int NWAVES = 8;
constexpr int N_PHASES = 13;
#ifndef MK_N_LAUNCHES
#define MK_N_LAUNCHES 1
#endif

constexpr size_t MiB = 1u << 20;
constexpr size_t WS_CTL = 0, CTL_ZERO_BYTES = 1 * MiB;
constexpr size_t WS_KMEAN = 1 * MiB;
constexpr size_t WS_SUBK = 2 * MiB;
constexpr size_t WS_LORABT = 3 * MiB;
constexpr size_t WS_LORAA = 8 * MiB;
constexpr size_t WS_PIDX = 14 * MiB;
constexpr size_t WS_PG = 18 * MiB;
constexpr size_t WS_BC = 22 * MiB;
constexpr size_t WS_WPA = 32 * MiB;
constexpr size_t WS_WPB = 48 * MiB;
constexpr size_t WS_WOUT = 64 * MiB;
constexpr size_t WS_WQ = 96 * MiB;
constexpr size_t WS_U8 = 112 * MiB;
constexpr size_t WS_V8 = 176 * MiB;
constexpr size_t WS_VSC = 240 * MiB;
constexpr size_t WS_USC = 244 * MiB;
constexpr size_t WS_PSQ = 8 * MiB;
constexpr size_t WS_WINT = 368 * MiB;
constexpr size_t WS_WINT8 = 368 * MiB;
constexpr size_t WS_XN8 = 476 * MiB;
constexpr size_t WS_XN = 532 * MiB;
constexpr size_t WS_WDEC = 432 * MiB;
constexpr size_t WS_ICLR = 496 * MiB;
constexpr size_t WS_GG = 560 * MiB;
constexpr size_t WS_PARTO = 432 * MiB;
constexpr size_t WS_PARTML = 692 * MiB;
constexpr size_t WS_MLIST = 23 * MiB;
constexpr size_t WS_YA = 368 * MiB;
constexpr size_t WS_YB = 400 * MiB;
constexpr size_t WS_HN8 = 368 * MiB;
constexpr size_t WS_HN = 564 * MiB;
constexpr size_t WS_ZR = 628 * MiB;
constexpr size_t WS_Y = 628 * MiB;
constexpr size_t WS_QRY = 692 * MiB;
constexpr size_t WS_ZM = 732 * MiB;
constexpr size_t WS_ZG = 828 * MiB;
constexpr size_t WS_SCAN = 956 * MiB;
constexpr size_t WS_TMP = 956 * MiB;
constexpr size_t WS_MERGED = 1084 * MiB;
constexpr size_t WS_END = 1180 * MiB;
constexpr size_t WS_H1R = 732 * MiB;

constexpr int CW_BAR = 4096;
constexpr int CW_MCNT = 16384;

constexpr int RING_BYTES = 131072;
constexpr int LDS_BYTES = 147456;
constexpr int LDSCTL_OFF = LDS_BYTES - 1024, MISC_OFF = LDSCTL_OFF + 320;

#define GAS __attribute__((address_space(1)))
#define LAS __attribute__((address_space(3)))
typedef unsigned short bf16;
typedef unsigned v4u __attribute__((ext_vector_type(4)));
typedef unsigned v2u __attribute__((ext_vector_type(2)));
typedef float f32x4 __attribute__((ext_vector_type(4)));
typedef float f32x2 __attribute__((ext_vector_type(2)));
typedef __bf16 bf2_t __attribute__((ext_vector_type(2)));
#define LDS_WAIT() asm volatile("s_waitcnt lgkmcnt(0)" ::: "memory")
#define VM_WAIT() asm volatile("s_waitcnt vmcnt(0)" ::: "memory")
__device__ __forceinline__ unsigned f2bf(float f) { unsigned u = __builtin_bit_cast(unsigned, f); return (u + 0x7fffu + ((u >> 16) & 1u)) >> 16; }
__device__ __forceinline__ unsigned pk2(float lo, float hi) { return f2bf(lo) | (f2bf(hi) << 16); }
__device__ __forceinline__ float bflo(unsigned w) { return __uint_as_float(w << 16); }
__device__ __forceinline__ float bfhi(unsigned w) { return __uint_as_float(w & 0xffff0000u); }
__device__ __forceinline__ f32x4 bf4(v2u w) { return (f32x4){bflo(w.x), bfhi(w.x), bflo(w.y), bfhi(w.y)}; }
__device__ __forceinline__ float bf1(bf16 h) { return __uint_as_float(((unsigned)h) << 16); }
__device__ __forceinline__ float dot2bf(unsigned a, unsigned b, float c) { return __builtin_amdgcn_fdot2_f32_bf16(__builtin_bit_cast(bf2_t, a), __builtin_bit_cast(bf2_t, b), c, false); }
__device__ __forceinline__ float sigmoidf_(float x) { return 1.0f / (1.0f + __expf(-x)); }

#define XB_TMO      128
#define XB_XCNT(j)  (256  + 64 * (j))
#define XB_XSUB(j)  (1280 + 64 * (j))
#define XB_XGEN(j)  (2304 + 64 * (j))
#define XB_TOP      3328
#define XB_TOPGEN   3392
#define XCD_BAR_WORDS 3456
#define XB_SPIN_CAP (1u << 18)
__device__ __forceinline__ unsigned xb_ld(unsigned* p)              { return __hip_atomic_load(p, __ATOMIC_RELAXED, __HIP_MEMORY_SCOPE_AGENT); }
__device__ __forceinline__ unsigned xb_add(unsigned* p, unsigned v) { return __hip_atomic_fetch_add(p, v, __ATOMIC_RELAXED, __HIP_MEMORY_SCOPE_AGENT); }
__device__ __forceinline__ unsigned xb_xcc_id() { return (unsigned)__builtin_amdgcn_s_getreg((3 << 11) | 20) & 0xFu; }
#define XB_SPIN(cond, bar) do { unsigned _sp = 0; while (cond) { __builtin_amdgcn_s_sleep(1); \
    if ((++_sp & 255u) == 0u) { if (xb_ld(&(bar)[XB_TMO])) break; if (_sp > XB_SPIN_CAP) { atomicAdd(&(bar)[XB_TMO], 1u); break; } } } } while (0)
struct XcdBarrier { unsigned* bar; unsigned x; volatile LAS unsigned* st; };
__device__ __forceinline__ XcdBarrier xcd_barrier_post(unsigned* bar, volatile LAS unsigned* st) {
    XcdBarrier b; b.bar = bar; b.x = xb_xcc_id(); b.st = st;
    if (threadIdx.x == 0) (void)xb_add(&bar[XB_XCNT(b.x)], 1u);
    return b;
}
__device__ __forceinline__ void xcd_barrier_complete(unsigned* bar, unsigned x, unsigned& nloc, unsigned& nx) {
    const unsigned G = gridDim.x * gridDim.y * gridDim.z;
    unsigned sum, cnt, mine, sp = 0u;
    for (;;) {
        sum = 0u; cnt = 0u; mine = 0u;
#pragma unroll
        for (unsigned j = 0; j < 16; ++j) { const unsigned c = xb_ld(&bar[XB_XCNT(j)]); sum += c; cnt += (c > 0u) ? 1u : 0u; mine = (j == x) ? c : mine; }
        if (sum == G) break;
        __builtin_amdgcn_s_sleep(1);
        if ((++sp & 255u) == 0u) { if (xb_ld(&bar[XB_TMO])) break; if (sp > XB_SPIN_CAP) { atomicAdd(&bar[XB_TMO], 1u); break; } }
    }
    nloc = mine > 0u ? mine : 1u; nx = cnt > 0u ? cnt : 1u;
}
__device__ __forceinline__ void xcd_barrier(const XcdBarrier& b) {
    asm volatile("s_waitcnt vmcnt(0)" ::: "memory");
    __syncthreads();
    if (threadIdx.x == 0) {
        unsigned* bar = b.bar;
        __builtin_amdgcn_s_waitcnt(0);
        unsigned nloc = b.st[0], nx = b.st[1];
        if (nloc == 0u) { xcd_barrier_complete(bar, b.x, nloc, nx); b.st[0] = nloc; b.st[1] = nx; }
        const unsigned old = xb_add(&bar[XB_XSUB(b.x)], 1u);
        const unsigned gen = old / nloc;
        if (old + 1u == (gen + 1u) * nloc) {
            __builtin_amdgcn_fence(__ATOMIC_RELEASE, "agent");
            asm volatile("s_waitcnt vmcnt(0)" ::: "memory");
            const unsigned og = xb_add(&bar[XB_TOP], 1u);
            const unsigned tg = og / nx;
            if (og + 1u == (tg + 1u) * nx) xb_add(&bar[XB_TOPGEN], 1u);
            else XB_SPIN(xb_ld(&bar[XB_TOPGEN]) == tg, bar);
            __builtin_amdgcn_fence(__ATOMIC_ACQUIRE, "agent");
            xb_add(&bar[XB_XGEN(b.x)], 1u);
            asm volatile("s_waitcnt vmcnt(0)" ::: "memory");
        } else {
            XB_SPIN(xb_ld(&bar[XB_XGEN(b.x)]) == gen, bar);
            __builtin_amdgcn_fence(__ATOMIC_ACQUIRE, "agent");
            asm volatile("s_waitcnt vmcnt(0)" ::: "memory");
        }
    }
    __syncthreads();
}

struct Frame {
    LAS unsigned char* lds;
    int tid, lane, wave, G, gw, NGW;
    const float* const* in;
    float* out;
    unsigned char* ws;
};
__device__ __forceinline__ float dpp_add16(float v) {
    v += __builtin_bit_cast(float, __builtin_amdgcn_update_dpp(0, __builtin_bit_cast(int, v), 0xB1, 0xF, 0xF, false));
    v += __builtin_bit_cast(float, __builtin_amdgcn_update_dpp(0, __builtin_bit_cast(int, v), 0x4E, 0xF, 0xF, false));
    v += __builtin_bit_cast(float, __builtin_amdgcn_update_dpp(0, __builtin_bit_cast(int, v), 0x141, 0xF, 0xF, false));
    v += __builtin_bit_cast(float, __builtin_amdgcn_update_dpp(0, __builtin_bit_cast(int, v), 0x140, 0xF, 0xF, false));
    return v;
}
__device__ __forceinline__ float dpp_max16(float v) {
    v = fmaxf(v, __builtin_bit_cast(float, __builtin_amdgcn_update_dpp(0, __builtin_bit_cast(int, v), 0xB1, 0xF, 0xF, false)));
    v = fmaxf(v, __builtin_bit_cast(float, __builtin_amdgcn_update_dpp(0, __builtin_bit_cast(int, v), 0x4E, 0xF, 0xF, false)));
    v = fmaxf(v, __builtin_bit_cast(float, __builtin_amdgcn_update_dpp(0, __builtin_bit_cast(int, v), 0x141, 0xF, 0xF, false)));
    v = fmaxf(v, __builtin_bit_cast(float, __builtin_amdgcn_update_dpp(0, __builtin_bit_cast(int, v), 0x140, 0xF, 0xF, false)));
    return v;
}
__device__ __forceinline__ float rdlane(float v, int l) { return __builtin_bit_cast(float, __builtin_amdgcn_readlane(__builtin_bit_cast(int, v), l)); }
__device__ __forceinline__ float wave_sum(float v) { v = dpp_add16(v); return (rdlane(v, 0) + rdlane(v, 16)) + (rdlane(v, 32) + rdlane(v, 48)); }
__device__ __forceinline__ float wave_max(float v) { v = dpp_max16(v); return fmaxf(fmaxf(rdlane(v, 0), rdlane(v, 16)), fmaxf(rdlane(v, 32), rdlane(v, 48))); }

__device__ __forceinline__ void p0_transpose_item(const float* W, int K, int N, bf16* WT, int row_add, LAS float* scr, int item, int lane, const float* kscale = nullptr) {
    const int nblk = N / 32, kb = item / nblk, nb = item % nblk, k0 = 64 * kb, n0 = 32 * nb;
#pragma unroll
    for (int i = 0; i < 32; ++i) { const int kk = 2 * i + (lane >> 5); const float wv = W[(size_t)(k0 + kk) * N + n0 + (lane & 31)]; scr[kk * 33 + (lane & 31)] = kscale ? wv * kscale[k0 + kk] : wv; }
    LDS_WAIT(); asm volatile("" ::: "memory");
    const int c = lane & 7;
#pragma unroll
    for (int j = 0; j < 4; ++j) { const int n = (lane >> 3) + 8 * j; const LAS float* s = scr + (8 * c) * 33 + n;
        v4u o; o.x = pk2(s[0 * 33], s[1 * 33]); o.y = pk2(s[2 * 33], s[3 * 33]); o.z = pk2(s[4 * 33], s[5 * 33]); o.w = pk2(s[6 * 33], s[7 * 33]);
        *(v4u*)(WT + (size_t)(row_add + n0 + n) * K + k0 + 8 * c) = o; }
    LDS_WAIT(); asm volatile("" ::: "memory");
}
__device__ __forceinline__ void rms_row_to_bf16(const float* xrow, const float* g, bf16* orow, int lane) {
    const f32x4* xr = (const f32x4*)xrow + lane; const f32x4* gr = (const f32x4*)g + lane;
    f32x4 v[16]; float s = 0.f;
#pragma unroll
    for (int j = 0; j < 16; ++j) { v[j] = xr[64 * j]; s += (v[j].x * v[j].x + v[j].y * v[j].y) + (v[j].z * v[j].z + v[j].w * v[j].w); }
    const float rs = 1.0f / sqrtf(wave_sum(s) * (1.f / D_) + 1e-6f);
    v2u* o8 = (v2u*)orow + lane;
#pragma unroll
    for (int j = 0; j < 16; ++j) { const f32x4 gg = gr[64 * j]; v2u w; w.x = pk2(v[j].x * rs * gg.x, v[j].y * rs * gg.y); w.y = pk2(v[j].z * rs * gg.z, v[j].w * rs * gg.w); o8[64 * j] = w; }
}
__device__ __forceinline__ unsigned pk4_fp8(float a, float b, float c, float d) { int w = 0; w = __builtin_amdgcn_cvt_pk_fp8_f32(a, b, w, false); w = __builtin_amdgcn_cvt_pk_fp8_f32(c, d, w, true); return (unsigned)w; }
__device__ __forceinline__ void rms_row_to_fp8(const float* xrow, const float* g, unsigned char* orow, int lane) {
    const f32x4* xr = (const f32x4*)xrow + lane; const f32x4* gr = (const f32x4*)g + lane;
    f32x4 v[16]; float s = 0.f;
#pragma unroll
    for (int j = 0; j < 16; ++j) { v[j] = xr[64 * j]; s += (v[j].x * v[j].x + v[j].y * v[j].y) + (v[j].z * v[j].z + v[j].w * v[j].w); }
    const float rs = 16.0f / sqrtf(wave_sum(s) * (1.f / D_) + 1e-6f);
    unsigned* o4 = (unsigned*)orow + lane;
#pragma unroll
    for (int j = 0; j < 16; ++j) { const f32x4 gg = gr[64 * j]; o4[64 * j] = pk4_fp8(v[j].x * rs * gg.x, v[j].y * rs * gg.y, v[j].z * rs * gg.z, v[j].w * rs * gg.w); }
}
__device__ __forceinline__ void rms_row_to_both(const float* xrow, const float* g, bf16* orow, unsigned char* orow8, int lane) {
    const f32x4* xr = (const f32x4*)xrow + lane; const f32x4* gr = (const f32x4*)g + lane;
    f32x4 v[16]; float s = 0.f;
#pragma unroll
    for (int j = 0; j < 16; ++j) { v[j] = xr[64 * j]; s += (v[j].x * v[j].x + v[j].y * v[j].y) + (v[j].z * v[j].z + v[j].w * v[j].w); }
    const float rs = 1.0f / sqrtf(wave_sum(s) * (1.f / D_) + 1e-6f);
    unsigned* o4 = (unsigned*)orow8 + lane; (void)orow;
#pragma unroll
    for (int j = 0; j < 16; ++j) { const f32x4 y = v[j] * rs * gr[64 * j]; o4[64 * j] = pk4_fp8(y.x * 16.f, y.y * 16.f, y.z * 16.f, y.w * 16.f); }
}
__device__ __forceinline__ void p0_transpose_item_fp8(const float* W, int K, int N, unsigned char* WT, int row_add, LAS float* scr, int item, int lane) {
    const int nblk = N / 32, kb = item / nblk, nb = item % nblk, k0 = 64 * kb, n0 = 32 * nb;
#pragma unroll
    for (int i = 0; i < 32; ++i) { const int kk = 2 * i + (lane >> 5); scr[kk * 33 + (lane & 31)] = W[(size_t)(k0 + kk) * N + n0 + (lane & 31)]; }
    LDS_WAIT(); asm volatile("" ::: "memory");
    const int c = lane & 3;
#pragma unroll
    for (int j = 0; j < 2; ++j) { const int n = (lane >> 2) + 16 * j; const LAS float* s = scr + (16 * c) * 33 + n; v4u o;
        o.x = pk4_fp8(s[0 * 33] * 256.f, s[1 * 33] * 256.f, s[2 * 33] * 256.f, s[3 * 33] * 256.f); o.y = pk4_fp8(s[4 * 33] * 256.f, s[5 * 33] * 256.f, s[6 * 33] * 256.f, s[7 * 33] * 256.f);
        o.z = pk4_fp8(s[8 * 33] * 256.f, s[9 * 33] * 256.f, s[10 * 33] * 256.f, s[11 * 33] * 256.f); o.w = pk4_fp8(s[12 * 33] * 256.f, s[13 * 33] * 256.f, s[14 * 33] * 256.f, s[15 * 33] * 256.f);
        *(v4u*)(WT + (size_t)(row_add + n0 + n) * K + k0 + 16 * c) = o; }
    LDS_WAIT(); asm volatile("" ::: "memory");
}
template <bool FP8> __device__ __forceinline__ void transpose_stream(const float* W, int K, int N, void* WT_, int split, int add, int ldt, int col_add, LAS float* scr, int it0, int its, int nitems, int lane, const float* kscale) {
    const int nblk = N / 32; float cur[32];
    if (it0 < nitems) { const int kb = it0 / nblk, nb = it0 % nblk;
#pragma unroll
        for (int i = 0; i < 32; ++i) cur[i] = W[(size_t)(64 * kb + 2 * i + (lane >> 5)) * N + 32 * nb + (lane & 31)]; }
    for (int it = it0; it < nitems; it += its) {
        float nxt[32]; const int itn = it + its;
        if (itn < nitems) { const int kb = itn / nblk, nb = itn % nblk;
#pragma unroll
            for (int i = 0; i < 32; ++i) nxt[i] = W[(size_t)(64 * kb + 2 * i + (lane >> 5)) * N + 32 * nb + (lane & 31)]; }
        else {
#pragma unroll
            for (int i = 0; i < 32; ++i) nxt[i] = 0.f; }
        const int kb = it / nblk, nb = it % nblk, k0 = 64 * kb, n0 = 32 * nb;
#pragma unroll
        for (int i = 0; i < 32; ++i) { const int kk = 2 * i + (lane >> 5); scr[kk * 33 + (lane & 31)] = kscale ? cur[i] * kscale[k0 + kk] : cur[i]; }
        LDS_WAIT(); asm volatile("" ::: "memory");
        if (FP8) { unsigned char* WT = (unsigned char*)WT_; const int c = lane & 3, row_add = n0 >= split ? add : 0;
#pragma unroll
            for (int j = 0; j < 2; ++j) { const int n = (lane >> 2) + 16 * j; const LAS float* sp = scr + (16 * c) * 33 + n; v4u o;
                o.x = pk4_fp8(sp[0 * 33] * 256.f, sp[1 * 33] * 256.f, sp[2 * 33] * 256.f, sp[3 * 33] * 256.f); o.y = pk4_fp8(sp[4 * 33] * 256.f, sp[5 * 33] * 256.f, sp[6 * 33] * 256.f, sp[7 * 33] * 256.f);
                o.z = pk4_fp8(sp[8 * 33] * 256.f, sp[9 * 33] * 256.f, sp[10 * 33] * 256.f, sp[11 * 33] * 256.f); o.w = pk4_fp8(sp[12 * 33] * 256.f, sp[13 * 33] * 256.f, sp[14 * 33] * 256.f, sp[15 * 33] * 256.f);
                *(v4u*)(WT + (size_t)(row_add + n0 + n) * K + k0 + 16 * c) = o; } }
        else { bf16* WT = (bf16*)WT_; const int c = lane & 7;
#pragma unroll
            for (int j = 0; j < 4; ++j) { const int n = (lane >> 3) + 8 * j; const LAS float* sp = scr + (8 * c) * 33 + n;
                v4u o; o.x = pk2(sp[0 * 33], sp[1 * 33]); o.y = pk2(sp[2 * 33], sp[3 * 33]); o.z = pk2(sp[4 * 33], sp[5 * 33]); o.w = pk2(sp[6 * 33], sp[7 * 33]);
                *(v4u*)(WT + (size_t)(add + n0 + n) * ldt + col_add + k0 + 8 * c) = o; } }
        LDS_WAIT(); asm volatile("" ::: "memory");
#pragma unroll
        for (int i = 0; i < 32; ++i) cur[i] = nxt[i];
    }
}
__device__ __forceinline__ void cvt_straight(const float* src, bf16* dst, size_t n, size_t gt, size_t ngt) {
    for (size_t i = gt; i < n / 8; i += ngt) { const f32x4 a = ((const f32x4*)src)[2 * i], b = ((const f32x4*)src)[2 * i + 1];
        v4u o; o.x = pk2(a.x, a.y); o.y = pk2(a.z, a.w); o.z = pk2(b.x, b.y); o.w = pk2(b.z, b.w); ((v4u*)dst)[i] = o; }
}

__device__ __forceinline__ void quant_rows(const float* src, unsigned char* dst, float* scales, int nrows, int gw, int ngw, int lane) {
    for (int r = gw; r < nrows; r += ngw) {
        const f32x4* s4 = (const f32x4*)(src + (size_t)r * D_) + lane; f32x4 v[16]; float m = 0.f;
#pragma unroll
        for (int j = 0; j < 16; ++j) { v[j] = s4[64 * j]; m = fmaxf(fmaxf(m, fmaxf(fabsf(v[j].x), fabsf(v[j].y))), fmaxf(fabsf(v[j].z), fabsf(v[j].w))); }
        m = wave_max(m); const float inv = m > 0.f ? 127.0f / m : 0.f;
        unsigned* d4 = (unsigned*)(dst + (size_t)r * D_) + lane;
#pragma unroll
        for (int j = 0; j < 16; ++j) { const unsigned q0 = (unsigned)((int)rintf(v[j].x * inv) + 128), q1 = (unsigned)((int)rintf(v[j].y * inv) + 128), q2 = (unsigned)((int)rintf(v[j].z * inv) + 128), q3 = (unsigned)((int)rintf(v[j].w * inv) + 128);
            d4[64 * j] = q0 | (q1 << 8) | (q2 << 16) | (q3 << 24); }
        if (lane == 0) scales[r] = m * (1.0f / 127.0f);
    }
}
__device__ __forceinline__ unsigned fp6_code(float y) {
    const float a = fminf(fabsf(y), 7.5f);
    const int m = a < 2.0f ? (int)rintf(a * 8.0f) : (a < 4.0f ? 16 + (int)rintf((a - 2.0f) * 4.0f) : 24 + (int)rintf((a - 4.0f) * 2.0f));
    return (unsigned)m | (y < 0.f ? 32u : 0u);
}
__device__ __forceinline__ void quant_rows_fp6(const float* src, unsigned char* dst, float* scales, int nrows, int gw, int ngw, int lane) {
    for (int r = gw; r < nrows; r += ngw) {
        const f32x4* s4 = (const f32x4*)(src + (size_t)r * D_) + lane; f32x4 v[16]; float m = 0.f;
#pragma unroll
        for (int j = 0; j < 16; ++j) { v[j] = s4[64 * j]; m = fmaxf(fmaxf(m, fmaxf(fabsf(v[j].x), fabsf(v[j].y))), fmaxf(fabsf(v[j].z), fabsf(v[j].w))); }
        m = wave_max(m); const float inv = m > 0.f ? 7.5f / m : 0.f;
        const int k = lane & 3;
        unsigned* d4 = (unsigned*)(dst + (size_t)r * 192) + ((lane >> 4) * 12 + ((lane & 15) >> 2) * 3 + k);
#pragma unroll
        for (int j = 0; j < 16; ++j) {
            const unsigned P = fp6_code(v[j].x * inv) | (fp6_code(v[j].y * inv) << 6) | (fp6_code(v[j].z * inv) << 12) | (fp6_code(v[j].w * inv) << 18);
            const unsigned P0 = (unsigned)__builtin_amdgcn_update_dpp(0, (int)P, 0x00, 0xF, 0xF, false), P1 = (unsigned)__builtin_amdgcn_update_dpp(0, (int)P, 0x55, 0xF, 0xF, false);
            const unsigned P2 = (unsigned)__builtin_amdgcn_update_dpp(0, (int)P, 0xAA, 0xF, 0xF, false), P3 = (unsigned)__builtin_amdgcn_update_dpp(0, (int)P, 0xFF, 0xF, 0xF, false);
            const unsigned d0 = P0 | (P1 << 24), d1 = (P1 >> 8) | (P2 << 16), d2 = (P2 >> 16) | (P3 << 8);
            if (k < 3) d4[(size_t)j * (16384 * 48)] = k == 0 ? d0 : (k == 1 ? d1 : d2);
        }
        if (lane == 0) scales[r] = m * (1.0f / 7.5f);
    }
}
__device__ __forceinline__ void quant_rows4(const float* src, const float* cscale, unsigned char* dst, bf16* bscale, int nrows, int gw, int ngw, int lane) {
    for (int r = gw; r < nrows; r += ngw) {
        const f32x4* s4 = (const f32x4*)(src + (size_t)r * D_) + lane;
        unsigned* d4 = (unsigned*)(dst + (size_t)r * 128) + (lane >> 1);
        f32x4 vv[16];
#pragma unroll
        for (int j = 0; j < 16; ++j) vv[j] = s4[64 * j] * ((const f32x4*)cscale)[lane + 64 * j];
#pragma unroll
        for (int j = 0; j < 16; ++j) {
            const f32x4 v = vv[j];
            float m = fmaxf(fmaxf(fabsf(v.x), fabsf(v.y)), fmaxf(fabsf(v.z), fabsf(v.w)));
            m = fmaxf(m, __builtin_bit_cast(float, __builtin_amdgcn_update_dpp(0, __builtin_bit_cast(int, m), 0xB1, 0xF, 0xF, false)));
            m = fmaxf(m, __builtin_bit_cast(float, __builtin_amdgcn_update_dpp(0, __builtin_bit_cast(int, m), 0x4E, 0xF, 0xF, false)));
            m = fmaxf(m, __builtin_bit_cast(float, __builtin_amdgcn_update_dpp(0, __builtin_bit_cast(int, m), 0x141, 0xF, 0xF, false)));
            const unsigned sb = f2bf(m * (1.0f / 7.0f)); const float s = __uint_as_float(sb << 16); const float inv = s > 0.f ? 1.0f / s : 0.f;
            const int q0 = min(max((int)rintf(v.x * inv), -7), 7), q1 = min(max((int)rintf(v.y * inv), -7), 7), q2 = min(max((int)rintf(v.z * inv), -7), 7), q3 = min(max((int)rintf(v.w * inv), -7), 7);
            const unsigned P = (unsigned)(q0 + 8) | ((unsigned)(q1 + 8) << 8) | ((unsigned)(q2 + 8) << 16) | ((unsigned)(q3 + 8) << 24);
            const unsigned Q = (unsigned)__builtin_amdgcn_update_dpp(0, (int)P, 0xB1, 0xF, 0xF, false);
            if ((lane & 1) == 0) d4[(size_t)j * (16384 * 32)] = P | (Q << 4);
            if ((lane & 7) == 0) bscale[((size_t)j * 16384 + r) * 8 + (lane >> 3)] = (bf16)sb;
        }
    }
}
__device__ __forceinline__ void p0_prologue(Frame& F) {
    LAS float* scr = (LAS float*)(F.lds + F.wave * 16384);
    const float* w_in = F.in[2];
    constexpr int I_IN = (D_ / 64) * (IN_COLS / 32);
    transpose_stream<true>(w_in, D_, IN_COLS, F.ws + WS_WINT8, RWKV_COLS, 128, 0, 0, scr, F.gw, F.NGW, I_IN, F.lane, nullptr);
#if defined(PROBE_P0) && (PROBE_P0 & 1)
    transpose_stream<true>(w_in, D_, IN_COLS, F.ws + WS_WINT8, RWKV_COLS, 128, 0, 0, scr, F.gw, F.NGW, I_IN, F.lane, nullptr);
#endif
    const size_t gt = (size_t)blockIdx.x * 512 + F.tid, ngt = (size_t)F.G * 512;
    { v4u* p = (v4u*)(F.ws + WS_WINT8 + (size_t)RWKV_COLS * D_); const v4u z = {0u, 0u, 0u, 0u}; for (size_t i = gt; i < (size_t)128 * D_ / 16; i += ngt) p[i] = z; }
    { bf16* LB = (bf16*)(F.ws + WS_LORABT);
      transpose_stream<false>(F.in[5], 64, RW, LB, 0, 0, LORA_K, 0, scr, F.gw, F.NGW, 64, F.lane, nullptr);
      transpose_stream<false>(F.in[7], 64, RW, LB, 0, 2048, LORA_K, 64, scr, F.gw >= 64 ? F.gw - 64 : (1 << 30), F.NGW, 64, F.lane, nullptr);
      transpose_stream<false>(F.in[8], 256, RW, LB, 0, 4096, LORA_K, 128, scr, F.gw >= 128 ? F.gw - 128 : (1 << 30), F.NGW, 256, F.lane, nullptr);
      const v4u z = {0u, 0u, 0u, 0u};
      for (size_t i = gt; i < (size_t)LORA_N * (LORA_K / 8); i += ngt) { const int row = (int)(i / (LORA_K / 8)), g8c = (int)(i % (LORA_K / 8)) * 8, seg = row >> 11;
          const bool data = seg == 0 ? g8c < 64 : (seg == 1 ? (g8c >= 64 && g8c < 128) : g8c >= 128);
          if (!data) *(v4u*)(LB + (size_t)row * LORA_K + g8c) = z; } }
    for (int m = F.gw; m < S_; m += F.NGW) rms_row_to_both(F.in[0] + (size_t)m * D_, F.in[1], (bf16*)(F.ws + WS_XN) + (size_t)m * D_, F.ws + WS_XN8 + (size_t)m * D_, F.lane);
#if defined(PROBE_P0) && (PROBE_P0 & 2)
    for (int m = F.gw; m < S_; m += F.NGW) rms_row_to_both(F.in[0] + (size_t)m * D_, F.in[1], (bf16*)(F.ws + WS_XN) + (size_t)m * D_, F.ws + WS_XN8 + (size_t)m * D_, F.lane);
#endif
}

constexpr int QROWS_EARLY = 4096;
__device__ __forceinline__ void late_prep(Frame& F, int mgw, int mngw) {
    LAS float* scr = (LAS float*)(F.lds + F.wave * 16384);
    constexpr int I_PA = (RW / 64) * (D_ / 32), I_OUT = (D_ / 64) * (D_ / 32), I_Q = (D_ / 64) * (2048 / 32);
    transpose_stream<false>(F.in[14], RW, D_, F.ws + WS_WPA, 0, 0, RW, 0, scr, mgw, mngw, I_PA, F.lane, nullptr);
    transpose_stream<true>(F.in[15], RW, D_, F.ws + WS_WPB, 1 << 30, 0, 0, 0, scr, mgw, mngw, I_PA, F.lane, nullptr);
    transpose_stream<false>(F.in[16], D_, D_, F.ws + WS_WOUT, 0, 0, D_, 0, scr, mgw, mngw, I_OUT, F.lane, nullptr);
    transpose_stream<false>(F.in[18], D_, 2048, F.ws + WS_WQ, 0, 0, D_, 0, scr, mgw, mngw, I_Q, F.lane, F.in[17]);
    quant_rows4(F.in[20], F.in[17], F.ws + WS_U8, (bf16*)(F.ws + WS_USC), PE, QROWS_EARLY + mgw, mngw, F.lane);
    quant_rows_fp6(F.in[21], F.ws + WS_V8, (float*)(F.ws + WS_VSC), PE, QROWS_EARLY + mgw, mngw, F.lane);
    cvt_straight(F.in[19], (bf16*)(F.ws + WS_SUBK), (size_t)16 * 128 * 128, (size_t)mgw * 64 + F.lane, (size_t)mngw * 64);
}

__device__ __forceinline__ void p2_prep(Frame& F) {
    const size_t gt = (size_t)blockIdx.x * 512 + F.tid, ngt = (size_t)F.G * 512;
    const bf16* ZR = (const bf16*)(F.ws + WS_ZR); const float* mu = F.in[3]; bf16* LA = (bf16*)(F.ws + WS_LORAA);
    for (size_t i = gt; i < (size_t)S_ * LORA_K; i += ngt) { const int t = (int)(i / LORA_K), c = (int)(i % LORA_K);
        const float zc = bf1(ZR[(size_t)t * ZR_LD + 6144 + c]), zp = t > 0 ? bf1(ZR[(size_t)(t - 1) * ZR_LD + 6144 + c]) : 0.f;
        const float zs = zc + (zp - zc) * mu[6144 + c];
        const float v = c < 64 ? tanhf(zs) : (c < 128 ? zs : sigmoidf_(zs));
        LA[i] = (bf16)f2bf(v); }
    const bf16* ZM = (const bf16*)(F.ws + WS_ZM); bf16* KMH = (bf16*)(F.ws + WS_KMEAN); bf16* KML = (bf16*)(F.ws + WS_KMEAN + 262144);
    LAS float* red = (LAS float*)F.lds;
    for (int item = blockIdx.x; item < MNB * 8; item += F.G) {
        const int j = item >> 3, cg = item & 7, col = cg * 256 + 4 * F.lane; f32x4 s = {0.f, 0.f, 0.f, 0.f};
        const bf16* zp = ZM + (size_t)(j * MBS + F.wave * 32) * ZM_LD + 2048 + col;
#pragma unroll 8
        for (int r = 0; r < 32; ++r) s += bf4(*(const v2u*)(zp + (size_t)r * ZM_LD));
        *(LAS f32x4*)(red + F.wave * 256 + 4 * F.lane) = s;
        __syncthreads();
        if (F.tid < 256) { float a = 0.f;
#pragma unroll
            for (int w = 0; w < 8; ++w) a += red[w * 256 + F.tid];
            a *= (1.0f / MBS); const int cc = cg * 256 + F.tid; const size_t o = ((size_t)(cc >> 7) * MNB + j) * MD + (cc & 127);
            const unsigned hi = f2bf(a); KMH[o] = (bf16)hi; KML[o] = (bf16)f2bf(a - __uint_as_float(hi << 16)); }
        __syncthreads();
    }
}

__device__ __forceinline__ void p4_rwkv_prep(Frame& F) {
    const bf16* ZR = (const bf16*)(F.ws + WS_ZR); const float* mu = F.in[3];
    const float* WDEC = (const float*)(F.ws + WS_WDEC); const bf16* ICLR = (const bf16*)(F.ws + WS_ICLR);
    const float* k_k = F.in[9]; const float* k_a = F.in[10]; const float* r_k = F.in[11];
    unsigned char* SC = F.ws + WS_SCAN; float* BC = (float*)(F.ws + WS_BC);
    const int hq = F.gw & 7, c = hq * 256 + 4 * F.lane, h = hq * 4 + (F.lane >> 4), q = F.lane & 15, tstep = F.NGW >> 3;
    const f32x4 mur = *(const f32x4*)(mu + c), muk = *(const f32x4*)(mu + 2048 + c), muv = *(const f32x4*)(mu + 4096 + c), kk4 = *(const f32x4*)(k_k + c), ka4 = *(const f32x4*)(k_a + c), rk4 = *(const f32x4*)(r_k + c);
    for (int tb = F.gw >> 3; tb < S_; tb += 4 * tstep) {
        v2u zcr[4], zck[4], zcv[4], zpr[4], zpk[4], zpv[4], ic[4]; f32x4 wd[4];
#pragma unroll
        for (int k = 0; k < 4; ++k) { const int t = tb + k * tstep; const v2u z0 = {0u, 0u};
            zcr[k] = zck[k] = zcv[k] = zpr[k] = zpk[k] = zpv[k] = ic[k] = z0; wd[k] = (f32x4){0.f, 0.f, 0.f, 0.f};
            if (t < S_) { const bf16* zc = ZR + (size_t)t * ZR_LD + c;
                zcr[k] = *(const v2u*)zc; zck[k] = *(const v2u*)(zc + 2048); zcv[k] = *(const v2u*)(zc + 4096);
                if (t > 0) { const bf16* zp = zc - ZR_LD; zpr[k] = *(const v2u*)zp; zpk[k] = *(const v2u*)(zp + 2048); zpv[k] = *(const v2u*)(zp + 4096); }
                ic[k] = *(const v2u*)(ICLR + (size_t)t * RW + c); wd[k] = *(const f32x4*)(WDEC + (size_t)t * RW + c); } }
#pragma unroll
        for (int k = 0; k < 4; ++k) { const int t = tb + k * tstep;
            if (t < S_) {
                const f32x4 rc = bf4(zcr[k]), kc = bf4(zck[k]), vc = bf4(zcv[k]);
                f32x4 rp = {0.f, 0.f, 0.f, 0.f}, kp = rp, vp = rp;
                if (t > 0) { rp = bf4(zpr[k]); kp = bf4(zpk[k]); vp = bf4(zpv[k]); }
                const f32x4 r = rc + (rp - rc) * mur, kx = kc + (kp - kc) * muk, v = vc + (vp - vc) * muv;
                const f32x4 iclr = bf4(ic[k]), w = wd[k];
                f32x4 kk = kx * kk4;
                const float ss = dpp_add16((kk.x * kk.x + kk.y * kk.y) + (kk.z * kk.z + kk.w * kk.w)); kk = kk * (1.0f / sqrtf(ss + 1e-12f));
                const f32x4 km = kx * (1.0f + (iclr - 1.0f) * ka4);
                const f32x4 rkr = r * km * rk4;
                const float bc = dpp_add16((rkr.x + rkr.y) + (rkr.z + rkr.w));
                unsigned char* rec = SC + ((size_t)h * S_ + t) * SCAN_REC;
                *(f32x4*)(rec + 16 * q) = w;
                const f32x4 a = -kk, b = kk * iclr;
                *(v2u*)(rec + 256 + 8 * q) = (v2u){pk2(r.x, r.y), pk2(r.z, r.w)};
                *(v2u*)(rec + 384 + 8 * q) = (v2u){pk2(km.x, km.y), pk2(km.z, km.w)};
                *(v2u*)(rec + 512 + 8 * q) = (v2u){pk2(v.x, v.y), pk2(v.z, v.w)};
                *(v2u*)(rec + 640 + 8 * q) = (v2u){pk2(a.x, a.y), pk2(a.z, a.w)};
                *(v2u*)(rec + 768 + 8 * q) = (v2u){pk2(b.x, b.y), pk2(b.z, b.w)};
                if (q == 0) BC[t * RH + h] = bc; } }
    }
}

constexpr int SC_T = 32;
#define SCAN_ISSUE(c_) do { const unsigned char* g_ = src + (size_t)(c_) * SC_T * SCAN_REC; _Pragma("unroll") for (int i = 0; i < 7; ++i) sx[i] = *(const v4u*)(g_ + (size_t)(pt + 256 * i) * 16); } while (0)
#define SCAN_COMMIT(c_) do { LAS float* dst_ = inb + ((c_) & 1) * (SC_T * 384); \
    _Pragma("unroll") for (int i = 0; i < 7; ++i) { const int p_ = pt + 256 * i, s_ = p_ / 56, pi_ = p_ % 56; LAS float* d_ = dst_ + s_ * 384; \
        if (pi_ < 16) *(LAS v4u*)(d_ + pi_ * 4) = sx[i]; \
        else { LAS float* dd_ = d_ + 64 + (pi_ - 16) * 8; \
            *(LAS f32x4*)dd_ = (f32x4){bflo(sx[i].x), bfhi(sx[i].x), bflo(sx[i].y), bfhi(sx[i].y)}; *(LAS f32x4*)(dd_ + 4) = (f32x4){bflo(sx[i].z), bfhi(sx[i].z), bflo(sx[i].w), bfhi(sx[i].w)}; } } } while (0)
__device__ __forceinline__ void scan_flush_y(const LAS float* yb, float* Y, int c, int pt, int colbase) {
    const LAS float* s = yb + (c & 1) * (SC_T * 16);
#pragma unroll
    for (int i = 0; i < 2; ++i) { const int idx = pt + 256 * i, st = idx >> 4, rr = idx & 15; Y[(size_t)(c * SC_T + st) * RW + colbase + rr] = s[idx]; }
}
__device__ __forceinline__ void p5_scan_block(Frame& F, int sb) {
    const int h = sb >> 2, rg = sb & 3;
    LAS float* inb = (LAS float*)F.lds;
    LAS float* yb = (LAS float*)(F.lds + 98304);
    const unsigned char* src = F.ws + WS_SCAN + (size_t)h * S_ * SCAN_REC;
    float* Y = (float*)(F.ws + WS_Y);
    const int pt = F.tid - 256, colbase = h * 64 + rg * 16;
    constexpr int NCH = S_ / SC_T;
    v4u sx[7];
    if (F.wave >= 4) { SCAN_ISSUE(0); SCAN_COMMIT(0); SCAN_ISSUE(1); }
    __syncthreads();
    const int q = F.lane & 15, rloc = 4 * F.wave + (F.lane >> 4);
    const bool b0 = (q & 1) != 0, b1 = (q & 2) != 0, b2 = (q & 4) != 0, b3 = (q & 8) != 0;
    const int qidx = (b0 ? 8 : 0) | (b1 ? 4 : 0) | (b2 ? 2 : 0) | (b3 ? 1 : 0);
    f32x2 Sa = {0.f, 0.f}, Sb = {0.f, 0.f};
    for (int c = 0; c < NCH; ++c) {
        if (F.wave < 4) {
            const LAS float* p = inb + (c & 1) * (SC_T * 384) + 4 * q; LAS float* yo = yb + (c & 1) * (SC_T * 16) + rloc;
            const LAS float* pv = inb + (c & 1) * (SC_T * 384) + 192 + rg * 16 + rloc;
            f32x4 w4 = *(const LAS f32x4*)(p), r4 = *(const LAS f32x4*)(p + 64), k4 = *(const LAS f32x4*)(p + 128), a4 = *(const LAS f32x4*)(p + 256), b4 = *(const LAS f32x4*)(p + 320); float vv = pv[0];
            f32x4 w5 = *(const LAS f32x4*)(p + 384), r5 = *(const LAS f32x4*)(p + 384 + 64), k5 = *(const LAS f32x4*)(p + 384 + 128), a5 = *(const LAS f32x4*)(p + 384 + 256), b5 = *(const LAS f32x4*)(p + 384 + 320); float v5 = pv[384];
            float yp[16];
#pragma unroll
            for (int s = 0; s < SC_T; ++s) {
                f32x4 nw = w5, nr = r5, nk = k5, na = a5, nb = b5; float nv = v5;
                if (s + 2 < SC_T) { nw = *(const LAS f32x4*)(p + (s + 2) * 384); nr = *(const LAS f32x4*)(p + (s + 2) * 384 + 64); nk = *(const LAS f32x4*)(p + (s + 2) * 384 + 128);
                    na = *(const LAS f32x4*)(p + (s + 2) * 384 + 256); nb = *(const LAS f32x4*)(p + (s + 2) * 384 + 320); nv = pv[(s + 2) * 384]; }
                const f32x2 pa = Sa * a4.lo + Sb * a4.hi;
                float sa = pa.x + pa.y;
                const f32x2 ta = Sa * w4.lo + k4.lo * vv, tb = Sb * w4.hi + k4.hi * vv;
                sa = dpp_add16(sa);
                Sa = ta + b4.lo * sa; Sb = tb + b4.hi * sa;
                const f32x2 py = Sa * r4.lo + Sb * r4.hi;
                yp[s & 15] = py.x + py.y;
                if ((s & 15) == 15) {
#define SCAN_RS(N_, SEL_, CTRL_) _Pragma("unroll") for (int i = 0; i < (N_); ++i) { const float keep = (SEL_) ? yp[2 * i + 1] : yp[2 * i], send = (SEL_) ? yp[2 * i] : yp[2 * i + 1]; \
                        yp[i] = keep + __builtin_bit_cast(float, __builtin_amdgcn_update_dpp(0, __builtin_bit_cast(int, send), (CTRL_), 0xF, 0xF, false)); }
                    SCAN_RS(8, b3, 0x128) SCAN_RS(4, b2, 0x141) SCAN_RS(2, b1, 0x1B) SCAN_RS(1, b0, 0xB1)
#undef SCAN_RS
                    yo[((s & 16) + qidx) * 16] = yp[0];
                }
                w4 = w5; r4 = r5; k4 = k5; a4 = a5; b4 = b5; vv = v5; w5 = nw; r5 = nr; k5 = nk; a5 = na; b5 = nb; v5 = nv;
            }
        } else {
            if (c + 1 < NCH) SCAN_COMMIT(c + 1);
            if (c + 2 < NCH) SCAN_ISSUE(c + 2);
            if (c > 0) scan_flush_y(yb, Y, c - 1, pt, colbase);
        }
        __syncthreads();
    }
    if (F.wave >= 4) scan_flush_y(yb, Y, NCH - 1, pt, colbase);
}

__device__ __forceinline__ int moba_list_off(int j) { return 8192 * j - 128 * j * (j + 1); }
constexpr int MLIST_HEAD = 126976;
__device__ __forceinline__ int dpp_min16i(int v) {
    v = min(v, __builtin_amdgcn_update_dpp(0, v, 0xB1, 0xF, 0xF, false));
    v = min(v, __builtin_amdgcn_update_dpp(0, v, 0x4E, 0xF, 0xF, false));
    v = min(v, __builtin_amdgcn_update_dpp(0, v, 0x141, 0xF, 0xF, false));
    v = min(v, __builtin_amdgcn_update_dpp(0, v, 0x140, 0xF, 0xF, false));
    return v;
}
typedef short gbf16x8 __attribute__((ext_vector_type(8)));
__device__ __forceinline__ void p4_moba_gate(Frame& F) {
    const bf16* ZM = (const bf16*)(F.ws + WS_ZM); const bf16* KMH = (const bf16*)(F.ws + WS_KMEAN); const bf16* KML = (const bf16*)(F.ws + WS_KMEAN + 262144);
    unsigned* CNT = (unsigned*)(F.ws + WS_CTL) + CW_MCNT; int* LIST = (int*)(F.ws + WS_MLIST);
    const int g = F.lane >> 4, l15 = F.lane & 15;
    for (int item = F.gw + 16 * MH; item < (S_ / 16) * MH; item += F.NGW) {
        const int tile = item >> 4, h = item & 15, t0 = tile * 16, blk = t0 >> 8;
        f32x4 acc[2] = {{0.f, 0.f, 0.f, 0.f}, {0.f, 0.f, 0.f, 0.f}};
#pragma unroll
        for (int ks = 0; ks < 4; ++ks) { const gbf16x8 a = *(const gbf16x8*)(ZM + (size_t)(t0 + l15) * ZM_LD + h * MD + 32 * ks + 8 * g);
#pragma unroll
            for (int nt = 0; nt < 2; ++nt) { const size_t o = ((size_t)h * MNB + l15 + 16 * nt) * MD + 32 * ks + 8 * g;
                acc[nt] = __builtin_amdgcn_mfma_f32_16x16x32_bf16(a, *(const gbf16x8*)(KMH + o), acc[nt], 0, 0, 0);
                acc[nt] = __builtin_amdgcn_mfma_f32_16x16x32_bf16(a, *(const gbf16x8*)(KML + o), acc[nt], 0, 0, 0); } }
#pragma unroll
        for (int r4 = 0; r4 < 4; ++r4) {
            float s0 = l15 < blk ? acc[0][r4] : -INFINITY, s1 = l15 + 16 < blk ? acc[1][r4] : -INFINITY;
            const int t = t0 + 4 * g + r4;
#pragma unroll
            for (int r = 0; r < 3; ++r) { const float m = dpp_max16(fmaxf(s0, s1));
                const int jm = (s0 == m) ? l15 : ((s1 == m) ? l15 + 16 : 99); const int jw = dpp_min16i(jm);
                if (m > -INFINITY && jm == jw) { const unsigned pos = atomicAdd(&CNT[(h * 32 + jw) * 16], 1u); LIST[(size_t)h * MLIST_HEAD + moba_list_off(jw) + pos] = t * 4 + r;
                    if (jw < 16) s0 = -INFINITY; else s1 = -INFINITY; } }
        }
    }
}
__device__ __forceinline__ int moba_off(int row, int ch) { return 256 * row + 16 * (ch ^ (((row & 3) << 2) | ((row >> 2) & 3))); }
typedef short bf16x8 __attribute__((ext_vector_type(8)));
typedef short s16x4 __attribute__((ext_vector_type(4)));
__device__ __forceinline__ void p5_moba_units(Frame& F, int mb, int nmb) {
    const bf16* ZM = (const bf16*)(F.ws + WS_ZM);
    const unsigned* CNT = (const unsigned*)(F.ws + WS_CTL) + CW_MCNT; const int* LIST = (const int*)(F.ws + WS_MLIST);
    bf16* PO = (bf16*)(F.ws + WS_PARTO); float* PML = (float*)(F.ws + WS_PARTML);
    LAS unsigned char* kv = F.lds;
    LAS unsigned char* pw = F.lds + 65536 + F.wave * 8448;
    LAS int* pref = (LAS int*)(F.lds + 133120);
    LAS int* nchs = pref + 520;
    if (F.tid < 512) nchs[F.tid] = (int)((CNT[F.tid * 16] + 127u) >> 7);
    __syncthreads();
    if (F.tid < 512) { int s = 0; for (int i = 0; i < F.tid; ++i) s += nchs[i]; pref[F.tid] = s; if (F.tid == 511) pref[512] = s + nchs[511]; }
    __syncthreads();
    const int U = 1024 + pref[512];
    const int g = F.lane >> 4, l15 = F.lane & 15;
    const float scale = 0.08838834764831845f;
#define MOBA_DECODE(u_, h_, j_, qb_, cnt_, own_, lst_) do { \
        if ((u_) < 1024) { own_ = 1; h_ = (u_) >> 6; j_ = ((u_) >> 1) & 31; qb_ = ((u_) & 1) * 128; cnt_ = 256; lst_ = LIST; } \
        else { own_ = 0; const int v_ = (u_) - 1024; int lo_ = 0, hi_ = 512; \
            while (hi_ - lo_ > 1) { const int mid_ = (lo_ + hi_) >> 1; if (pref[mid_] <= v_) lo_ = mid_; else hi_ = mid_; } \
            lo_ = __builtin_amdgcn_readfirstlane(lo_); h_ = lo_ >> 5; j_ = lo_ & 31; qb_ = __builtin_amdgcn_readfirstlane((v_ - pref[lo_]) * 128); cnt_ = __builtin_amdgcn_readfirstlane((int)CNT[lo_ * 16]); \
            lst_ = LIST + (size_t)h_ * MLIST_HEAD + moba_list_off(j_); } } while (0)
#define MOBA_LOADQ() do { const int q0_ = qb + F.wave * 16; \
        if (own) entA = ((j * 256 + q0_ + l15) << 2) | 3; else entA = (q0_ + l15 < cnt) ? lst[q0_ + l15] : -1; \
        const int tokA_ = entA >= 0 ? (entA >> 2) : 0; \
        _Pragma("unroll") for (int ks = 0; ks < 4; ++ks) qa[ks] = *(const v4u*)(ZM + (size_t)tokA_ * ZM_LD + h * MD + 32 * ks + 8 * g); \
        _Pragma("unroll") for (int i = 0; i < 8; ++i) { const int idx = F.tid + 512 * i; kx[i] = *(const v4u*)(ZM + (size_t)(j * 256 + (idx >> 4)) * ZM_LD + 2048 + h * MD + (idx & 15) * 8); } } while (0)
    int h = 0, j = 0, qb = 0, cnt = 0, own = 0; const int* lst = LIST; int entA = -1; v4u qa[4], kx[8];
    int stg, krd[4], vrd[2][8];
    { const int r0 = F.tid >> 4, chs = F.tid & 15; stg = 256 * r0 + 16 * (chs ^ (((r0 & 3) << 2) | ((r0 >> 2) & 3)));
      const int fk = ((l15 & 3) << 2) | ((l15 >> 2) & 3);
#pragma unroll
      for (int ks = 0; ks < 4; ++ks) krd[ks] = 256 * l15 + 16 * ((4 * ks + g) ^ fk);
      const int tq = l15 >> 2, tp = l15 & 3;
#pragma unroll
      for (int t = 0; t < 2; ++t) { const int fr = (tq << 2) | ((2 * g + t) & 3);
#pragma unroll
          for (int cc = 0; cc < 8; ++cc) vrd[t][cc] = 256 * (8 * g + 4 * t + tq) + 16 * ((2 * cc + (tp >> 1)) ^ fr) + 8 * (tp & 1); } }
    if (mb < U) { MOBA_DECODE(mb, h, j, qb, cnt, own, lst); MOBA_LOADQ(); }
    for (int u = mb; u < U; u += nmb) {
        const int ch = h, cj = j, cown = own; const bool active = qb + F.wave * 16 < cnt;
#pragma unroll
        for (int i = 0; i < 8; ++i) *(LAS v4u*)(kv + stg + 8192 * i) = kx[i];
        __syncthreads();
        v4u vst[8];
#pragma unroll
        for (int i = 0; i < 8; ++i) { const int idx = F.tid + 512 * i; vst[i] = *(const v4u*)(ZM + (size_t)(cj * 256 + (idx >> 4)) * ZM_LD + 4096 + ch * MD + (idx & 15) * 8); }
        float mrow[4], lrow[4]; int entR[4];
#pragma unroll
        for (int r = 0; r < 4; ++r) entR[r] = __shfl(entA, 4 * g + r);
        if (active) {
            f32x4 sacc[16];
#pragma unroll
            for (int nt = 0; nt < 16; ++nt) { sacc[nt] = (f32x4){0.f, 0.f, 0.f, 0.f};
#pragma unroll
                for (int ks = 0; ks < 4; ++ks) { const bf16x8 b = *(const LAS bf16x8*)(kv + krd[ks] + 4096 * nt);
                    sacc[nt] = __builtin_amdgcn_mfma_f32_16x16x32_bf16(__builtin_bit_cast(bf16x8, qa[ks]), b, sacc[nt], 0, 0, 0); } }
#pragma unroll
            for (int r = 0; r < 4; ++r) { const int tokr = entR[r] >> 2; float mx = -INFINITY;
#pragma unroll
                for (int nt = 0; nt < 16; ++nt) { float s = sacc[nt][r] * scale; if (cown && (cj * 256 + 16 * nt + l15) > tokr) s = -INFINITY; sacc[nt][r] = s; mx = fmaxf(mx, s); }
                mx = dpp_max16(mx); mrow[r] = mx; float sum = 0.f;
#pragma unroll
                for (int nt = 0; nt < 16; ++nt) { const float p = __expf(sacc[nt][r] - mx); sum += p; *(LAS bf16*)(pw + (4 * g + r) * 528 + (16 * nt + l15) * 2) = (bf16)f2bf(p); }
                lrow[r] = dpp_add16(sum); }
        }
        __syncthreads();
#pragma unroll
        for (int i = 0; i < 8; ++i) *(LAS v4u*)(kv + stg + 8192 * i) = vst[i];
        if (u + nmb < U) { MOBA_DECODE(u + nmb, h, j, qb, cnt, own, lst); MOBA_LOADQ(); }
        __syncthreads();
        if (active) {
            f32x4 oacc[8];
#pragma unroll
            for (int c = 0; c < 8; ++c) oacc[c] = (f32x4){0.f, 0.f, 0.f, 0.f};
#pragma unroll
            for (int ks = 0; ks < 8; ++ks) { const bf16x8 a = *(const LAS bf16x8*)(pw + l15 * 528 + (32 * ks + 8 * g) * 2);
#pragma unroll
                for (int c = 0; c < 8; ++c) {
                    const s16x4 t0 = __builtin_amdgcn_ds_read_tr16_b64_v4i16((LAS s16x4*)(kv + vrd[0][c] + 8192 * ks));
                    const s16x4 t1 = __builtin_amdgcn_ds_read_tr16_b64_v4i16((LAS s16x4*)(kv + vrd[1][c] + 8192 * ks));
                    const bf16x8 b = {t0.x, t0.y, t0.z, t0.w, t1.x, t1.y, t1.z, t1.w};
                    oacc[c] = __builtin_amdgcn_mfma_f32_16x16x32_bf16(a, b, oacc[c], 0, 0, 0); } }
#pragma unroll
            for (int r = 0; r < 4; ++r) if (entR[r] >= 0) { const int tok = entR[r] >> 2, slot = entR[r] & 3; const size_t base = ((size_t)(tok * MH + ch) * 4 + slot); const float inv = 1.0f / lrow[r];
#pragma unroll
                for (int c = 0; c < 8; ++c) PO[base * MD + 16 * c + l15] = (bf16)f2bf(oacc[c][r] * inv);
                if (l15 == 0) { PML[base * 2] = mrow[r]; PML[base * 2 + 1] = lrow[r]; } }
        }
        __syncthreads();
    }
#undef MOBA_DECODE
#undef MOBA_LOADQ
}
__device__ __forceinline__ void p6_moba_combine(Frame& F) {
    const bf16* PO = (const bf16*)(F.ws + WS_PARTO); const float* PML = (const float*)(F.ws + WS_PARTML); bf16* YB = (bf16*)(F.ws + WS_YB);
    for (int t = F.gw; t < S_; t += F.NGW) {
        const int h = F.lane >> 2, dq = F.lane & 3, blk = t >> 8, nsel = blk < 3 ? blk : 3; const size_t base = (size_t)(t * MH + h) * 4;
        const f32x4 ml0 = *(const f32x4*)(PML + base * 2), ml1 = *(const f32x4*)(PML + base * 2 + 4);
        v4u x[4][4];
#pragma unroll
        for (int s = 0; s < 4; ++s)
#pragma unroll
            for (int k = 0; k < 4; ++k) x[s][k] = *(const v4u*)(PO + (base + s) * MD + dq * 32 + k * 8);
        const float ms[4] = {ml0.x, ml0.z, ml1.x, ml1.z}, ls[4] = {ml0.y, ml0.w, ml1.y, ml1.w};
        float M = ms[3];
#pragma unroll
        for (int s = 0; s < 3; ++s) if (s < nsel) M = fmaxf(M, ms[s]);
        float wsum = 0.f, w[4];
#pragma unroll
        for (int s = 0; s < 4; ++s) { w[s] = (s == 3 || s < nsel) ? __expf(ms[s] - M) * ls[s] : 0.f; wsum += w[s]; }
        const float inv = 1.0f / wsum;
#pragma unroll
        for (int k = 0; k < 4; ++k) { float o[8] = {0.f, 0.f, 0.f, 0.f, 0.f, 0.f, 0.f, 0.f};
#pragma unroll
            for (int s = 0; s < 4; ++s) if (s == 3 || s < nsel) { const v4u v = x[s][k]; o[0] += w[s] * bflo(v.x); o[1] += w[s] * bfhi(v.x); o[2] += w[s] * bflo(v.y); o[3] += w[s] * bfhi(v.y); o[4] += w[s] * bflo(v.z); o[5] += w[s] * bfhi(v.z); o[6] += w[s] * bflo(v.w); o[7] += w[s] * bfhi(v.w); }
            const float i16 = inv * 16.0f; *(v2u*)((unsigned char*)YB + (size_t)t * RW + h * MD + dq * 32 + k * 8) = (v2u){pk4_fp8(o[0] * i16, o[1] * i16, o[2] * i16, o[3] * i16), pk4_fp8(o[4] * i16, o[5] * i16, o[6] * i16, o[7] * i16)}; }
    }
}

__device__ __forceinline__ void p6_rwkv_post(Frame& F) {
    const float* Y = (const float*)(F.ws + WS_Y); const bf16* GG = (const bf16*)(F.ws + WS_GG); const float* BC = (const float*)(F.ws + WS_BC);
    const unsigned char* SC = F.ws + WS_SCAN; bf16* YA = (bf16*)(F.ws + WS_YA);
    const float* gn_w = F.in[12]; const float* gn_b = F.in[13];
    const int hq = F.gw & 7, c = hq * 256 + 4 * F.lane, h = hq * 4 + (F.lane >> 4), q = F.lane & 15, tstep = F.NGW >> 3;
    const f32x4 gw4 = *(const f32x4*)(gn_w + c), gb4 = *(const f32x4*)(gn_b + c);
    for (int tb = F.gw >> 3; tb < S_; tb += 4 * tstep) {
        f32x4 yy[4]; v2u vv[4], gg[4]; float bcv[4];
#pragma unroll
        for (int k = 0; k < 4; ++k) { const int t = tb + k * tstep; yy[k] = (f32x4){0.f, 0.f, 0.f, 0.f}; vv[k] = gg[k] = (v2u){0u, 0u}; bcv[k] = 0.f;
            if (t < S_) { yy[k] = *(const f32x4*)(Y + (size_t)t * RW + c); vv[k] = *(const v2u*)(SC + ((size_t)h * S_ + t) * SCAN_REC + 512 + 8 * q); gg[k] = *(const v2u*)(GG + (size_t)t * RW + c); bcv[k] = BC[t * RH + h]; } }
#pragma unroll
        for (int k = 0; k < 4; ++k) { const int t = tb + k * tstep;
            if (t < S_) {
                const f32x4 y = yy[k];
                const float mean = dpp_add16((y.x + y.y) + (y.z + y.w)) * (1.f / 64.f); const f32x4 d = y - mean;
                const float var = dpp_add16((d.x * d.x + d.y * d.y) + (d.z * d.z + d.w * d.w)) * (1.f / 64.f);
                const f32x4 yn = d * (1.0f / sqrtf(var + 64e-5f)) * gw4 + gb4;
                const f32x4 o = (yn + bcv[k] * bf4(vv[k])) * bf4(gg[k]);
                *(v2u*)(YA + (size_t)t * RW + c) = (v2u){pk2(o.x, o.y), pk2(o.z, o.w)}; } }
    }
}

__device__ __forceinline__ void p9_norm(Frame& F) {
    for (int m = F.gw; m < S_; m += F.NGW) rms_row_to_bf16((const float*)(F.ws + WS_H1R) + (size_t)m * D_, F.in[17], (bf16*)(F.ws + WS_HN) + (size_t)m * D_, F.lane);
}

__device__ __forceinline__ float uniq_key(float s, int n) { return __uint_as_float((__float_as_uint(s) & ~0xffu) | (unsigned)(255 - n)); }
#define INS16(A_, X_) do { float x_ = (X_); _Pragma("unroll") for (int i_ = 0; i_ < 16; ++i_) { const float hi_ = fmaxf(A_[i_], x_); x_ = fminf(A_[i_], x_); A_[i_] = hi_; } } while (0)
__device__ __forceinline__ void p11_route(Frame& F) {
    const bf16* QRY = (const bf16*)(F.ws + WS_QRY); const bf16* SK = (const bf16*)(F.ws + WS_SUBK);
    int* PIDX = (int*)(F.ws + WS_PIDX); float* PGT = (float*)(F.ws + WS_PG);
    LAS float* sc = (LAS float*)(F.lds + F.wave * 16640);
    LAS int* ptab = (LAS int*)(F.lds + 8 * 16640);
    if (F.tid < 50) { const int l = F.tid; const int ci = l < 16 ? 0 : l < 24 ? 1 : l < 29 ? 2 : l < 33 ? 3 : l < 36 ? 4 : l < 38 ? 5 : l < 40 ? 6 : l < 42 ? 7 : l - 34;
        const int cj = l < 16 ? l : l < 24 ? l - 16 : l < 29 ? l - 24 : l < 33 ? l - 29 : l < 36 ? l - 33 : l < 38 ? l - 36 : l < 40 ? l - 38 : l < 42 ? l - 40 : 0; ptab[l] = ci * 16 + cj; }
    __syncthreads();
    const int g = F.lane >> 4, l15 = F.lane & 15;
    for (int item = F.gw; item < (S_ / 16) * PH; item += F.NGW) {
        const int tile = item >> 3, h = item & 7, t0 = tile * 16;
#pragma unroll
        for (int c = 0; c < 2; ++c) {
            f32x4 acc[8];
#pragma unroll
            for (int nt = 0; nt < 8; ++nt) acc[nt] = (f32x4){0.f, 0.f, 0.f, 0.f};
#pragma unroll
            for (int ks = 0; ks < 4; ++ks) { const gbf16x8 a = *(const gbf16x8*)(QRY + (size_t)(t0 + l15) * 2048 + h * 256 + c * 128 + 32 * ks + 8 * g);
#pragma unroll
                for (int nt = 0; nt < 8; ++nt) acc[nt] = __builtin_amdgcn_mfma_f32_16x16x32_bf16(a, *(const gbf16x8*)(SK + ((size_t)(h * 2 + c) * PNK + 16 * nt + l15) * 128 + 32 * ks + 8 * g), acc[nt], 0, 0, 0); }
#pragma unroll
            for (int nt = 0; nt < 8; ++nt)
#pragma unroll
                for (int r = 0; r < 4; ++r) sc[(c * 16 + 4 * g + r) * 129 + 16 * nt + l15] = acc[nt][r];
        }
        if (F.lane < 32) {
            LAS float* row = sc + F.lane * 129; float a[16];
#pragma unroll
            for (int i = 0; i < 16; ++i) a[i] = -INFINITY;
#pragma unroll 4
            for (int n = 0; n < PNK; ++n) INS16(a, uniq_key(row[n], n));
            float tv[16]; int ti[16];
#pragma unroll
            for (int i = 0; i < 16; ++i) { ti[i] = 255 - (int)(__float_as_uint(a[i]) & 255u); tv[i] = row[ti[i]]; }
#pragma unroll
            for (int i = 0; i < 16; ++i) { row[i] = tv[i]; row[16 + i] = __int_as_float(ti[i]); }
        }
        if (F.lane < 16) {
            const LAS float* r0 = sc + F.lane * 129; const LAS float* r1 = sc + (16 + F.lane) * 129;
            float v0[16], v1[16];
#pragma unroll
            for (int i = 0; i < 16; ++i) { v0[i] = r0[i]; v1[i] = r1[i]; }
            float b[16];
#pragma unroll
            for (int i = 0; i < 16; ++i) b[i] = -INFINITY;
            { int p = 0;
#pragma unroll
              for (int i = 0; i < 16; ++i)
#pragma unroll
                  for (int j = 0; j < 16; ++j) if ((i + 1) * (j + 1) <= 16) { INS16(b, uniq_key(v0[i] + v1[j], p)); ++p; } }
            const int t = t0 + F.lane; float pv[16]; float den = 0.f; float mx = 0.f;
            float rsn; { const f32x4* pp = (const f32x4*)((const float*)(F.ws + WS_PSQ) + (size_t)t * 64); float q = 0.f;
#pragma unroll
              for (int k = 0; k < 16; ++k) { const f32x4 a4 = pp[k]; q += (a4.x + a4.y) + (a4.z + a4.w); }
              rsn = 1.0f / sqrtf(q * (1.f / D_) + 1e-6f); }
#pragma unroll
            for (int r = 0; r < 16; ++r) { const int p = 255 - (int)(__float_as_uint(b[r]) & 255u); const int ij = ptab[p]; const int ii = ij >> 4, jj = ij & 15;
                const float val = r0[ii] + r1[jj]; if (r == 0) mx = val; pv[r] = __expf((val - mx) * rsn); den += pv[r];
                PIDX[(size_t)t * 128 + h * PT + r] = __float_as_int(r0[16 + ii]) * PNK + __float_as_int(r1[16 + jj]); }
            const float inv = 1.0f / den;
#pragma unroll
            for (int r = 0; r < 16; ++r) PGT[(size_t)t * 128 + h * PT + r] = pv[r] * inv;
        }
    }
    __syncthreads();
}
#undef INS16

__device__ __forceinline__ float gelu_erf(float v) {
    const float av = fabsf(v), tt = __builtin_amdgcn_rcpf(av * 0.2316418882f + 1.0f);
    float q = tt * 0.5307027145f + (-0.7265760135f); q = q * tt + 0.7107068705f; q = q * tt + (-0.142248368f); q = q * tt + 0.127414796f; q = q * tt;
    const float e = __builtin_amdgcn_exp2f((v * v) * (-0.72134752044f));
    const float m = v * (q * e); return v < 0.f ? m : v - m;
}
__device__ __forceinline__ void p12_peer(Frame& F) {
    const bf16* HN = (const bf16*)(F.ws + WS_HN);
    const unsigned char* U4 = F.ws + WS_U8; const unsigned short* USS = (const unsigned short*)(F.ws + WS_USC); const unsigned char* V8 = F.ws + WS_V8; const float* VSC = (const float*)(F.ws + WS_VSC);
    const int* PIDX = (const int*)(F.ws + WS_PIDX); const float* PGT = (const float*)(F.ws + WS_PG); const float* PSQ = (const float*)(F.ws + WS_PSQ);
    const float* lnf = F.in[22];
    LAS unsigned char* XQ = F.lds + F.wave * 17408;
    LAS unsigned short* EL = (LAS unsigned short*)(XQ + 16384);
    LAS float* WL = (LAS float*)XQ;
    const int g8 = F.lane >> 3, k8 = F.lane & 7;
    float sx[4];
#pragma unroll
    for (int i = 0; i < 4; ++i) {
        const int t = F.gw + i * F.NGW; v4u xp[8]; float mxa = 0.f;
#pragma unroll
        for (int j = 0; j < 8; ++j) { xp[j] = ((const v4u*)(HN + (size_t)t * D_))[F.lane + 64 * j];
            mxa = fmaxf(fmaxf(fmaxf(mxa, fmaxf(fabsf(bflo(xp[j].x)), fabsf(bfhi(xp[j].x)))), fmaxf(fabsf(bflo(xp[j].y)), fabsf(bfhi(xp[j].y)))), fmaxf(fmaxf(fabsf(bflo(xp[j].z)), fabsf(bfhi(xp[j].z))), fmaxf(fabsf(bflo(xp[j].w)), fabsf(bfhi(xp[j].w))))); }
        mxa = wave_max(mxa); const float inv = mxa > 0.f ? 127.0f / mxa : 0.f;
        const float rsn = 1.0f / sqrtf(wave_sum(PSQ[(size_t)t * 64 + F.lane]) * (1.f / D_) + 1e-6f);
        sx[i] = mxa * rsn * (1.0f / 127.0f);
#pragma unroll
        for (int j = 0; j < 8; ++j) {
            const int q0 = (int)rintf(bflo(xp[j].x) * inv), q1 = (int)rintf(bfhi(xp[j].x) * inv), q2 = (int)rintf(bflo(xp[j].y) * inv), q3 = (int)rintf(bfhi(xp[j].y) * inv);
            const int q4 = (int)rintf(bflo(xp[j].z) * inv), q5 = (int)rintf(bfhi(xp[j].z) * inv), q6 = (int)rintf(bflo(xp[j].w) * inv), q7 = (int)rintf(bfhi(xp[j].w) * inv);
            *(LAS v2u*)(XQ + i * 4096 + 8 * (F.lane + 64 * j)) = (v2u){(unsigned)((q0 & 0xff) | ((q1 & 0xff) << 8) | ((q2 & 0xff) << 16) | (q3 << 24)), (unsigned)((q4 & 0xff) | ((q5 & 0xff) << 8) | ((q6 & 0xff) << 16) | (q7 << 24))}; }
        EL[i * 128 + F.lane] = (unsigned short)PIDX[(size_t)t * 128 + F.lane]; EL[i * 128 + 64 + F.lane] = (unsigned short)PIDX[(size_t)t * 128 + 64 + F.lane];
        asm volatile("" ::: "memory");
    }
    LDS_WAIT(); asm volatile("" ::: "memory");
    float psum[4][16];
#pragma unroll
    for (int i = 0; i < 4; ++i)
#pragma unroll
        for (int b = 0; b < 16; ++b) psum[i][b] = 0.f;
#define P12_U4(W_, XA_, XB_, ACC_) do { ACC_ = __builtin_amdgcn_sdot4((int)((W_) & 0x0F0F0F0Fu), (int)(XA_), ACC_, false); ACC_ = __builtin_amdgcn_sdot4((int)(((W_) >> 4) & 0x0F0F0F0Fu), (int)(XB_), ACC_, false); } while (0)
#define P12_ISSUE(c_, i_, h_, CW_, SC_) do { _Pragma("unroll") for (int bb = 0; bb < 8; ++bb) { const unsigned ro = (unsigned)(c_) * 16384u + (unsigned)EL[(i_) * 128 + ((h_) * 8 + bb) * 8 + g8]; \
        CW_[bb] = *(const v4u*)(U4 + (size_t)(ro * 128u + 16u * (unsigned)k8)); SC_[bb] = USS[(size_t)(ro * 8u + (unsigned)k8)]; } } while (0)
#define P12_XQ(c_, i_) do { xa = *(const LAS v4u*)(XQ + (i_) * 4096 + 256 * (c_) + 32 * k8); xb = *(const LAS v4u*)(XQ + (i_) * 4096 + 256 * (c_) + 32 * k8 + 16); \
        int xs = __builtin_amdgcn_sdot4((int)xa.x, 0x01010101, 0, false); xs = __builtin_amdgcn_sdot4((int)xa.y, 0x01010101, xs, false); xs = __builtin_amdgcn_sdot4((int)xa.z, 0x01010101, xs, false); xs = __builtin_amdgcn_sdot4((int)xa.w, 0x01010101, xs, false); \
        xs = __builtin_amdgcn_sdot4((int)xb.x, 0x01010101, xs, false); xs = __builtin_amdgcn_sdot4((int)xb.y, 0x01010101, xs, false); xs = __builtin_amdgcn_sdot4((int)xb.z, 0x01010101, xs, false); xs = __builtin_amdgcn_sdot4((int)xb.w, 0x01010101, xs, false); \
        xo = 8 * xs; } while (0)
#define P12_COMP(i_, h_, CW_, SC_) do { _Pragma("unroll") for (int bb = 0; bb < 8; ++bb) { int a0 = 0, a1 = 0; P12_U4(CW_[bb].x, xa.x, xa.y, a0); P12_U4(CW_[bb].y, xa.z, xa.w, a1); P12_U4(CW_[bb].z, xb.x, xb.y, a0); P12_U4(CW_[bb].w, xb.z, xb.w, a1); \
        psum[(i_)][(h_) * 8 + bb] += __uint_as_float(SC_[bb] << 16) * (float)((a0 + a1) - xo); } } while (0)
#define P12_BAR() asm volatile("" ::: "memory")
    { v4u cwA[8], cwB[8]; unsigned scA[8], scB[8]; v4u xa, xb; int xo;
      P12_ISSUE(0, 0, 0, cwA, scA);
_Pragma("nounroll")
      for (int c = 0; c < 16; ++c) { const int cn = c + 1 < 16 ? c + 1 : 15;
          P12_XQ(c, 0); P12_ISSUE(c, 0, 1, cwB, scB); P12_BAR(); P12_COMP(0, 0, cwA, scA); P12_ISSUE(c, 1, 0, cwA, scA); P12_BAR(); P12_COMP(0, 1, cwB, scB);
          P12_XQ(c, 1); P12_ISSUE(c, 1, 1, cwB, scB); P12_BAR(); P12_COMP(1, 0, cwA, scA); P12_ISSUE(c, 2, 0, cwA, scA); P12_BAR(); P12_COMP(1, 1, cwB, scB);
          P12_XQ(c, 2); P12_ISSUE(c, 2, 1, cwB, scB); P12_BAR(); P12_COMP(2, 0, cwA, scA); P12_ISSUE(c, 3, 0, cwA, scA); P12_BAR(); P12_COMP(2, 1, cwB, scB);
          P12_XQ(c, 3); P12_ISSUE(c, 3, 1, cwB, scB); P12_BAR(); P12_COMP(3, 0, cwA, scA); P12_ISSUE(cn, 0, 0, cwA, scA); P12_BAR(); P12_COMP(3, 1, cwB, scB);
      } }
#undef P12_ISSUE
#undef P12_XQ
#undef P12_COMP
#undef P12_BAR
#undef P12_U4
    asm volatile("" ::: "memory"); LDS_WAIT();
#pragma unroll
    for (int i = 0; i < 4; ++i) { const int t = F.gw + i * F.NGW;
#pragma unroll
        for (int b = 0; b < 16; ++b) { float d = psum[i][b];
            d += __builtin_bit_cast(float, __builtin_amdgcn_update_dpp(0, __builtin_bit_cast(int, d), 0xB1, 0xF, 0xF, false));
            d += __builtin_bit_cast(float, __builtin_amdgcn_update_dpp(0, __builtin_bit_cast(int, d), 0x4E, 0xF, 0xF, false));
            d += __builtin_bit_cast(float, __builtin_amdgcn_update_dpp(0, __builtin_bit_cast(int, d), 0x141, 0xF, 0xF, false));
            const int idx = b * 8 + g8; const float w = PGT[(size_t)t * 128 + idx] * gelu_erf(sx[i] * d) * VSC[EL[i * 128 + idx]];
            if (k8 == 0) WL[i * 128 + idx] = w; } }
    asm volatile("" ::: "memory"); LDS_WAIT();
    { typedef unsigned v3u_ __attribute__((ext_vector_type(3))); typedef unsigned v6u_ __attribute__((ext_vector_type(6))); typedef float v32f_ __attribute__((ext_vector_type(32)));
      const int eg = F.lane >> 4, cl = F.lane & 15; const bool hi5 = (F.lane & 32) != 0, hi4 = (F.lane & 16) != 0;
      LAS float* SSQ = (LAS float*)(XQ + 4096);
#pragma unroll
      for (int i = 0; i < 4; ++i) SSQ[i * 64 + F.lane] = 0.f;
#define P12_VISSUE(c_, i_, q_, D_X) do { _Pragma("unroll") for (int b = 0; b < 8; ++b) { const int idx = ((q_) * 8 + b) * 4 + eg; const unsigned ro = (unsigned)(c_) * 16384u + (unsigned)EL[(i_) * 128 + idx]; \
          const v3u_ ld_ = *(const v3u_*)(V8 + (size_t)(ro * 192u + 12u * (unsigned)cl)); if (b & 1) D_X[b >> 1].hi = ld_; else D_X[b >> 1].lo = ld_; } } while (0)
#define P12_VCOMP(i_, q_, D_X) do { _Pragma("unroll") for (int b = 0; b < 8; b += 2) { asm volatile("" : "+v"(D_X[b >> 1]));     \
          const float w0_ = WL[(i_) * 128 + ((q_) * 8 + b) * 4 + eg], w1_ = WL[(i_) * 128 + ((q_) * 8 + b + 1) * 4 + eg]; \
          const v32f_ f = __builtin_amdgcn_cvt_scalef32_pk32_f32_fp6(D_X[b >> 1], 1.0f); \
          _Pragma("unroll") for (int m = 0; m < 8; ++m) acc2[m] += (f32x2){f[2 * m], f[2 * m + 1]} * w0_; \
          _Pragma("unroll") for (int m = 0; m < 8; ++m) acc2[m] += (f32x2){f[16 + 2 * m], f[17 + 2 * m]} * w1_; asm volatile("" ::: "memory"); } } while (0)
      v6u_ dA[4], dB[4];
      P12_VISSUE(0, 0, 0, dA);
_Pragma("nounroll")
      for (int c = 0; c < 16; ++c) {
          int lo_ = 16 * cl + 4 * eg; asm volatile("" : "+v"(lo_));
_Pragma("nounroll")
          for (int i = 0; i < 4; ++i) { const int t = F.gw + i * F.NGW;
              f32x2 acc2[8];
#pragma unroll
              for (int m = 0; m < 8; ++m) acc2[m] = (f32x2){0.f, 0.f};
              const v2u hb = *(const v2u*)(HN + ((size_t)t * D_ + (size_t)(unsigned)(256 * c + lo_)));
              P12_VISSUE(c, i, 1, dB); asm volatile("" ::: "memory"); P12_VCOMP(i, 0, dA);
              P12_VISSUE(c, i, 2, dA); asm volatile("" ::: "memory"); P12_VCOMP(i, 1, dB);
              P12_VISSUE(c, i, 3, dB); asm volatile("" ::: "memory"); P12_VCOMP(i, 2, dA);
              { const int in_ = i + 1 < 4 ? i + 1 : 0, cn_ = i + 1 < 4 ? c : (c + 1 < 16 ? c + 1 : 15); P12_VISSUE(cn_, in_, 0, dA); } asm volatile("" ::: "memory"); P12_VCOMP(i, 3, dB);
              float r8[8], r4[4];
#pragma unroll
              for (int m = 0; m < 8; ++m) { const float lo_v = (m & 1) ? acc2[m >> 1].y : acc2[m >> 1].x, hi_v = (m & 1) ? acc2[4 + (m >> 1)].y : acc2[4 + (m >> 1)].x;
                  const float keep = hi5 ? hi_v : lo_v, send = hi5 ? lo_v : hi_v;
                  r8[m] = keep + __builtin_bit_cast(float, __builtin_amdgcn_ds_bpermute((F.lane ^ 32) << 2, __builtin_bit_cast(int, send))); }
#pragma unroll
              for (int m = 0; m < 4; ++m) { const float keep = hi4 ? r8[4 + m] : r8[m], send = hi4 ? r8[m] : r8[4 + m];
                  r4[m] = keep + __builtin_bit_cast(float, __builtin_amdgcn_ds_bpermute((F.lane ^ 16) << 2, __builtin_bit_cast(int, send))); }
              int lo3_ = lo_; asm volatile("" : "+v"(lo3_));
              const size_t col = (size_t)t * D_ + (size_t)(unsigned)(256 * c + lo3_);
              const f32x4 o = {r4[0] + bflo(hb.x), r4[1] + bfhi(hb.x), r4[2] + bflo(hb.y), r4[3] + bfhi(hb.y)};
              SSQ[i * 64 + F.lane] += (o.x * o.x + o.y * o.y) + (o.z * o.z + o.w * o.w);
              *(f32x4*)(F.out + col) = o;
          }
      }
#undef P12_VISSUE
#undef P12_VCOMP
      __builtin_amdgcn_fence(__ATOMIC_SEQ_CST, "agent");
      const int l2_ = fresh_lane(), lo2_ = 16 * (l2_ & 15) + 4 * (l2_ >> 4);
#pragma unroll
      for (int i = 0; i < 4; ++i) { const int t = F.gw + i * F.NGW;
          const float rs = 1.0f / sqrtf(wave_sum(SSQ[i * 64 + l2_]) * (1.f / D_) + 1e-6f);
_Pragma("nounroll")
          for (int c0 = 0; c0 < 16; c0 += 8) {
#pragma unroll
              for (int c = c0; c < c0 + 8; ++c) { const size_t col = (size_t)t * D_ + (size_t)(unsigned)(256 * c + lo2_); const f32x4 gn = *(const f32x4*)(lnf + (256 * c + lo2_));
                  const f32x4 o = *(const f32x4*)(F.out + col);
                  *(f32x4*)(F.out + col) = (f32x4){o.x * rs * gn.x, o.y * rs * gn.y, o.z * rs * gn.z, o.w * rs * gn.w}; }
              asm volatile("" ::: "memory"); } }
    }
}

struct Args { const float* in[23]; float* out; unsigned char* ws; int ph_lo, ph_hi, li, pad; };
__global__ void __launch_bounds__(NWAVES * 64, 2) mk_fwd(Args args) {
    extern __shared__ __attribute__((aligned(16))) unsigned char lds[];
    Frame F;
    F.lds = (LAS unsigned char*)lds;
    F.tid = threadIdx.x; F.lane = F.tid & 63; F.wave = __builtin_amdgcn_readfirstlane(F.tid >> 6);
    F.G = gridDim.x; F.gw = blockIdx.x * NWAVES + F.wave; F.NGW = F.G * NWAVES;
    F.in = args.in; F.out = args.out; F.ws = args.ws;
    volatile LAS unsigned* MISC = (volatile LAS unsigned*)(F.lds + MISC_OFF);
    for (int u = F.tid; u < (LDS_BYTES - LDSCTL_OFF) / 4; u += NWAVES * 64) ((LAS unsigned*)(F.lds + LDSCTL_OFF))[u] = 0u;
    __syncthreads();
    unsigned* ctl = (unsigned*)(F.ws + WS_CTL);
    XcdBarrier bar; bar.bar = ctl + CW_BAR + args.li * XCD_BAR_WORDS; bar.x = 0; bar.st = nullptr;
    const int lo = args.ph_lo, hi = args.ph_hi;
    if (hi - lo > 1) bar = xcd_barrier_post(ctl + CW_BAR + args.li * XCD_BAR_WORDS, MISC + 8);
#define IN(k) ((lo <= (k) && (k) < hi) && (F.lane = fresh_lane(), F.tid = F.wave * 64 + F.lane, true))
#ifndef PROBE_DUP
#define PROBE_DUP 0
#endif
#define REP(k) _Pragma("unroll") for (int _r = 0; _r < ((((PROBE_DUP) >> (k)) & 1) ? 2 : 1); ++_r)
#define SEAM(k) do { if (IN(k) && IN((k) + 1)) xcd_barrier(bar); } while (0)

    if (IN(0)) { REP(0) { p0_prologue(F); __syncthreads(); } SEAM(0); }
    if (IN(1)) REP(1) {
        { pg8::Gemm g{(const pg8::bf16_t*)(F.ws + WS_XN8), (const pg8::bf16_t*)(F.ws + WS_WINT8), S_, 20992, D_ / 2}; pg8::StaticOrder S; S.init(S_, 20992, F.G, (int)blockIdx.x);
          pg8::EpiZ E{(bf16*)(F.ws + WS_ZR), (bf16*)(F.ws + WS_ZM), (bf16*)(F.ws + WS_ZG), 0};
          pg8::gemm_phase<pg8::EpiZ, pg8::StaticOrder, PG8_ALIGN, PG8_SP2, true>(F.lds, g, S, E, F.wave); }
        __syncthreads();
        if (F.G == 256 && blockIdx.x >= 64) {
            F.lane = fresh_lane(); const int qw = ((int)blockIdx.x - 64) * NWAVES + F.wave, qn = 192 * NWAVES;
            quant_rows4(F.in[20], F.in[17], F.ws + WS_U8, (bf16*)(F.ws + WS_USC), QROWS_EARLY, qw, qn, F.lane);
            quant_rows_fp6(F.in[21], F.ws + WS_V8, (float*)(F.ws + WS_VSC), QROWS_EARLY, qw, qn, F.lane);
        } else if (F.G != 256 && blockIdx.x == 0) { for (int w = F.wave; w < NWAVES; w += NWAVES) { quant_rows4(F.in[20], F.in[17], F.ws + WS_U8, (bf16*)(F.ws + WS_USC), QROWS_EARLY, w, NWAVES, F.lane); quant_rows_fp6(F.in[21], F.ws + WS_V8, (float*)(F.ws + WS_VSC), QROWS_EARLY, w, NWAVES, F.lane); } }
    }
    SEAM(1);
    if (IN(2)) { REP(2) { p2_prep(F); } SEAM(2); }
    if (IN(3)) REP(3) {
        pg8::Gemm g{(const pg8::bf16_t*)(F.ws + WS_LORAA), (const pg8::bf16_t*)(F.ws + WS_LORABT), S_, LORA_N, LORA_K}; pg8::StaticOrder S; S.init(S_, LORA_N, F.G, (int)blockIdx.x);
        pg8::EpiLora E{(float*)(F.ws + WS_WDEC), (float*)(F.ws + WS_ICLR), (float*)(F.ws + WS_GG), F.in[4], F.in[6]};
        pg8::gemm_phase<pg8::EpiLora, pg8::StaticOrder, PG8_ALIGN, PG8_SP2>(F.lds, g, S, E, F.wave);
        __syncthreads();
    }
    SEAM(3);
    if (IN(4)) { REP(4) { p4_rwkv_prep(F); } p4_moba_gate(F); SEAM(4); }
    if (IN(5)) {
        if (F.G >= 256) { if (blockIdx.x < 128) { p5_scan_block(F, blockIdx.x);
#if PROBE_DUP & 0x10000
            __syncthreads(); p5_scan_block(F, blockIdx.x);
#endif
            } else { p5_moba_units(F, blockIdx.x - 128, F.G - 128); __syncthreads(); late_prep(F, (blockIdx.x - 128) * NWAVES + F.wave, (F.G - 128) * NWAVES);
#if PROBE_DUP & 0x20000
            __syncthreads(); p5_moba_units(F, blockIdx.x - 128, F.G - 128);
#endif
            } __syncthreads(); }
        SEAM(5);
    }
    if (IN(6)) { REP(6) { p6_rwkv_post(F); p6_moba_combine(F); } SEAM(6); }
    if (IN(7)) REP(7) {
        pg8::StaticOrder S; S.init(S_, D_, F.G, (int)blockIdx.x);
        { pg8::Gemm g{(const pg8::bf16_t*)(F.ws + WS_YA), (const pg8::bf16_t*)(F.ws + WS_WPA), S_, D_, RW};
          pg8::EpiGateMul E{(bf16*)(F.ws + WS_TMP), D_, (const bf16*)(F.ws + WS_ZG), ZG_LD};
          pg8::gemm_phase<pg8::EpiGateMul, pg8::StaticOrder, PG8_ALIGN, PG8_SP2>(F.lds, g, S, E, F.wave); }
        __syncthreads();
        { pg8::Gemm g{(const pg8::bf16_t*)(F.ws + WS_YB), (const pg8::bf16_t*)(F.ws + WS_WPB), S_, D_, RW / 2};
          pg8::EpiGateAdd E{(const bf16*)(F.ws + WS_TMP), D_, (const bf16*)(F.ws + WS_ZG) + 4096, ZG_LD, (bf16*)(F.ws + WS_MERGED)};
          pg8::gemm_phase<pg8::EpiGateAdd, pg8::StaticOrder, PG8_ALIGN, PG8_SP2, true>(F.lds, g, S, E, F.wave); }
        __syncthreads();
    }
    SEAM(7);
    if (IN(8)) REP(8) {
        pg8::Gemm g{(const pg8::bf16_t*)(F.ws + WS_MERGED), (const pg8::bf16_t*)(F.ws + WS_WOUT), S_, D_, D_}; pg8::StaticOrder S; S.init(S_, D_, F.G, (int)blockIdx.x);
        pg8::EpiResNorm E{F.in[0], D_, (bf16*)(F.ws + WS_HN), (float*)(F.ws + WS_PSQ)};
        pg8::gemm_phase<pg8::EpiResNorm, pg8::StaticOrder, PG8_ALIGN, PG8_SP2>(F.lds, g, S, E, F.wave);
        __syncthreads();
    }
    SEAM(8);
    if (IN(10)) REP(10) {
        pg8::Gemm g{(const pg8::bf16_t*)(F.ws + WS_HN), (const pg8::bf16_t*)(F.ws + WS_WQ), S_, 2048, D_}; pg8::StaticOrder S; S.init(S_, 2048, F.G, (int)blockIdx.x);
        pg8::EpiBf16 E{(bf16*)(F.ws + WS_QRY), 2048};
        pg8::gemm_phase<pg8::EpiBf16, pg8::StaticOrder, PG8_ALIGN, PG8_SP2>(F.lds, g, S, E, F.wave);
        __syncthreads();
    }
    SEAM(10);
    if (IN(11)) { REP(11) { p11_route(F); } SEAM(11); }
    if (IN(12)) { REP(12) { p12_peer(F); } }
#undef IN
#undef SEAM
}

extern "C" void kernel_launch(void* const* d_in, const int* in_sizes, int n_in, void* d_out, int out_size, void* d_ws, size_t ws_size, hipStream_t stream) {
    static int grid = 0;
    if (grid == 0) {
        if (n_in != 23 || out_size != S_ * D_ || ws_size < WS_END) { fprintf(stderr, "kernel_launch: unexpected shapes: n_in %d out %d ws %zu (need %zu)\n", n_in, out_size, ws_size, (size_t)WS_END); grid = -1; return; }
        int dev = 0, cus = 0, per_cu = 0;
        if (hipGetDevice(&dev) != hipSuccess || hipDeviceGetAttribute(&cus, hipDeviceAttributeMultiprocessorCount, dev) != hipSuccess) { grid = -1; return; }
        if (hipFuncSetAttribute((const void*)mk_fwd, hipFuncAttributeMaxDynamicSharedMemorySize, LDS_BYTES) != hipSuccess) { fprintf(stderr, "kernel_launch: hipFuncSetAttribute failed\n"); grid = -1; return; }
        if (hipOccupancyMaxActiveBlocksPerMultiprocessor(&per_cu, (const void*)mk_fwd, NWAVES * 64, LDS_BYTES) != hipSuccess || per_cu < 1) { fprintf(stderr, "kernel_launch: occupancy query reports %d\n", per_cu); }
        (void)hipGetLastError();
        grid = cus;
        if (grid != 256) fprintf(stderr, "kernel_launch: %d CUs (built for 256)\n", grid);
    }
    if (grid < 0) return;
    if (hipMemsetAsync((char*)d_ws + WS_CTL, 0, CTL_ZERO_BYTES, stream) != hipSuccess) return;
    Args a{};
    for (int i = 0; i < 23; ++i) a.in[i] = (const float*)d_in[i];
    a.out = (float*)d_out; a.ws = (unsigned char*)d_ws;
#if MK_N_LAUNCHES == 1
    a.ph_lo = 0; a.ph_hi = N_PHASES; a.li = 0;
    hipLaunchKernelGGL(mk_fwd, dim3(grid), dim3(NWAVES * 64), LDS_BYTES, stream, a);
#else
    for (int p = 0; p < N_PHASES; ++p) { a.ph_lo = p; a.ph_hi = p + 1; a.li = 0; hipLaunchKernelGGL(mk_fwd, dim3(grid), dim3(NWAVES * 64), LDS_BYTES, stream, a); }
#endif
}
```

```cpp
#include <hip/hip_runtime.h>
#include <cstdio>
#include <cstdint>
__device__ __forceinline__ int fresh_lane() { int l; asm volatile("v_mbcnt_lo_u32_b32 %0, -1, 0\n\tv_mbcnt_hi_u32_b32 %0, -1, %0" : "=v"(l)); return l; }
namespace pg8 {
#define PG8_LAS __attribute__((address_space(3)))
typedef unsigned short bf16_t;
typedef short bf16x8 __attribute__((ext_vector_type(8)));
typedef float f32x4 __attribute__((ext_vector_type(4)));
typedef unsigned u32x4 __attribute__((ext_vector_type(4)));
constexpr int BM = 256, BK = 64, HALF = 128, HTB = HALF * BK * 2  , STAGE_BYTES = 8 * HTB, NXCD = 8, WGM = 8;

__host__ __device__ __forceinline__ int lds_byte(int r, int c) { const int st = (r >> 4) * 2 + (c >> 5), rr = r & 15, cc = c & 31, ob = rr * 64 + cc * 2; return st * 1024 + (ob ^ (((ob >> 9) & 1) << 5)); }
__host__ __device__ __forceinline__ void stage_rc(int b, int& R, int& C) { const int st = b / 1024, sb = b % 1024, swz = sb ^ (((sb >> 9) & 1) << 5); R = (st >> 1) * 16 + swz / 64; C = (st & 1) * 32 + (swz % 64) / 2; }
__host__ __device__ __forceinline__ int perm32(int rho) { const int n = rho >> 4, i = rho & 15; return 8 * (i >> 2) + 4 * n + (i & 3); }

struct Unit { int pm, pn; };
struct Gemm { const bf16_t* A; const bf16_t* Bt; int M, N, K; float dq = 0.f; };

struct StaticOrder {
    int nM, nN, nwg, G, c;
    __host__ __device__ void init(int M, int N, int G_, int c_) { nM = M / BM; nN = N / BM; nwg = nM * nN; G = G_; c = c_; }
    __host__ __device__ bool next(int i, Unit& u) const {
        const long L = (long)i * G + c; if (L >= nwg) return false;
        int wgid = (int)L; { const int q = nwg / NXCD, r = nwg % NXCD, xcd = wgid % NXCD, off = wgid / NXCD; wgid = (xcd < r ? xcd * (q + 1) : r * (q + 1) + (xcd - r) * q) + off; }
        const int nig = WGM * nN, gid = wgid / nig, fm = gid * WGM, gsz = (nM - fm) < WGM ? (nM - fm) : WGM;
        u.pm = fm + ((wgid % nig) % gsz); u.pn = (wgid % nig) / gsz; return true;
    }
    __device__ __forceinline__ void a_ready(const Unit&) const {}
    __device__ __forceinline__ void done(const Unit&) const {}
};


__device__ __forceinline__ unsigned cvt_pk_bf16(float lo, float hi) { unsigned r; asm volatile("v_cvt_pk_bf16_f32 %0, %1, %2" : "=v"(r) : "v"(lo), "v"(hi)); return r; }
typedef float f32x2 __attribute__((ext_vector_type(2)));
typedef unsigned u32x2 __attribute__((ext_vector_type(2)));
__device__ __forceinline__ float fast_sigmoid(float x) { return __builtin_amdgcn_rcpf(1.0f + __builtin_amdgcn_exp2f(-1.44269504089f * x)); }
__device__ __forceinline__ float bf_lo(unsigned w) { return __uint_as_float(w << 16); }
__device__ __forceinline__ float bf_hi(unsigned w) { return __uint_as_float(w & 0xffff0000u); }

struct EpiBf16 {
    static constexpr bool PERM = true, AFTER_DRAIN = false; static constexpr bool MIDK = false;
    bf16_t* O; int ldc;
    __device__ __forceinline__ void operator()(const f32x4 (&acc)[2][2][4][2], const Unit& u, int wr, int wc, int fr_, int fq_) const {
        const int l_ = fresh_lane(), fr = l_ & 15, fq = l_ >> 4;
        const int row0 = u.pm * BM + wr * 64 + fr, col0 = u.pn * BM + wc * 32 + 8 * fq;
#pragma unroll
        for (int ai = 0; ai < 2; ++ai)
#pragma unroll
            for (int m = 0; m < 4; ++m) { bf16_t* rowp = O + (size_t)(row0 + ai * HALF + m * 16) * ldc + col0;
#pragma unroll
                for (int bj = 0; bj < 2; ++bj) { const f32x4 v0 = acc[ai][bj][m][0], v1 = acc[ai][bj][m][1];
                    u32x4 w; w.x = cvt_pk_bf16(v0[0], v0[1]); w.y = cvt_pk_bf16(v0[2], v0[3]); w.z = cvt_pk_bf16(v1[0], v1[1]); w.w = cvt_pk_bf16(v1[2], v1[3]);
                    *(u32x4*)(rowp + bj * HALF) = w; } }
    }
};
struct EpiZ {
    static constexpr bool PERM = true, AFTER_DRAIN = false; static constexpr bool MIDK = false;
    bf16_t *ZR, *ZM, *ZG; int pn0;
    __device__ __forceinline__ void operator()(const f32x4 (&acc)[2][2][4][2], const Unit& u, int wr, int wc, int fr_, int fq_) const {
        const int l_ = fresh_lane(), fr = l_ & 15, fq = l_ >> 4;
        bf16_t* base; int ldc, colt; bool sig = false; const int pn = u.pn + pn0;
        if (pn < 26) { base = ZR; ldc = 6656; colt = pn * BM; }
        else if (pn < 50) { base = ZM; ldc = 6144; colt = (pn - 26) * BM; }
        else { base = ZG; ldc = 8192; colt = (pn - 50) * BM; sig = true; }
        const int row0 = u.pm * BM + wr * 64 + fr, col0 = colt + wc * 32 + 8 * fq;
#pragma unroll
        for (int ai = 0; ai < 2; ++ai)
#pragma unroll
            for (int m = 0; m < 4; ++m) { bf16_t* rowp = base + (size_t)(row0 + ai * HALF + m * 16) * ldc + col0;
#pragma unroll
                for (int bj = 0; bj < 2; ++bj) { f32x4 v0 = acc[ai][bj][m][0], v1 = acc[ai][bj][m][1];
                    if (sig) {
#pragma unroll
                        for (int j = 0; j < 4; ++j) { v0[j] = fast_sigmoid(v0[j]); v1[j] = fast_sigmoid(v1[j]); } }
                    u32x4 w; w.x = cvt_pk_bf16(v0[0], v0[1]); w.y = cvt_pk_bf16(v0[2], v0[3]); w.z = cvt_pk_bf16(v1[0], v1[1]); w.w = cvt_pk_bf16(v1[2], v1[3]);
                    *(u32x4*)(rowp + bj * HALF) = w; } }
    }
};
struct EpiLora {
    static constexpr bool PERM = true, AFTER_DRAIN = false; static constexpr bool MIDK = false;
    float *WDEC, *ICLR, *GG; const float *w0, *a0;
    __device__ __forceinline__ void operator()(const f32x4 (&acc)[2][2][4][2], const Unit& u, int wr, int wc, int fr_, int fq_) const {
        const int l_ = fresh_lane(), fr = l_ & 15, fq = l_ >> 4;
        const int mode = u.pn >> 3; float* base = WDEC + (size_t)mode * ((size_t)8192 * 2048);
        bf16_t* baseh = (bf16_t*)base;
        const int row0 = u.pm * BM + wr * 64 + fr, col0 = (u.pn & 7) * BM + wc * 32 + 8 * fq;
        const float* bp = mode == 0 ? w0 : a0;
#pragma unroll
        for (int ai = 0; ai < 2; ++ai)
#pragma unroll
            for (int m = 0; m < 4; ++m) { const size_t ro = (size_t)(row0 + ai * HALF + m * 16) * 2048 + col0;
#pragma unroll
                for (int bj = 0; bj < 2; ++bj) { f32x4 v0 = acc[ai][bj][m][0], v1 = acc[ai][bj][m][1];
                    if (mode < 2) { v0 += *(const f32x4*)(bp + col0 + bj * HALF); v1 += *(const f32x4*)(bp + col0 + bj * HALF + 4); }
                    if (mode == 0) {
#pragma unroll
                        for (int j = 0; j < 4; ++j) { const float x0 = -v0[j]; const float s0 = fmaxf(x0, 0.f) + __logf(1.0f + __expf(-fabsf(x0))); v0[j] = __expf(-__expf(-s0 - 0.5f));
                            const float x1 = -v1[j]; const float s1 = fmaxf(x1, 0.f) + __logf(1.0f + __expf(-fabsf(x1))); v1[j] = __expf(-__expf(-s1 - 0.5f)); } }
                    else if (mode == 1) {
#pragma unroll
                        for (int j = 0; j < 4; ++j) { v0[j] = fast_sigmoid(v0[j]); v1[j] = fast_sigmoid(v1[j]); } }
                    if (mode == 0) { *(f32x4*)(base + ro + bj * HALF) = v0; *(f32x4*)(base + ro + bj * HALF + 4) = v1; }
                    else { u32x4 w; w.x = cvt_pk_bf16(v0[0], v0[1]); w.y = cvt_pk_bf16(v0[2], v0[3]); w.z = cvt_pk_bf16(v1[0], v1[1]); w.w = cvt_pk_bf16(v1[2], v1[3]); *(u32x4*)(baseh + ro + bj * HALF) = w; } }
                asm volatile("" ::: "memory"); }
    }
};
struct EpiGateMul {
    static constexpr bool PERM = false, AFTER_DRAIN = false; static constexpr bool MIDK = false;
    bf16_t* T; int ldc; const bf16_t* G; int ldg;
    __device__ __forceinline__ void operator()(const f32x4 (&acc)[2][2][4][2], const Unit& u, int wr, int wc, int fr_, int fq_) const {
        const int l_ = fresh_lane(), fr = l_ & 15, fq = l_ >> 4;
        const int row0 = u.pm * BM + wr * 64 + fr, col0 = u.pn * BM + wc * 32 + 4 * fq;
#pragma unroll
        for (int ai = 0; ai < 2; ++ai)
#pragma unroll
            for (int m = 0; m < 4; ++m) { const size_t r = (size_t)(row0 + ai * HALF + m * 16);
#pragma unroll
                for (int bj = 0; bj < 2; ++bj)
#pragma unroll
                    for (int n = 0; n < 2; ++n) { const u32x2 g = *(const u32x2*)(G + r * ldg + col0 + bj * HALF + n * 16); const f32x4 a = acc[ai][bj][m][n];
                        u32x2 w; w.x = cvt_pk_bf16(a[0] * bf_lo(g.x), a[1] * bf_hi(g.x)); w.y = cvt_pk_bf16(a[2] * bf_lo(g.y), a[3] * bf_hi(g.y)); *(u32x2*)(T + r * ldc + col0 + bj * HALF + n * 16) = w; } }
    }
};
struct EpiGateAdd {
    static constexpr bool PERM = false, AFTER_DRAIN = false; static constexpr bool MIDK = false;
    const bf16_t* T; int ldc; const bf16_t* G; int ldg; bf16_t* O;
    __device__ __forceinline__ void operator()(const f32x4 (&acc)[2][2][4][2], const Unit& u, int wr, int wc, int fr_, int fq_) const {
        const int l_ = fresh_lane(), fr = l_ & 15, fq = l_ >> 4;
        const int row0 = u.pm * BM + wr * 64 + fr, col0 = u.pn * BM + wc * 32 + 4 * fq;
#pragma unroll
        for (int ai = 0; ai < 2; ++ai)
#pragma unroll
            for (int m = 0; m < 4; ++m) { const size_t r = (size_t)(row0 + ai * HALF + m * 16);
#pragma unroll
                for (int bj = 0; bj < 2; ++bj)
#pragma unroll
                    for (int n = 0; n < 2; ++n) { const u32x2 g = *(const u32x2*)(G + r * ldg + col0 + bj * HALF + n * 16); const f32x4 a = acc[ai][bj][m][n];
                        const u32x2 t = *(const u32x2*)(T + r * ldc + col0 + bj * HALF + n * 16);
                        int w8 = 0; w8 = __builtin_amdgcn_cvt_pk_fp8_f32(16.f * (bf_lo(t.x) + a[0] * bf_lo(g.x)), 16.f * (bf_hi(t.x) + a[1] * bf_hi(g.x)), w8, false); w8 = __builtin_amdgcn_cvt_pk_fp8_f32(16.f * (bf_lo(t.y) + a[2] * bf_lo(g.y)), 16.f * (bf_hi(t.y) + a[3] * bf_hi(g.y)), w8, true);
                        *(int*)((unsigned char*)O + r * ldc + col0 + bj * HALF + n * 16) = w8; }
                asm volatile("" ::: "memory"); }
    }
};
struct EpiGateFold {
    static constexpr bool PERM = false, AFTER_DRAIN = false; static constexpr bool MIDK = true;
    const bf16_t* G; int ldg; bf16_t* O; int ldc;
    __device__ __forceinline__ void mid(f32x4 (&acc)[2][2][4][2], const Unit& u, int wr, int wc) const {
        const int l_ = fresh_lane(), fr = l_ & 15, fq = l_ >> 4;
        const int row0 = u.pm * BM + wr * 64 + fr, col0 = u.pn * BM + wc * 32 + 4 * fq;
#pragma unroll
        for (int ai = 0; ai < 2; ++ai)
#pragma unroll
            for (int m = 0; m < 4; ++m) { const size_t r = (size_t)(row0 + ai * HALF + m * 16);
#pragma unroll
                for (int bj = 0; bj < 2; ++bj)
#pragma unroll
                    for (int n = 0; n < 2; ++n) { const u32x2 ga = *(const u32x2*)(G + r * ldg + col0 + bj * HALF + n * 16), gb = *(const u32x2*)(G + r * ldg + 4096 + col0 + bj * HALF + n * 16); f32x4 a = acc[ai][bj][m][n];
                        a[0] *= bf_lo(ga.x) * __builtin_amdgcn_rcpf(bf_lo(gb.x)); a[1] *= bf_hi(ga.x) * __builtin_amdgcn_rcpf(bf_hi(gb.x)); a[2] *= bf_lo(ga.y) * __builtin_amdgcn_rcpf(bf_lo(gb.y)); a[3] *= bf_hi(ga.y) * __builtin_amdgcn_rcpf(bf_hi(gb.y));
                        acc[ai][bj][m][n] = a; }
                asm volatile("" ::: "memory"); }
    }
    __device__ __forceinline__ void operator()(const f32x4 (&acc)[2][2][4][2], const Unit& u, int wr, int wc, int fr_, int fq_) const {
        const int l_ = fresh_lane(), fr = l_ & 15, fq = l_ >> 4;
        const int row0 = u.pm * BM + wr * 64 + fr, col0 = u.pn * BM + wc * 32 + 4 * fq;
#pragma unroll
        for (int ai = 0; ai < 2; ++ai)
#pragma unroll
            for (int m = 0; m < 4; ++m) { const size_t r = (size_t)(row0 + ai * HALF + m * 16);
#pragma unroll
                for (int bj = 0; bj < 2; ++bj)
#pragma unroll
                    for (int n = 0; n < 2; ++n) { const u32x2 g = *(const u32x2*)(G + r * ldg + 4096 + col0 + bj * HALF + n * 16); const f32x4 a = acc[ai][bj][m][n];
                        int w8 = 0; w8 = __builtin_amdgcn_cvt_pk_fp8_f32(16.f * (a[0] * bf_lo(g.x)), 16.f * (a[1] * bf_hi(g.x)), w8, false); w8 = __builtin_amdgcn_cvt_pk_fp8_f32(16.f * (a[2] * bf_lo(g.y)), 16.f * (a[3] * bf_hi(g.y)), w8, true);
                        *(int*)((unsigned char*)O + r * ldc + col0 + bj * HALF + n * 16) = w8; }
                asm volatile("" ::: "memory"); }
    }
};
struct EpiRes {
    static constexpr bool PERM = false, AFTER_DRAIN = false; static constexpr bool MIDK = false;
    float* C; const float* R; int ldc;
    __device__ __forceinline__ void operator()(const f32x4 (&acc)[2][2][4][2], const Unit& u, int wr, int wc, int fr_, int fq_) const {
        const int l_ = fresh_lane(), fr = l_ & 15, fq = l_ >> 4;
        const int row0 = u.pm * BM + wr * 64 + fr, col0 = u.pn * BM + wc * 32 + 4 * fq;
#pragma unroll
        for (int ai = 0; ai < 2; ++ai)
#pragma unroll
            for (int m = 0; m < 4; ++m) { const size_t r = (size_t)(row0 + ai * HALF + m * 16);
#pragma unroll
                for (int bj = 0; bj < 2; ++bj)
#pragma unroll
                    for (int n = 0; n < 2; ++n) { const size_t o = r * ldc + col0 + bj * HALF + n * 16; *(f32x4*)(C + o) = *(const f32x4*)(R + o) + acc[ai][bj][m][n]; } }
    }
};

struct EpiResNorm {
    static constexpr bool PERM = false, AFTER_DRAIN = false; static constexpr bool MIDK = false;
    const float* R; int ldc; bf16_t* HB; float* PSQ;
    __device__ __forceinline__ void operator()(const f32x4 (&acc)[2][2][4][2], const Unit& u, int wr, int wc, int fr_, int fq_) const {
        const int l_ = fresh_lane(), fr = l_ & 15, fq = l_ >> 4;
        const int row0 = u.pm * BM + wr * 64 + fr, col0 = u.pn * BM + wc * 32 + 4 * fq;
#pragma unroll
        for (int ai = 0; ai < 2; ++ai)
#pragma unroll
            for (int m = 0; m < 4; ++m) { const size_t r = (size_t)(row0 + ai * HALF + m * 16); float ss = 0.f;
#pragma unroll
                for (int bj = 0; bj < 2; ++bj)
#pragma unroll
                    for (int n = 0; n < 2; ++n) { const size_t o = r * ldc + col0 + bj * HALF + n * 16; const f32x4 c = *(const f32x4*)(R + o) + acc[ai][bj][m][n];
                        ss += (c[0] * c[0] + c[1] * c[1]) + (c[2] * c[2] + c[3] * c[3]);
                        u32x2 w; w.x = cvt_pk_bf16(c[0], c[1]); w.y = cvt_pk_bf16(c[2], c[3]); *(u32x2*)(HB + o) = w; }
                ss += __builtin_bit_cast(float, __builtin_amdgcn_ds_bpermute((l_ ^ 16) << 2, __builtin_bit_cast(int, ss)));
                ss += __builtin_bit_cast(float, __builtin_amdgcn_ds_bpermute((l_ ^ 32) << 2, __builtin_bit_cast(int, ss)));
                if (fq == 0) PSQ[r * 64 + u.pn * 4 + wc] = ss;
                asm volatile("" ::: "memory"); }
    }
};

typedef int i32x8 __attribute__((ext_vector_type(8)));
typedef int i32x4 __attribute__((ext_vector_type(4)));
template <class Epi, class Sched, bool ALIGN_EPI = false, bool SP2 = false, int F8 = 0>
__device__ __forceinline__ void gemm_phase(PG8_LAS unsigned char* lds, const Gemm g, const Sched& S, const Epi& E, int wid_) {
    const int wid = __builtin_amdgcn_readfirstlane(wid_), lane = fresh_lane(), tid = wid * 64 + lane, wr = wid >> 2, wc = wid & 3, fr = lane & 15, fq = lane >> 4;
    const int K = g.K, nt = K / BK;
    unsigned voffA, voffB;
    { int R, C; stage_rc(tid * 16, R, C); const int Rb = Epi::PERM ? ((R & ~31) + perm32(R & 31)) : R; voffA = (unsigned)(R * K + C) * 2u; voffB = (unsigned)(Rb * K + C) * 2u; }
    const size_t rstep64 = (size_t)64 * K * 2;
    const size_t kstep = (size_t)(BK * 2);
    const size_t hstep = (size_t)HALF * K * 2;
    const size_t tstep = 2 * hstep;
    const unsigned ldsw = (unsigned)wid * 1024u;
    const int aoff = lds_byte(wr * 64 + fr, fq * 8), boff = lds_byte(wc * 32 + fr, fq * 8);
#define PG8_SA(b, h) (((b) * 2 + (h)) * HTB)
#define PG8_SB(b, h) ((4 + (b) * 2 + (h)) * HTB)
#define PG8_STAGE(bufoff, gbase, voff) do { _Pragma("unroll") for (int _i = 0; _i < 2; ++_i) \
        __builtin_amdgcn_global_load_lds((const unsigned*)((const char*)(gbase) + _i * rstep64 + (voff)), (PG8_LAS unsigned*)(lds + (bufoff) + ldsw + _i * 8192), 16, 0, 0); } while (0)
#define PG8_LDA(dst, b, h) do { _Pragma("unroll") for (int m = 0; m < 4; ++m) { if constexpr (F8) { const i32x4 _lo = *(const PG8_LAS i32x4*)(lds + PG8_SA(b, h) + aoff + m * 2048), _hi = *(const PG8_LAS i32x4*)(lds + PG8_SA(b, h) + aoff + m * 2048 + 1024); dst##8[m] = __builtin_shufflevector(_lo, _hi, 0, 1, 2, 3, 4, 5, 6, 7); } \
        else { _Pragma("unroll") for (int k = 0; k < 2; ++k) dst[m][k] = *(const PG8_LAS bf16x8*)(lds + PG8_SA(b, h) + aoff + m * 2048 + k * 1024); } } } while (0)
#define PG8_LDB(dst, b, h) do { _Pragma("unroll") for (int n = 0; n < 2; ++n) { if constexpr (F8) { const i32x4 _lo = *(const PG8_LAS i32x4*)(lds + PG8_SB(b, h) + boff + n * 2048), _hi = *(const PG8_LAS i32x4*)(lds + PG8_SB(b, h) + boff + n * 2048 + 1024); dst##8[n] = __builtin_shufflevector(_lo, _hi, 0, 1, 2, 3, 4, 5, 6, 7); } \
        else { _Pragma("unroll") for (int k = 0; k < 2; ++k) dst[n][k] = *(const PG8_LAS bf16x8*)(lds + PG8_SB(b, h) + boff + n * 2048 + k * 1024); } } } while (0)
#define PG8_MMA(ai, bj, At, Bt) do { __builtin_amdgcn_s_setprio(1); _Pragma("unroll") for (int m = 0; m < 4; ++m) _Pragma("unroll") for (int n = 0; n < 2; ++n) { \
        if constexpr (F8 == 2) { i32x4 c_ = __builtin_bit_cast(i32x4, acc[ai][bj][m][n]); \
            c_ = __builtin_amdgcn_mfma_i32_16x16x64_i8(__builtin_shufflevector(Bt##8[n], Bt##8[n], 0, 1, 2, 3), __builtin_shufflevector(At##8[m], At##8[m], 0, 1, 2, 3), c_, 0, 0, 0); \
            c_ = __builtin_amdgcn_mfma_i32_16x16x64_i8(__builtin_shufflevector(Bt##8[n], Bt##8[n], 4, 5, 6, 7), __builtin_shufflevector(At##8[m], At##8[m], 4, 5, 6, 7), c_, 0, 0, 0); acc[ai][bj][m][n] = __builtin_bit_cast(f32x4, c_); } \
        else if constexpr (F8 == 1) acc[ai][bj][m][n] = __builtin_amdgcn_mfma_scale_f32_16x16x128_f8f6f4(Bt##8[n], At##8[m], acc[ai][bj][m][n], 0, 0, 0, 0x7b77, 1, 0x7b77); \
        else { _Pragma("unroll") for (int k = 0; k < 2; ++k) acc[ai][bj][m][n] = __builtin_amdgcn_mfma_f32_16x16x32_bf16(Bt[n][k], At[m][k], acc[ai][bj][m][n], 0, 0, 0); } } __builtin_amdgcn_s_setprio(0); } while (0)
#define PG8_WAIT_V(n) asm volatile("s_waitcnt vmcnt(" #n ")" ::: "memory")
#define PG8_WAIT_L(n) asm volatile("s_waitcnt lgkmcnt(" #n ")" ::: "memory")
#define PG8_BAR __builtin_amdgcn_s_barrier()
#define PG8_SCHED __builtin_amdgcn_sched_barrier(0)
    Unit cur, nxt; int ui = 0;
    if (!S.next(0, cur)) return;
    f32x4 acc[2][2][4][2];
#pragma unroll
    for (int a = 0; a < 2; ++a)
#pragma unroll
        for (int b = 0; b < 2; ++b)
#pragma unroll
            for (int m = 0; m < 4; ++m)
#pragma unroll
                for (int n = 0; n < 2; ++n) acc[a][b][m][n] = (f32x4){0.f, 0.f, 0.f, 0.f};
    bf16x8 At[4][2], B0[2][2], B1[2][2]; i32x8 At8[4], B08[2], B18[2];
    const char* cA = (const char*)g.A + (size_t)cur.pm * tstep; const char* cB = (const char*)g.Bt + (size_t)cur.pn * tstep;
    S.a_ready(cur);
    if constexpr (SP2) {
        PG8_STAGE(PG8_SB(0, 0), cB, voffB); PG8_STAGE(PG8_SB(0, 1), cB + hstep, voffB); PG8_STAGE(PG8_SA(0, 0), cA, voffA); PG8_STAGE(PG8_SA(0, 1), cA + hstep, voffA);
        if (wr == 1) PG8_BAR;
        PG8_WAIT_V(2); PG8_BAR;
        PG8_STAGE(PG8_SB(1, 0), cB + kstep, voffB); PG8_STAGE(PG8_SA(1, 0), cA + kstep, voffA); PG8_STAGE(PG8_SB(1, 1), cB + hstep + kstep, voffB);
        PG8_WAIT_V(6); PG8_BAR;
    } else {
        PG8_STAGE(PG8_SB(0, 0), cB, voffB); PG8_STAGE(PG8_SA(0, 0), cA, voffA); PG8_STAGE(PG8_SB(0, 1), cB + hstep, voffB); PG8_STAGE(PG8_SA(0, 1), cA + hstep, voffA);
        if (wr == 1) PG8_BAR;
        PG8_WAIT_V(4); PG8_BAR;
        PG8_STAGE(PG8_SB(1, 0), cB + kstep, voffB); PG8_STAGE(PG8_SA(1, 0), cA + kstep, voffA); PG8_STAGE(PG8_SB(1, 1), cB + hstep + kstep, voffB);
        PG8_WAIT_V(6); PG8_BAR;
    }
    for (;;) {
        const bool has_next = S.next(ui + 1, nxt);
        const char* nA = has_next ? (const char*)g.A + (size_t)nxt.pm * tstep : cA; const char* nB = has_next ? (const char*)g.Bt + (size_t)nxt.pn * tstep : cB;
        for (int t = 0; t < nt; t += 2) {
            if constexpr (Epi::MIDK) { if (t == (nt >> 1)) E.mid(acc, cur, wr, wc); }
            const bool last = (t == nt - 2);
            const char* a1 = cA + (size_t)(t + 1) * kstep;
            const char* a2 = last ? nA : cA + (size_t)(t + 2) * kstep; const char* b2 = last ? nB : cB + (size_t)(t + 2) * kstep;
            const char* a3 = a2 + kstep; const char* b3 = b2 + kstep;
            if (last && has_next) S.a_ready(nxt);
            if constexpr (SP2) {
            PG8_LDB(B0, 0, 0); PG8_LDB(B1, 0, 1); PG8_SCHED; PG8_LDA(At, 0, 0); PG8_STAGE(PG8_SA(1, 1), a1 + hstep, voffA);
            PG8_WAIT_V(8); PG8_WAIT_L(0); PG8_BAR; PG8_MMA(0, 0, At, B0); PG8_MMA(0, 1, At, B1); PG8_BAR; PG8_SCHED;
            PG8_LDA(At, 0, 1); PG8_STAGE(PG8_SB(0, 0), b2, voffB); PG8_STAGE(PG8_SB(0, 1), b2 + hstep, voffB); PG8_STAGE(PG8_SA(0, 0), a2, voffA);
            PG8_WAIT_V(8); PG8_WAIT_L(0); PG8_BAR; PG8_MMA(1, 0, At, B0); PG8_MMA(1, 1, At, B1); PG8_BAR; PG8_SCHED;
            PG8_LDB(B0, 1, 0); PG8_LDB(B1, 1, 1); PG8_SCHED; PG8_LDA(At, 1, 0); PG8_STAGE(PG8_SA(0, 1), a2 + hstep, voffA);
            PG8_WAIT_V(8); PG8_WAIT_L(0); PG8_BAR; PG8_MMA(0, 0, At, B0); PG8_MMA(0, 1, At, B1); PG8_BAR; PG8_SCHED;
            PG8_LDA(At, 1, 1); PG8_STAGE(PG8_SB(1, 0), b3, voffB); PG8_STAGE(PG8_SB(1, 1), b3 + hstep, voffB); PG8_STAGE(PG8_SA(1, 0), a3, voffA);
            PG8_WAIT_V(8); PG8_WAIT_L(0); PG8_BAR; PG8_MMA(1, 0, At, B0); PG8_MMA(1, 1, At, B1); PG8_BAR; PG8_SCHED;
            } else {
            PG8_LDB(B0, 0, 0); PG8_SCHED; PG8_LDA(At, 0, 0); PG8_STAGE(PG8_SA(1, 1), a1 + hstep, voffA);
            PG8_WAIT_L(8); PG8_BAR; PG8_WAIT_L(0); PG8_MMA(0, 0, At, B0); PG8_BAR; PG8_SCHED;
            PG8_LDB(B1, 0, 1); PG8_STAGE(PG8_SB(0, 0), b2, voffB);
            PG8_BAR; PG8_WAIT_L(0); PG8_MMA(0, 1, At, B1); PG8_BAR;
            PG8_LDA(At, 0, 1); PG8_STAGE(PG8_SA(0, 0), a2, voffA);
            PG8_BAR; PG8_WAIT_L(0); PG8_MMA(1, 0, At, B0); PG8_BAR; PG8_SCHED;
            PG8_STAGE(PG8_SB(0, 1), b2 + hstep, voffB);
            PG8_WAIT_V(6); PG8_BAR; PG8_MMA(1, 1, At, B1); PG8_BAR;
            PG8_LDB(B0, 1, 0); PG8_SCHED; PG8_LDA(At, 1, 0); PG8_STAGE(PG8_SA(0, 1), a2 + hstep, voffA);
            PG8_WAIT_L(8); PG8_BAR; PG8_WAIT_L(0); PG8_MMA(0, 0, At, B0); PG8_BAR; PG8_SCHED;
            PG8_LDB(B1, 1, 1); PG8_STAGE(PG8_SB(1, 0), b3, voffB);
            PG8_BAR; PG8_WAIT_L(0); PG8_MMA(0, 1, At, B1); PG8_BAR;
            PG8_LDA(At, 1, 1); PG8_STAGE(PG8_SA(1, 0), a3, voffA);
            PG8_BAR; PG8_WAIT_L(0); PG8_MMA(1, 0, At, B0); PG8_BAR; PG8_SCHED;
            PG8_STAGE(PG8_SB(1, 1), b3 + hstep, voffB);
            PG8_WAIT_V(6); PG8_BAR; PG8_MMA(1, 1, At, B1); PG8_BAR;
            }
        }
        if constexpr (ALIGN_EPI) { if (wr == 0) PG8_BAR; }
        if constexpr (F8 == 2) { const float dq_ = g.dq;
            _Pragma("unroll") for (int a_ = 0; a_ < 2; ++a_) _Pragma("unroll") for (int b_ = 0; b_ < 2; ++b_) _Pragma("unroll") for (int m_ = 0; m_ < 4; ++m_) _Pragma("unroll") for (int n_ = 0; n_ < 2; ++n_) { const i32x4 c_ = __builtin_bit_cast(i32x4, acc[a_][b_][m_][n_]);
                acc[a_][b_][m_][n_] = (f32x4){(float)c_.x * dq_, (float)c_.y * dq_, (float)c_.z * dq_, (float)c_.w * dq_}; } }
        if constexpr (!Epi::AFTER_DRAIN) { E(acc, cur, wr, wc, fr, fq); S.done(cur); }
        if (!has_next) break;
#pragma unroll
        for (int a = 0; a < 2; ++a)
#pragma unroll
            for (int b = 0; b < 2; ++b)
#pragma unroll
                for (int m = 0; m < 4; ++m)
#pragma unroll
                    for (int n = 0; n < 2; ++n) acc[a][b][m][n] = (f32x4){0.f, 0.f, 0.f, 0.f};
        cur = nxt; cA = nA; cB = nB; ++ui;
        if constexpr (ALIGN_EPI) { if (wr == 1) PG8_BAR; }
    }
    PG8_WAIT_V(0);
    if constexpr (!ALIGN_EPI) { if (wr == 0) PG8_BAR; }
    PG8_BAR;
    if constexpr (Epi::AFTER_DRAIN) { E.fused(acc, cur, wr, wc, fr, fq, lds, wid, lane); S.done(cur); }
#undef PG8_SA
#undef PG8_SB
#undef PG8_STAGE
#undef PG8_LDA
#undef PG8_LDB
#undef PG8_MMA
#undef PG8_WAIT_V
#undef PG8_WAIT_L
#undef PG8_BAR
#undef PG8_SCHED
}
}

#ifndef PG8_SP2
#define PG8_SP2 true
#endif
#ifndef PG8_ALIGN
#define PG8_ALIGN true
#endif

constexpr int S_ = 8192, D_ = 4096;
constexpr int RW = 2048, RH = 32, RN = 64;
constexpr int IN_COLS = 20864, RWKV_COLS = 6528;
constexpr int ZR_LD = 6656, ZM_LD = 6144, ZG_LD = 8192, ZN = ZR_LD + ZM_LD + ZG_LD;
constexpr int MH = 16, MD = 128, MBS = 256, MNB = 32;
constexpr int PH = 8, PNK = 128, PE = 16384, PT = 16;
constexpr int LORA_K = 384, LORA_N = 6144;
constexpr int SCAN_REC = 896;
constexpr int NWAVES = 8;
constexpr int N_PHASES = 13;
#ifndef MK_N_LAUNCHES
#define MK_N_LAUNCHES 1
#endif

constexpr size_t MiB = 1u << 20;
constexpr size_t WS_CTL = 0, CTL_ZERO_BYTES = 1 * MiB;
constexpr size_t WS_KMEAN = 1 * MiB;
constexpr size_t WS_SUBK = 2 * MiB;
constexpr size_t WS_LORABT = 3 * MiB;
constexpr size_t WS_LORAA = 8 * MiB;
constexpr size_t WS_PIDX = 14 * MiB;
constexpr size_t WS_PG = 18 * MiB;
constexpr size_t WS_BC = 22 * MiB;
constexpr size_t WS_WPA = 32 * MiB;
constexpr size_t WS_WPB = 48 * MiB;
constexpr size_t WS_WOUT = 64 * MiB;
constexpr size_t WS_WQ = 96 * MiB;
constexpr size_t WS_U8 = 112 * MiB;
constexpr size_t WS_V8 = 176 * MiB;
constexpr size_t WS_VSC = 240 * MiB;
constexpr size_t WS_USC = 244 * MiB;
constexpr size_t WS_PSQ = 8 * MiB;
constexpr size_t WS_WINT = 368 * MiB;
constexpr size_t WS_WINT8 = 368 * MiB;
constexpr size_t WS_XN8 = 476 * MiB;
constexpr size_t WS_XN = 532 * MiB;
constexpr size_t WS_WDEC = 432 * MiB;
constexpr size_t WS_ICLR = 496 * MiB;
constexpr size_t WS_GG = 560 * MiB;
constexpr size_t WS_PARTO = 432 * MiB;
constexpr size_t WS_PARTML = 692 * MiB;
constexpr size_t WS_MLIST = 23 * MiB;
constexpr size_t WS_YA = 368 * MiB;
constexpr size_t WS_YB = 400 * MiB;
constexpr size_t WS_HN8 = 368 * MiB;
constexpr size_t WS_HN = 564 * MiB;
constexpr size_t WS_ZR = 628 * MiB;
constexpr size_t WS_Y = 628 * MiB;
constexpr size_t WS_QRY = 692 * MiB;
constexpr size_t WS_ZM = 732 * MiB;
constexpr size_t WS_ZG = 828 * MiB;
constexpr size_t WS_SCAN = 956 * MiB;
constexpr size_t WS_TMP = 956 * MiB;
constexpr size_t WS_MERGED = 1084 * MiB;
constexpr size_t WS_END = 1180 * MiB;
constexpr size_t WS_H1R = 732 * MiB;

constexpr int CW_BAR = 4096;
constexpr int CW_MCNT = 16384;

constexpr int RING_BYTES = 131072;
constexpr int LDS_BYTES = 147456;
constexpr int LDSCTL_OFF = LDS_BYTES - 1024, MISC_OFF = LDSCTL_OFF + 320;

#define GAS __attribute__((address_space(1)))
#define LAS __attribute__((address_space(3)))
typedef unsigned short bf16;
typedef unsigned v4u __attribute__((ext_vector_type(4)));
typedef unsigned v2u __attribute__((ext_vector_type(2)));
typedef float f32x4 __attribute__((ext_vector_type(4)));
typedef float f32x2 __attribute__((ext_vector_type(2)));
typedef __bf16 bf2_t __attribute__((ext_vector_type(2)));
#define LDS_WAIT() asm volatile("s_waitcnt lgkmcnt(0)" ::: "memory")
#define VM_WAIT() asm volatile("s_waitcnt vmcnt(0)" ::: "memory")
__device__ __forceinline__ unsigned f2bf(float f) { unsigned u = __builtin_bit_cast(unsigned, f); return (u + 0x7fffu + ((u >> 16) & 1u)) >> 16; }
__device__ __forceinline__ unsigned pk2(float lo, float hi) { return f2bf(lo) | (f2bf(hi) << 16); }
__device__ __forceinline__ float bflo(unsigned w) { return __uint_as_float(w << 16); }
__device__ __forceinline__ float bfhi(unsigned w) { return __uint_as_float(w & 0xffff0000u); }
__device__ __forceinline__ f32x4 bf4(v2u w) { return (f32x4){bflo(w.x), bfhi(w.x), bflo(w.y), bfhi(w.y)}; }
__device__ __forceinline__ float bf1(bf16 h) { return __uint_as_float(((unsigned)h) << 16); }
__device__ __forceinline__ float dot2bf(unsigned a, unsigned b, float c) { return __builtin_amdgcn_fdot2_f32_bf16(__builtin_bit_cast(bf2_t, a), __builtin_bit_cast(bf2_t, b), c, false); }
__device__ __forceinline__ float sigmoidf_(float x) { return 1.0f / (1.0f + __expf(-x)); }

#define XB_TMO      128
#define XB_XCNT(j)  (256  + 64 * (j))
#define XB_XSUB(j)  (1280 + 64 * (j))
#define XB_XGEN(j)  (2304 + 64 * (j))
#define XB_TOP      3328
#define XB_TOPGEN   3392
#define XCD_BAR_WORDS 3456
#define XB_SPIN_CAP (1u << 18)
__device__ __forceinline__ unsigned xb_ld(unsigned* p)              { return __hip_atomic_load(p, __ATOMIC_RELAXED, __HIP_MEMORY_SCOPE_AGENT); }
__device__ __forceinline__ unsigned xb_add(unsigned* p, unsigned v) { return __hip_atomic_fetch_add(p, v, __ATOMIC_RELAXED, __HIP_MEMORY_SCOPE_AGENT); }
__device__ __forceinline__ unsigned xb_xcc_id() { return (unsigned)__builtin_amdgcn_s_getreg((3 << 11) | 20) & 0xFu; }
#define XB_SPIN(cond, bar) do { unsigned _sp = 0; while (cond) { __builtin_amdgcn_s_sleep(1); \
    if ((++_sp & 255u) == 0u) { if (xb_ld(&(bar)[XB_TMO])) break; if (_sp > XB_SPIN_CAP) { atomicAdd(&(bar)[XB_TMO], 1u); break; } } } } while (0)
struct XcdBarrier { unsigned* bar; unsigned x; volatile LAS unsigned* st; };
__device__ __forceinline__ XcdBarrier xcd_barrier_post(unsigned* bar, volatile LAS unsigned* st) {
    XcdBarrier b; b.bar = bar; b.x = xb_xcc_id(); b.st = st;
    if (threadIdx.x == 0) (void)xb_add(&bar[XB_XCNT(b.x)], 1u);
    return b;
}
__device__ __forceinline__ void xcd_barrier_complete(unsigned* bar, unsigned x, unsigned& nloc, unsigned& nx) {
    const unsigned G = gridDim.x * gridDim.y * gridDim.z;
    unsigned sum, cnt, mine, sp = 0u;
    for (;;) {
        sum = 0u; cnt = 0u; mine = 0u;
#pragma unroll
        for (unsigned j = 0; j < 16; ++j) { const unsigned c = xb_ld(&bar[XB_XCNT(j)]); sum += c; cnt += (c > 0u) ? 1u : 0u; mine = (j == x) ? c : mine; }
        if (sum == G) break;
        __builtin_amdgcn_s_sleep(1);
        if ((++sp & 255u) == 0u) { if (xb_ld(&bar[XB_TMO])) break; if (sp > XB_SPIN_CAP) { atomicAdd(&bar[XB_TMO], 1u); break; } }
    }
    nloc = mine > 0u ? mine : 1u; nx = cnt > 0u ? cnt : 1u;
}
__device__ __forceinline__ void xcd_barrier(const XcdBarrier& b) {
    asm volatile("s_waitcnt vmcnt(0)" ::: "memory");
    __syncthreads();
    if (threadIdx.x == 0) {
        unsigned* bar = b.bar;
        __builtin_amdgcn_s_waitcnt(0);
        unsigned nloc = b.st[0], nx = b.st[1];
        if (nloc == 0u) { xcd_barrier_complete(bar, b.x, nloc, nx); b.st[0] = nloc; b.st[1] = nx; }
        const unsigned old = xb_add(&bar[XB_XSUB(b.x)], 1u);
        const unsigned gen = old / nloc;
        if (old + 1u == (gen + 1u) * nloc) {
            __builtin_amdgcn_fence(__ATOMIC_RELEASE, "agent");
            asm volatile("s_waitcnt vmcnt(0)" ::: "memory");
            const unsigned og = xb_add(&bar[XB_TOP], 1u);
            const unsigned tg = og / nx;
            if (og + 1u == (tg + 1u) * nx) xb_add(&bar[XB_TOPGEN], 1u);
            else XB_SPIN(xb_ld(&bar[XB_TOPGEN]) == tg, bar);
            __builtin_amdgcn_fence(__ATOMIC_ACQUIRE, "agent");
            xb_add(&bar[XB_XGEN(b.x)], 1u);
            asm volatile("s_waitcnt vmcnt(0)" ::: "memory");
        } else {
            XB_SPIN(xb_ld(&bar[XB_XGEN(b.x)]) == gen, bar);
            __builtin_amdgcn_fence(__ATOMIC_ACQUIRE, "agent");
            asm volatile("s_waitcnt vmcnt(0)" ::: "memory");
        }
    }
    __syncthreads();
}

struct Frame {
    LAS unsigned char* lds;
    int tid, lane, wave, G, gw, NGW;
    const float* const* in;
    float* out;
    unsigned char* ws;
};
__device__ __forceinline__ float dpp_add16(float v) {
    v += __builtin_bit_cast(float, __builtin_amdgcn_update_dpp(0, __builtin_bit_cast(int, v), 0xB1, 0xF, 0xF, false));
    v += __builtin_bit_cast(float, __builtin_amdgcn_update_dpp(0, __builtin_bit_cast(int, v), 0x4E, 0xF, 0xF, false));
    v += __builtin_bit_cast(float, __builtin_amdgcn_update_dpp(0, __builtin_bit_cast(int, v), 0x141, 0xF, 0xF, false));
    v += __builtin_bit_cast(float, __builtin_amdgcn_update_dpp(0, __builtin_bit_cast(int, v), 0x140, 0xF, 0xF, false));
    return v;
}
__device__ __forceinline__ float dpp_max16(float v) {
    v = fmaxf(v, __builtin_bit_cast(float, __builtin_amdgcn_update_dpp(0, __builtin_bit_cast(int, v), 0xB1, 0xF, 0xF, false)));
    v = fmaxf(v, __builtin_bit_cast(float, __builtin_amdgcn_update_dpp(0, __builtin_bit_cast(int, v), 0x4E, 0xF, 0xF, false)));
    v = fmaxf(v, __builtin_bit_cast(float, __builtin_amdgcn_update_dpp(0, __builtin_bit_cast(int, v), 0x141, 0xF, 0xF, false)));
    v = fmaxf(v, __builtin_bit_cast(float, __builtin_amdgcn_update_dpp(0, __builtin_bit_cast(int, v), 0x140, 0xF, 0xF, false)));
    return v;
}
__device__ __forceinline__ float rdlane(float v, int l) { return __builtin_bit_cast(float, __builtin_amdgcn_readlane(__builtin_bit_cast(int, v), l)); }
__device__ __forceinline__ float wave_sum(float v) { v = dpp_add16(v); return (rdlane(v, 0) + rdlane(v, 16)) + (rdlane(v, 32) + rdlane(v, 48)); }
__device__ __forceinline__ float wave_max(float v) { v = dpp_max16(v); return fmaxf(fmaxf(rdlane(v, 0), rdlane(v, 16)), fmaxf(rdlane(v, 32), rdlane(v, 48))); }

__device__ __forceinline__ void p0_transpose_item(const float* W, int K, int N, bf16* WT, int row_add, LAS float* scr, int item, int lane, const float* kscale = nullptr) {
    const int nblk = N / 32, kb = item / nblk, nb = item % nblk, k0 = 64 * kb, n0 = 32 * nb;
#pragma unroll
    for (int i = 0; i < 32; ++i) { const int kk = 2 * i + (lane >> 5); const float wv = W[(size_t)(k0 + kk) * N + n0 + (lane & 31)]; scr[kk * 33 + (lane & 31)] = kscale ? wv * kscale[k0 + kk] : wv; }
    LDS_WAIT(); asm volatile("" ::: "memory");
    const int c = lane & 7;
#pragma unroll
    for (int j = 0; j < 4; ++j) { const int n = (lane >> 3) + 8 * j; const LAS float* s = scr + (8 * c) * 33 + n;
        v4u o; o.x = pk2(s[0 * 33], s[1 * 33]); o.y = pk2(s[2 * 33], s[3 * 33]); o.z = pk2(s[4 * 33], s[5 * 33]); o.w = pk2(s[6 * 33], s[7 * 33]);
        *(v4u*)(WT + (size_t)(row_add + n0 + n) * K + k0 + 8 * c) = o; }
    LDS_WAIT(); asm volatile("" ::: "memory");
}
__device__ __forceinline__ void rms_row_to_bf16(const float* xrow, const float* g, bf16* orow, int lane) {
    const f32x4* xr = (const f32x4*)xrow + lane; const f32x4* gr = (const f32x4*)g + lane;
    f32x4 v[16]; float s = 0.f;
#pragma unroll
    for (int j = 0; j < 16; ++j) { v[j] = xr[64 * j]; s += (v[j].x * v[j].x + v[j].y * v[j].y) + (v[j].z * v[j].z + v[j].w * v[j].w); }
    const float rs = 1.0f / sqrtf(wave_sum(s) * (1.f / D_) + 1e-6f);
    v2u* o8 = (v2u*)orow + lane;
#pragma unroll
    for (int j = 0; j < 16; ++j) { const f32x4 gg = gr[64 * j]; v2u w; w.x = pk2(v[j].x * rs * gg.x, v[j].y * rs * gg.y); w.y = pk2(v[j].z * rs * gg.z, v[j].w * rs * gg.w); o8[64 * j] = w; }
}
__device__ __forceinline__ unsigned pk4_fp8(float a, float b, float c, float d) { int w = 0; w = __builtin_amdgcn_cvt_pk_fp8_f32(a, b, w, false); w = __builtin_amdgcn_cvt_pk_fp8_f32(c, d, w, true); return (unsigned)w; }
constexpr float I8_SA = 25.0f, I8_SW = 1470.0f;
__device__ __forceinline__ unsigned pk4_i8(float a, float b, float c, float d) {
    const int q0 = (int)rintf(fminf(fmaxf(a, -127.f), 127.f)), q1 = (int)rintf(fminf(fmaxf(b, -127.f), 127.f)), q2 = (int)rintf(fminf(fmaxf(c, -127.f), 127.f)), q3 = (int)rintf(fminf(fmaxf(d, -127.f), 127.f));
    return (unsigned)(q0 & 0xff) | ((unsigned)(q1 & 0xff) << 8) | ((unsigned)(q2 & 0xff) << 16) | ((unsigned)q3 << 24);
}
__device__ __forceinline__ void rms_row_to_fp8(const float* xrow, const float* g, unsigned char* orow, int lane) {
    const f32x4* xr = (const f32x4*)xrow + lane; const f32x4* gr = (const f32x4*)g + lane;
    f32x4 v[16]; float s = 0.f;
#pragma unroll
    for (int j = 0; j < 16; ++j) { v[j] = xr[64 * j]; s += (v[j].x * v[j].x + v[j].y * v[j].y) + (v[j].z * v[j].z + v[j].w * v[j].w); }
    const float rs = 16.0f / sqrtf(wave_sum(s) * (1.f / D_) + 1e-6f);
    unsigned* o4 = (unsigned*)orow + lane;
#pragma unroll
    for (int j = 0; j < 16; ++j) { const f32x4 gg = gr[64 * j]; o4[64 * j] = pk4_fp8(v[j].x * rs * gg.x, v[j].y * rs * gg.y, v[j].z * rs * gg.z, v[j].w * rs * gg.w); }
}
__device__ __forceinline__ void rms_row_to_both(const float* xrow, const float* g, bf16* orow, unsigned char* orow8, int lane) {
    const f32x4* xr = (const f32x4*)xrow + lane; const f32x4* gr = (const f32x4*)g + lane;
    f32x4 v[16]; float s = 0.f;
#pragma unroll
    for (int j = 0; j < 16; ++j) { v[j] = xr[64 * j]; s += (v[j].x * v[j].x + v[j].y * v[j].y) + (v[j].z * v[j].z + v[j].w * v[j].w); }
    const float rs = 1.0f / sqrtf(wave_sum(s) * (1.f / D_) + 1e-6f);
    unsigned* o4 = (unsigned*)orow8 + lane; (void)orow;
#pragma unroll
    for (int j = 0; j < 16; ++j) { const f32x4 y = v[j] * rs * gr[64 * j]; o4[64 * j] = pk4_i8(y.x * I8_SA, y.y * I8_SA, y.z * I8_SA, y.w * I8_SA); }
}
__device__ __forceinline__ void p0_transpose_item_fp8(const float* W, int K, int N, unsigned char* WT, int row_add, LAS float* scr, int item, int lane) {
    const int nblk = N / 32, kb = item / nblk, nb = item % nblk, k0 = 64 * kb, n0 = 32 * nb;
#pragma unroll
    for (int i = 0; i < 32; ++i) { const int kk = 2 * i + (lane >> 5); scr[kk * 33 + (lane & 31)] = W[(size_t)(k0 + kk) * N + n0 + (lane & 31)]; }
    LDS_WAIT(); asm volatile("" ::: "memory");
    const int c = lane & 3;
#pragma unroll
    for (int j = 0; j < 2; ++j) { const int n = (lane >> 2) + 16 * j; const LAS float* s = scr + (16 * c) * 33 + n; v4u o;
        o.x = pk4_fp8(s[0 * 33] * 256.f, s[1 * 33] * 256.f, s[2 * 33] * 256.f, s[3 * 33] * 256.f); o.y = pk4_fp8(s[4 * 33] * 256.f, s[5 * 33] * 256.f, s[6 * 33] * 256.f, s[7 * 33] * 256.f);
        o.z = pk4_fp8(s[8 * 33] * 256.f, s[9 * 33] * 256.f, s[10 * 33] * 256.f, s[11 * 33] * 256.f); o.w = pk4_fp8(s[12 * 33] * 256.f, s[13 * 33] * 256.f, s[14 * 33] * 256.f, s[15 * 33] * 256.f);
        *(v4u*)(WT + (size_t)(row_add + n0 + n) * K + k0 + 16 * c) = o; }
    LDS_WAIT(); asm volatile("" ::: "memory");
}
template <int FP8> __device__ __forceinline__ void transpose_stream(const float* W, int K, int N, void* WT_, int split, int add, int ldt, int col_add, LAS float* scr, int it0, int its, int nitems, int lane, const float* kscale) {
    const int nblk = N / 32; float cur[32];
    if (it0 < nitems) { const int kb = it0 / nblk, nb = it0 % nblk;
#pragma unroll
        for (int i = 0; i < 32; ++i) cur[i] = W[(size_t)(64 * kb + 2 * i + (lane >> 5)) * N + 32 * nb + (lane & 31)]; }
    for (int it = it0; it < nitems; it += its) {
        float nxt[32]; const int itn = it + its;
        if (itn < nitems) { const int kb = itn / nblk, nb = itn % nblk;
#pragma unroll
            for (int i = 0; i < 32; ++i) nxt[i] = W[(size_t)(64 * kb + 2 * i + (lane >> 5)) * N + 32 * nb + (lane & 31)]; }
        else {
#pragma unroll
            for (int i = 0; i < 32; ++i) nxt[i] = 0.f; }
        const int kb = it / nblk, nb = it % nblk, k0 = 64 * kb, n0 = 32 * nb;
#pragma unroll
        for (int i = 0; i < 32; ++i) { const int kk = 2 * i + (lane >> 5); scr[kk * 33 + (lane & 31)] = kscale ? cur[i] * kscale[k0 + kk] : cur[i]; }
        LDS_WAIT(); asm volatile("" ::: "memory");
        if (FP8) { unsigned char* WT = (unsigned char*)WT_; const int c = lane & 3, row_add = n0 >= split ? add : 0;
#pragma unroll
            for (int j = 0; j < 2; ++j) { const int n = (lane >> 2) + 16 * j; const LAS float* sp = scr + (16 * c) * 33 + n; v4u o;
                if (FP8 == 2) { o.x = pk4_i8(sp[0 * 33] * I8_SW, sp[1 * 33] * I8_SW, sp[2 * 33] * I8_SW, sp[3 * 33] * I8_SW); o.y = pk4_i8(sp[4 * 33] * I8_SW, sp[5 * 33] * I8_SW, sp[6 * 33] * I8_SW, sp[7 * 33] * I8_SW);
                    o.z = pk4_i8(sp[8 * 33] * I8_SW, sp[9 * 33] * I8_SW, sp[10 * 33] * I8_SW, sp[11 * 33] * I8_SW); o.w = pk4_i8(sp[12 * 33] * I8_SW, sp[13 * 33] * I8_SW, sp[14 * 33] * I8_SW, sp[15 * 33] * I8_SW); }
                else {
                o.x = pk4_fp8(sp[0 * 33] * 256.f, sp[1 * 33] * 256.f, sp[2 * 33] * 256.f, sp[3 * 33] * 256.f); o.y = pk4_fp8(sp[4 * 33] * 256.f, sp[5 * 33] * 256.f, sp[6 * 33] * 256.f, sp[7 * 33] * 256.f);
                o.z = pk4_fp8(sp[8 * 33] * 256.f, sp[9 * 33] * 256.f, sp[10 * 33] * 256.f, sp[11 * 33] * 256.f); o.w = pk4_fp8(sp[12 * 33] * 256.f, sp[13 * 33] * 256.f, sp[14 * 33] * 256.f, sp[15 * 33] * 256.f); }
                *(v4u*)(WT + (size_t)(row_add + n0 + n) * (ldt ? ldt : K) + col_add + k0 + 16 * c) = o; } }
        else { bf16* WT = (bf16*)WT_; const int c = lane & 7;
#pragma unroll
            for (int j = 0; j < 4; ++j) { const int n = (lane >> 3) + 8 * j; const LAS float* sp = scr + (8 * c) * 33 + n;
                v4u o; o.x = pk2(sp[0 * 33], sp[1 * 33]); o.y = pk2(sp[2 * 33], sp[3 * 33]); o.z = pk2(sp[4 * 33], sp[5 * 33]); o.w = pk2(sp[6 * 33], sp[7 * 33]);
                *(v4u*)(WT + (size_t)(add + n0 + n) * ldt + col_add + k0 + 8 * c) = o; } }
        LDS_WAIT(); asm volatile("" ::: "memory");
#pragma unroll
        for (int i = 0; i < 32; ++i) cur[i] = nxt[i];
    }
}
__device__ __forceinline__ void cvt_straight(const float* src, bf16* dst, size_t n, size_t gt, size_t ngt) {
    for (size_t i = gt; i < n / 8; i += ngt) { const f32x4 a = ((const f32x4*)src)[2 * i], b = ((const f32x4*)src)[2 * i + 1];
        v4u o; o.x = pk2(a.x, a.y); o.y = pk2(a.z, a.w); o.z = pk2(b.x, b.y); o.w = pk2(b.z, b.w); ((v4u*)dst)[i] = o; }
}

__device__ __forceinline__ void quant_rows(const float* src, unsigned char* dst, float* scales, int nrows, int gw, int ngw, int lane) {
    for (int r = gw; r < nrows; r += ngw) {
        const f32x4* s4 = (const f32x4*)(src + (size_t)r * D_) + lane; f32x4 v[16]; float m = 0.f;
#pragma unroll
        for (int j = 0; j < 16; ++j) { v[j] = s4[64 * j]; m = fmaxf(fmaxf(m, fmaxf(fabsf(v[j].x), fabsf(v[j].y))), fmaxf(fabsf(v[j].z), fabsf(v[j].w))); }
        m = wave_max(m); const float inv = m > 0.f ? 127.0f / m : 0.f;
        unsigned* d4 = (unsigned*)(dst + (size_t)r * D_) + lane;
#pragma unroll
        for (int j = 0; j < 16; ++j) { const unsigned q0 = (unsigned)((int)rintf(v[j].x * inv) + 128), q1 = (unsigned)((int)rintf(v[j].y * inv) + 128), q2 = (unsigned)((int)rintf(v[j].z * inv) + 128), q3 = (unsigned)((int)rintf(v[j].w * inv) + 128);
            d4[64 * j] = q0 | (q1 << 8) | (q2 << 16) | (q3 << 24); }
        if (lane == 0) scales[r] = m * (1.0f / 127.0f);
    }
}
__device__ __forceinline__ unsigned fp6_code(float y) {
    const float a = fminf(fabsf(y), 7.5f);
    const int m = a < 2.0f ? (int)rintf(a * 8.0f) : (a < 4.0f ? 16 + (int)rintf((a - 2.0f) * 4.0f) : 24 + (int)rintf((a - 4.0f) * 2.0f));
    return (unsigned)m | (y < 0.f ? 32u : 0u);
}
__device__ __forceinline__ void quant_rows_fp6(const float* src, unsigned char* dst, float* scales, int nrows, int gw, int ngw, int lane) {
    for (int r = gw; r < nrows; r += ngw) {
        const f32x4* s4 = (const f32x4*)(src + (size_t)r * D_) + lane; f32x4 v[16]; float m = 0.f;
#pragma unroll
        for (int j = 0; j < 16; ++j) { v[j] = s4[64 * j]; m = fmaxf(fmaxf(m, fmaxf(fabsf(v[j].x), fabsf(v[j].y))), fmaxf(fabsf(v[j].z), fabsf(v[j].w))); }
        m = wave_max(m); const float inv = m > 0.f ? 7.5f / m : 0.f;
        const int k = lane & 3;
        unsigned* d4 = (unsigned*)(dst + (size_t)r * 192) + ((lane >> 4) * 12 + ((lane & 15) >> 2) * 3 + k);
#pragma unroll
        for (int j = 0; j < 16; ++j) {
            const unsigned P = fp6_code(v[j].x * inv) | (fp6_code(v[j].y * inv) << 6) | (fp6_code(v[j].z * inv) << 12) | (fp6_code(v[j].w * inv) << 18);
            const unsigned P0 = (unsigned)__builtin_amdgcn_update_dpp(0, (int)P, 0x00, 0xF, 0xF, false), P1 = (unsigned)__builtin_amdgcn_update_dpp(0, (int)P, 0x55, 0xF, 0xF, false);
            const unsigned P2 = (unsigned)__builtin_amdgcn_update_dpp(0, (int)P, 0xAA, 0xF, 0xF, false), P3 = (unsigned)__builtin_amdgcn_update_dpp(0, (int)P, 0xFF, 0xF, 0xF, false);
            const unsigned d0 = P0 | (P1 << 24), d1 = (P1 >> 8) | (P2 << 16), d2 = (P2 >> 16) | (P3 << 8);
            if (k < 3) d4[(size_t)j * (16384 * 48)] = k == 0 ? d0 : (k == 1 ? d1 : d2);
        }
        if (lane == 0) scales[r] = m * (1.0f / 7.5f);
    }
}
__device__ __forceinline__ void quant_rows4(const float* src, const float* cscale, unsigned char* dst, bf16* bscale, int nrows, int gw, int ngw, int lane) {
    for (int r = gw; r < nrows; r += ngw) {
        const f32x4* s4 = (const f32x4*)(src + (size_t)r * D_) + lane;
        unsigned* d4 = (unsigned*)(dst + (size_t)r * 128) + (lane >> 1);
        f32x4 vv[16];
#pragma unroll
        for (int j = 0; j < 16; ++j) vv[j] = s4[64 * j] * ((const f32x4*)cscale)[lane + 64 * j];
#pragma unroll
        for (int j = 0; j < 16; ++j) {
            const f32x4 v = vv[j];
            float m = fmaxf(fmaxf(fabsf(v.x), fabsf(v.y)), fmaxf(fabsf(v.z), fabsf(v.w)));
            m = fmaxf(m, __builtin_bit_cast(float, __builtin_amdgcn_update_dpp(0, __builtin_bit_cast(int, m), 0xB1, 0xF, 0xF, false)));
            m = fmaxf(m, __builtin_bit_cast(float, __builtin_amdgcn_update_dpp(0, __builtin_bit_cast(int, m), 0x4E, 0xF, 0xF, false)));
            m = fmaxf(m, __builtin_bit_cast(float, __builtin_amdgcn_update_dpp(0, __builtin_bit_cast(int, m), 0x141, 0xF, 0xF, false)));
            const unsigned sb = f2bf(m * (1.0f / 7.0f)); const float s = __uint_as_float(sb << 16); const float inv = s > 0.f ? 1.0f / s : 0.f;
            const int q0 = min(max((int)rintf(v.x * inv), -7), 7), q1 = min(max((int)rintf(v.y * inv), -7), 7), q2 = min(max((int)rintf(v.z * inv), -7), 7), q3 = min(max((int)rintf(v.w * inv), -7), 7);
            const unsigned P = (unsigned)(q0 + 8) | ((unsigned)(q1 + 8) << 8) | ((unsigned)(q2 + 8) << 16) | ((unsigned)(q3 + 8) << 24);
            const unsigned Q = (unsigned)__builtin_amdgcn_update_dpp(0, (int)P, 0xB1, 0xF, 0xF, false);
            if ((lane & 1) == 0) d4[(size_t)j * (16384 * 32)] = P | (Q << 4);
            if ((lane & 7) == 0) bscale[((size_t)j * 16384 + r) * 8 + (lane >> 3)] = (bf16)sb;
        }
    }
}
__device__ __forceinline__ void p0_prologue(Frame& F) {
    LAS float* scr = (LAS float*)(F.lds + F.wave * 16384);
    const float* w_in = F.in[2];
    constexpr int I_IN = (D_ / 64) * (IN_COLS / 32);
    transpose_stream<2>(w_in, D_, IN_COLS, F.ws + WS_WINT8, RWKV_COLS, 128, 0, 0, scr, F.gw, F.NGW, I_IN, F.lane, nullptr);
#if defined(PROBE_P0) && (PROBE_P0 & 1)
    transpose_stream<true>(w_in, D_, IN_COLS, F.ws + WS_WINT8, RWKV_COLS, 128, 0, 0, scr, F.gw, F.NGW, I_IN, F.lane, nullptr);
#endif
    const size_t gt = (size_t)blockIdx.x * 512 + F.tid, ngt = (size_t)F.G * 512;
    { v4u* p = (v4u*)(F.ws + WS_WINT8 + (size_t)RWKV_COLS * D_); const v4u z = {0u, 0u, 0u, 0u}; for (size_t i = gt; i < (size_t)128 * D_ / 16; i += ngt) p[i] = z; }
    { bf16* LB = (bf16*)(F.ws + WS_LORABT);
      transpose_stream<false>(F.in[5], 64, RW, LB, 0, 0, LORA_K, 0, scr, F.gw, F.NGW, 64, F.lane, nullptr);
      transpose_stream<false>(F.in[7], 64, RW, LB, 0, 2048, LORA_K, 64, scr, F.gw >= 64 ? F.gw - 64 : (1 << 30), F.NGW, 64, F.lane, nullptr);
      transpose_stream<false>(F.in[8], 256, RW, LB, 0, 4096, LORA_K, 128, scr, F.gw >= 128 ? F.gw - 128 : (1 << 30), F.NGW, 256, F.lane, nullptr);
      const v4u z = {0u, 0u, 0u, 0u};
      for (size_t i = gt; i < (size_t)LORA_N * (LORA_K / 8); i += ngt) { const int row = (int)(i / (LORA_K / 8)), g8c = (int)(i % (LORA_K / 8)) * 8, seg = row >> 11;
          const bool data = seg == 0 ? g8c < 64 : (seg == 1 ? (g8c >= 64 && g8c < 128) : g8c >= 128);
          if (!data) *(v4u*)(LB + (size_t)row * LORA_K + g8c) = z; } }
    for (int m = F.gw; m < S_; m += F.NGW) rms_row_to_both(F.in[0] + (size_t)m * D_, F.in[1], (bf16*)(F.ws + WS_XN) + (size_t)m * D_, F.ws + WS_XN8 + (size_t)m * D_, F.lane);
#if defined(PROBE_P0) && (PROBE_P0 & 2)
    for (int m = F.gw; m < S_; m += F.NGW) rms_row_to_both(F.in[0] + (size_t)m * D_, F.in[1], (bf16*)(F.ws + WS_XN) + (size_t)m * D_, F.ws + WS_XN8 + (size_t)m * D_, F.lane);
#endif
}

constexpr int QROWS_EARLY = 4096;
__device__ __forceinline__ void late_prep(Frame& F, int mgw, int mngw) {
    LAS float* scr = (LAS float*)(F.lds + F.wave * 16384);
    constexpr int I_PA = (RW / 64) * (D_ / 32), I_OUT = (D_ / 64) * (D_ / 32), I_Q = (D_ / 64) * (2048 / 32);
    transpose_stream<true>(F.in[14], RW, D_, F.ws + WS_WPA, 1 << 30, 0, 4096, 0, scr, mgw, mngw, I_PA, F.lane, nullptr);
    transpose_stream<true>(F.in[15], RW, D_, F.ws + WS_WPA, 1 << 30, 0, 4096, 2048, scr, mgw, mngw, I_PA, F.lane, nullptr);
    transpose_stream<true>(F.in[16], D_, D_, F.ws + WS_WOUT, 1 << 30, 0, 0, 0, scr, mgw, mngw, I_OUT, F.lane, nullptr);
    transpose_stream<false>(F.in[18], D_, 2048, F.ws + WS_WQ, 0, 0, D_, 0, scr, mgw, mngw, I_Q, F.lane, F.in[17]);
    quant_rows4(F.in[20], F.in[17], F.ws + WS_U8, (bf16*)(F.ws + WS_USC), PE, QROWS_EARLY + mgw, mngw, F.lane);
    quant_rows_fp6(F.in[21], F.ws + WS_V8, (float*)(F.ws + WS_VSC), PE, QROWS_EARLY + mgw, mngw, F.lane);
    cvt_straight(F.in[19], (bf16*)(F.ws + WS_SUBK), (size_t)16 * 128 * 128, (size_t)mgw * 64 + F.lane, (size_t)mngw * 64);
}

__device__ __forceinline__ void p2_prep(Frame& F) {
    const size_t gt = (size_t)blockIdx.x * 512 + F.tid, ngt = (size_t)F.G * 512;
    const bf16* ZR = (const bf16*)(F.ws + WS_ZR); const float* mu = F.in[3]; bf16* LA = (bf16*)(F.ws + WS_LORAA);
    for (size_t i = gt; i < (size_t)S_ * LORA_K; i += ngt) { const int t = (int)(i / LORA_K), c = (int)(i % LORA_K);
        const float zc = bf1(ZR[(size_t)t * ZR_LD + 6144 + c]), zp = t > 0 ? bf1(ZR[(size_t)(t - 1) * ZR_LD + 6144 + c]) : 0.f;
        const float zs = zc + (zp - zc) * mu[6144 + c];
        const float v = c < 64 ? tanhf(zs) : (c < 128 ? zs : sigmoidf_(zs));
        LA[i] = (bf16)f2bf(v); }
    const bf16* ZM = (const bf16*)(F.ws + WS_ZM); bf16* KMH = (bf16*)(F.ws + WS_KMEAN); bf16* KML = (bf16*)(F.ws + WS_KMEAN + 262144);
    LAS float* red = (LAS float*)F.lds;
    for (int item = blockIdx.x; item < MNB * 8; item += F.G) {
        const int j = item >> 3, cg = item & 7, col = cg * 256 + 4 * F.lane; f32x4 s = {0.f, 0.f, 0.f, 0.f};
        const bf16* zp = ZM + (size_t)(j * MBS + F.wave * 32) * ZM_LD + 2048 + col;
#pragma unroll 8
        for (int r = 0; r < 32; ++r) s += bf4(*(const v2u*)(zp + (size_t)r * ZM_LD));
        *(LAS f32x4*)(red + F.wave * 256 + 4 * F.lane) = s;
        __syncthreads();
        if (F.tid < 256) { float a = 0.f;
#pragma unroll
            for (int w = 0; w < 8; ++w) a += red[w * 256 + F.tid];
            a *= (1.0f / MBS); const int cc = cg * 256 + F.tid; const size_t o = ((size_t)(cc >> 7) * MNB + j) * MD + (cc & 127);
            const unsigned hi = f2bf(a); KMH[o] = (bf16)hi; KML[o] = (bf16)f2bf(a - __uint_as_float(hi << 16)); }
        __syncthreads();
    }
}

__device__ __forceinline__ void p4_rwkv_prep(Frame& F) {
    const bf16* ZR = (const bf16*)(F.ws + WS_ZR); const float* mu = F.in[3];
    const float* WDEC = (const float*)(F.ws + WS_WDEC); const bf16* ICLR = (const bf16*)(F.ws + WS_ICLR);
    const float* k_k = F.in[9]; const float* k_a = F.in[10]; const float* r_k = F.in[11];
    unsigned char* SC = F.ws + WS_SCAN; float* BC = (float*)(F.ws + WS_BC);
    const int hq = F.gw & 7, c = hq * 256 + 4 * F.lane, h = hq * 4 + (F.lane >> 4), q = F.lane & 15, tstep = F.NGW >> 3;
    const f32x4 mur = *(const f32x4*)(mu + c), muk = *(const f32x4*)(mu + 2048 + c), muv = *(const f32x4*)(mu + 4096 + c), kk4 = *(const f32x4*)(k_k + c), ka4 = *(const f32x4*)(k_a + c), rk4 = *(const f32x4*)(r_k + c);
    for (int tb = F.gw >> 3; tb < S_; tb += 4 * tstep) {
        v2u zcr[4], zck[4], zcv[4], zpr[4], zpk[4], zpv[4], ic[4]; f32x4 wd[4];
#pragma unroll
        for (int k = 0; k < 4; ++k) { const int t = tb + k * tstep; const v2u z0 = {0u, 0u};
            zcr[k] = zck[k] = zcv[k] = zpr[k] = zpk[k] = zpv[k] = ic[k] = z0; wd[k] = (f32x4){0.f, 0.f, 0.f, 0.f};
            if (t < S_) { const bf16* zc = ZR + (size_t)t * ZR_LD + c;
                zcr[k] = *(const v2u*)zc; zck[k] = *(const v2u*)(zc + 2048); zcv[k] = *(const v2u*)(zc + 4096);
                if (t > 0) { const bf16* zp = zc - ZR_LD; zpr[k] = *(const v2u*)zp; zpk[k] = *(const v2u*)(zp + 2048); zpv[k] = *(const v2u*)(zp + 4096); }
                ic[k] = *(const v2u*)(ICLR + (size_t)t * RW + c); wd[k] = *(const f32x4*)(WDEC + (size_t)t * RW + c); } }
#pragma unroll
        for (int k = 0; k < 4; ++k) { const int t = tb + k * tstep;
            if (t < S_) {
                const f32x4 rc = bf4(zcr[k]), kc = bf4(zck[k]), vc = bf4(zcv[k]);
                f32x4 rp = {0.f, 0.f, 0.f, 0.f}, kp = rp, vp = rp;
                if (t > 0) { rp = bf4(zpr[k]); kp = bf4(zpk[k]); vp = bf4(zpv[k]); }
                const f32x4 r = rc + (rp - rc) * mur, kx = kc + (kp - kc) * muk, v = vc + (vp - vc) * muv;
                const f32x4 iclr = bf4(ic[k]), w = wd[k];
                f32x4 kk = kx * kk4;
                const float ss = dpp_add16((kk.x * kk.x + kk.y * kk.y) + (kk.z * kk.z + kk.w * kk.w)); kk = kk * (1.0f / sqrtf(ss + 1e-12f));
                const f32x4 km = kx * (1.0f + (iclr - 1.0f) * ka4);
                const f32x4 rkr = r * km * rk4;
                const float bc = dpp_add16((rkr.x + rkr.y) + (rkr.z + rkr.w));
                unsigned char* rec = SC + ((size_t)h * S_ + t) * SCAN_REC;
                *(f32x4*)(rec + 16 * q) = w;
                const f32x4 a = -kk, b = kk * iclr;
                *(v2u*)(rec + 256 + 8 * q) = (v2u){pk2(r.x, r.y), pk2(r.z, r.w)};
                *(v2u*)(rec + 384 + 8 * q) = (v2u){pk2(km.x, km.y), pk2(km.z, km.w)};
                *(v2u*)(rec + 512 + 8 * q) = (v2u){pk2(v.x, v.y), pk2(v.z, v.w)};
                *(v2u*)(rec + 640 + 8 * q) = (v2u){pk2(a.x, a.y), pk2(a.z, a.w)};
                *(v2u*)(rec + 768 + 8 * q) = (v2u){pk2(b.x, b.y), pk2(b.z, b.w)};
                if (q == 0) BC[t * RH + h] = bc; } }
    }
}

constexpr int SC_T = 32;
#define SCAN_ISSUE(c_) do { const unsigned char* g_ = src + (size_t)(c_) * SC_T * SCAN_REC; _Pragma("unroll") for (int i = 0; i < 7; ++i) sx[i] = *(const v4u*)(g_ + (size_t)(pt + 256 * i) * 16); } while (0)
#define SCAN_COMMIT(c_) do { LAS float* dst_ = inb + ((c_) & 1) * (SC_T * 384); \
    _Pragma("unroll") for (int i = 0; i < 7; ++i) { const int p_ = pt + 256 * i, s_ = p_ / 56, pi_ = p_ % 56; LAS float* d_ = dst_ + s_ * 384; \
        if (pi_ < 16) *(LAS v4u*)(d_ + pi_ * 4) = sx[i]; \
        else { LAS float* dd_ = d_ + 64 + (pi_ - 16) * 8; \
            *(LAS f32x4*)dd_ = (f32x4){bflo(sx[i].x), bfhi(sx[i].x), bflo(sx[i].y), bfhi(sx[i].y)}; *(LAS f32x4*)(dd_ + 4) = (f32x4){bflo(sx[i].z), bfhi(sx[i].z), bflo(sx[i].w), bfhi(sx[i].w)}; } } } while (0)
__device__ __forceinline__ void scan_flush_y(const LAS float* yb, float* Y, int c, int pt, int colbase) {
    const LAS float* s = yb + (c & 1) * (SC_T * 16);
#pragma unroll
    for (int i = 0; i < 2; ++i) { const int idx = pt + 256 * i, st = idx >> 4, rr = idx & 15; Y[(size_t)(c * SC_T + st) * RW + colbase + rr] = s[idx]; }
}
__device__ __forceinline__ void p5_scan_block(Frame& F, int sb) {
    const int h = sb >> 2, rg = sb & 3;
    LAS float* inb = (LAS float*)F.lds;
    LAS float* yb = (LAS float*)(F.lds + 98304);
    const unsigned char* src = F.ws + WS_SCAN + (size_t)h * S_ * SCAN_REC;
    float* Y = (float*)(F.ws + WS_Y);
    const int pt = F.tid - 256, colbase = h * 64 + rg * 16;
    constexpr int NCH = S_ / SC_T;
    v4u sx[7];
    if (F.wave >= 4) { SCAN_ISSUE(0); SCAN_COMMIT(0); SCAN_ISSUE(1); }
    __syncthreads();
    const int q = F.lane & 15, rloc = 4 * F.wave + (F.lane >> 4);
    const bool b0 = (q & 1) != 0, b1 = (q & 2) != 0, b2 = (q & 4) != 0, b3 = (q & 8) != 0;
    const int qidx = (b0 ? 8 : 0) | (b1 ? 4 : 0) | (b2 ? 2 : 0) | (b3 ? 1 : 0);
    f32x2 Sa = {0.f, 0.f}, Sb = {0.f, 0.f};
    for (int c = 0; c < NCH; ++c) {
        if (F.wave < 4) {
            const LAS float* p = inb + (c & 1) * (SC_T * 384) + 4 * q; LAS float* yo = yb + (c & 1) * (SC_T * 16) + rloc;
            const LAS float* pv = inb + (c & 1) * (SC_T * 384) + 192 + rg * 16 + rloc;
            f32x4 w4 = *(const LAS f32x4*)(p), r4 = *(const LAS f32x4*)(p + 64), k4 = *(const LAS f32x4*)(p + 128), a4 = *(const LAS f32x4*)(p + 256), b4 = *(const LAS f32x4*)(p + 320); float vv = pv[0];
            f32x4 w5 = *(const LAS f32x4*)(p + 384), r5 = *(const LAS f32x4*)(p + 384 + 64), k5 = *(const LAS f32x4*)(p + 384 + 128), a5 = *(const LAS f32x4*)(p + 384 + 256), b5 = *(const LAS f32x4*)(p + 384 + 320); float v5 = pv[384];
            float yp[16];
#pragma unroll
            for (int s = 0; s < SC_T; ++s) {
                f32x4 nw = w5, nr = r5, nk = k5, na = a5, nb = b5; float nv = v5;
                if (s + 2 < SC_T) { nw = *(const LAS f32x4*)(p + (s + 2) * 384); nr = *(const LAS f32x4*)(p + (s + 2) * 384 + 64); nk = *(const LAS f32x4*)(p + (s + 2) * 384 + 128);
                    na = *(const LAS f32x4*)(p + (s + 2) * 384 + 256); nb = *(const LAS f32x4*)(p + (s + 2) * 384 + 320); nv = pv[(s + 2) * 384]; }
                const f32x2 pa = Sa * a4.lo + Sb * a4.hi;
                float sa = pa.x + pa.y;
                const f32x2 ta = Sa * w4.lo + k4.lo * vv, tb = Sb * w4.hi + k4.hi * vv;
                sa = dpp_add16(sa);
                Sa = ta + b4.lo * sa; Sb = tb + b4.hi * sa;
                const f32x2 py = Sa * r4.lo + Sb * r4.hi;
                yp[s & 15] = py.x + py.y;
                if ((s & 15) == 15) {
#define SCAN_RS(N_, SEL_, CTRL_) _Pragma("unroll") for (int i = 0; i < (N_); ++i) { const float keep = (SEL_) ? yp[2 * i + 1] : yp[2 * i], send = (SEL_) ? yp[2 * i] : yp[2 * i + 1]; \
                        yp[i] = keep + __builtin_bit_cast(float, __builtin_amdgcn_update_dpp(0, __builtin_bit_cast(int, send), (CTRL_), 0xF, 0xF, false)); }
                    SCAN_RS(8, b3, 0x128) SCAN_RS(4, b2, 0x141) SCAN_RS(2, b1, 0x1B) SCAN_RS(1, b0, 0xB1)
#undef SCAN_RS
                    yo[((s & 16) + qidx) * 16] = yp[0];
                }
                w4 = w5; r4 = r5; k4 = k5; a4 = a5; b4 = b5; vv = v5; w5 = nw; r5 = nr; k5 = nk; a5 = na; b5 = nb; v5 = nv;
            }
        } else {
            if (c + 1 < NCH) SCAN_COMMIT(c + 1);
            if (c + 2 < NCH) SCAN_ISSUE(c + 2);
            if (c > 0) scan_flush_y(yb, Y, c - 1, pt, colbase);
        }
        __syncthreads();
    }
    if (F.wave >= 4) scan_flush_y(yb, Y, NCH - 1, pt, colbase);
}

__device__ __forceinline__ int moba_list_off(int j) { return 8192 * j - 128 * j * (j + 1); }
constexpr int MLIST_HEAD = 126976;
__device__ __forceinline__ int dpp_min16i(int v) {
    v = min(v, __builtin_amdgcn_update_dpp(0, v, 0xB1, 0xF, 0xF, false));
    v = min(v, __builtin_amdgcn_update_dpp(0, v, 0x4E, 0xF, 0xF, false));
    v = min(v, __builtin_amdgcn_update_dpp(0, v, 0x141, 0xF, 0xF, false));
    v = min(v, __builtin_amdgcn_update_dpp(0, v, 0x140, 0xF, 0xF, false));
    return v;
}
typedef short gbf16x8 __attribute__((ext_vector_type(8)));
__device__ __forceinline__ void p4_moba_gate(Frame& F) {
    const bf16* ZM = (const bf16*)(F.ws + WS_ZM); const bf16* KMH = (const bf16*)(F.ws + WS_KMEAN); const bf16* KML = (const bf16*)(F.ws + WS_KMEAN + 262144);
    unsigned* CNT = (unsigned*)(F.ws + WS_CTL) + CW_MCNT; int* LIST = (int*)(F.ws + WS_MLIST);
    const int g = F.lane >> 4, l15 = F.lane & 15;
    for (int item = F.gw + 16 * MH; item < (S_ / 16) * MH; item += F.NGW) {
        const int tile = item >> 4, h = item & 15, t0 = tile * 16, blk = t0 >> 8;
        f32x4 acc[2] = {{0.f, 0.f, 0.f, 0.f}, {0.f, 0.f, 0.f, 0.f}};
#pragma unroll
        for (int ks = 0; ks < 4; ++ks) { const gbf16x8 a = *(const gbf16x8*)(ZM + (size_t)(t0 + l15) * ZM_LD + h * MD + 32 * ks + 8 * g);
#pragma unroll
            for (int nt = 0; nt < 2; ++nt) { const size_t o = ((size_t)h * MNB + l15 + 16 * nt) * MD + 32 * ks + 8 * g;
                acc[nt] = __builtin_amdgcn_mfma_f32_16x16x32_bf16(a, *(const gbf16x8*)(KMH + o), acc[nt], 0, 0, 0);
                acc[nt] = __builtin_amdgcn_mfma_f32_16x16x32_bf16(a, *(const gbf16x8*)(KML + o), acc[nt], 0, 0, 0); } }
#pragma unroll
        for (int r4 = 0; r4 < 4; ++r4) {
            float s0 = l15 < blk ? acc[0][r4] : -INFINITY, s1 = l15 + 16 < blk ? acc[1][r4] : -INFINITY;
            const int t = t0 + 4 * g + r4;
#pragma unroll
            for (int r = 0; r < 3; ++r) { const float m = dpp_max16(fmaxf(s0, s1));
                const int jm = (s0 == m) ? l15 : ((s1 == m) ? l15 + 16 : 99); const int jw = dpp_min16i(jm);
                if (m > -INFINITY && jm == jw) { const unsigned pos = atomicAdd(&CNT[(h * 32 + jw) * 16], 1u); LIST[(size_t)h * MLIST_HEAD + moba_list_off(jw) + pos] = t * 4 + r;
                    if (jw < 16) s0 = -INFINITY; else s1 = -INFINITY; } }
        }
    }
}
__device__ __forceinline__ int moba_off(int row, int ch) { return 256 * row + 16 * (ch ^ (((row & 3) << 2) | ((row >> 2) & 3))); }
typedef short bf16x8 __attribute__((ext_vector_type(8)));
typedef short s16x4 __attribute__((ext_vector_type(4)));
__device__ __forceinline__ void p5_moba_units(Frame& F, int mb, int nmb) {
    const bf16* ZM = (const bf16*)(F.ws + WS_ZM);
    const unsigned* CNT = (const unsigned*)(F.ws + WS_CTL) + CW_MCNT; const int* LIST = (const int*)(F.ws + WS_MLIST);
    bf16* PO = (bf16*)(F.ws + WS_PARTO); float* PML = (float*)(F.ws + WS_PARTML);
    LAS unsigned char* kv = F.lds;
    LAS unsigned char* pw = F.lds + 65536 + F.wave * 8448;
    LAS int* pref = (LAS int*)(F.lds + 133120);
    LAS int* nchs = pref + 520;
    if (F.tid < 512) nchs[F.tid] = (int)((CNT[F.tid * 16] + 127u) >> 7);
    __syncthreads();
    if (F.tid < 512) { int s = 0; for (int i = 0; i < F.tid; ++i) s += nchs[i]; pref[F.tid] = s; if (F.tid == 511) pref[512] = s + nchs[511]; }
    __syncthreads();
    const int U = 1024 + pref[512];
    const int g = F.lane >> 4, l15 = F.lane & 15;
    const float scale = 0.08838834764831845f;
#define MOBA_DECODE(u_, h_, j_, qb_, cnt_, own_, lst_) do { \
        if ((u_) < 1024) { own_ = 1; h_ = (u_) >> 6; j_ = ((u_) >> 1) & 31; qb_ = ((u_) & 1) * 128; cnt_ = 256; lst_ = LIST; } \
        else { own_ = 0; const int v_ = (u_) - 1024; int lo_ = 0, hi_ = 512; \
            while (hi_ - lo_ > 1) { const int mid_ = (lo_ + hi_) >> 1; if (pref[mid_] <= v_) lo_ = mid_; else hi_ = mid_; } \
            lo_ = __builtin_amdgcn_readfirstlane(lo_); h_ = lo_ >> 5; j_ = lo_ & 31; qb_ = __builtin_amdgcn_readfirstlane((v_ - pref[lo_]) * 128); cnt_ = __builtin_amdgcn_readfirstlane((int)CNT[lo_ * 16]); \
            lst_ = LIST + (size_t)h_ * MLIST_HEAD + moba_list_off(j_); } } while (0)
#define MOBA_LOADQ() do { const int q0_ = qb + F.wave * 16; \
        if (own) entA = ((j * 256 + q0_ + l15) << 2) | 3; else entA = (q0_ + l15 < cnt) ? lst[q0_ + l15] : -1; \
        const int tokA_ = entA >= 0 ? (entA >> 2) : 0; \
        _Pragma("unroll") for (int ks = 0; ks < 4; ++ks) qa[ks] = *(const v4u*)(ZM + (size_t)tokA_ * ZM_LD + h * MD + 32 * ks + 8 * g); \
        _Pragma("unroll") for (int i = 0; i < 8; ++i) { const int idx = F.tid + 512 * i; kx[i] = *(const v4u*)(ZM + (size_t)(j * 256 + (idx >> 4)) * ZM_LD + 2048 + h * MD + (idx & 15) * 8); } } while (0)
    int h = 0, j = 0, qb = 0, cnt = 0, own = 0; const int* lst = LIST; int entA = -1; v4u qa[4], kx[8];
    int stg, krd[4], vrd[2][8];
    { const int r0 = F.tid >> 4, chs = F.tid & 15; stg = 256 * r0 + 16 * (chs ^ (((r0 & 3) << 2) | ((r0 >> 2) & 3)));
      const int fk = ((l15 & 3) << 2) | ((l15 >> 2) & 3);
#pragma unroll
      for (int ks = 0; ks < 4; ++ks) krd[ks] = 256 * l15 + 16 * ((4 * ks + g) ^ fk);
      const int tq = l15 >> 2, tp = l15 & 3;
#pragma unroll
      for (int t = 0; t < 2; ++t) { const int fr = (tq << 2) | ((2 * g + t) & 3);
#pragma unroll
          for (int cc = 0; cc < 8; ++cc) vrd[t][cc] = 256 * (8 * g + 4 * t + tq) + 16 * ((2 * cc + (tp >> 1)) ^ fr) + 8 * (tp & 1); } }
    if (mb < U) { MOBA_DECODE(mb, h, j, qb, cnt, own, lst); MOBA_LOADQ(); }
    for (int u = mb; u < U; u += nmb) {
        const int ch = h, cj = j, cown = own; const bool active = qb + F.wave * 16 < cnt;
#pragma unroll
        for (int i = 0; i < 8; ++i) *(LAS v4u*)(kv + stg + 8192 * i) = kx[i];
        __syncthreads();
        v4u vst[8];
#pragma unroll
        for (int i = 0; i < 8; ++i) { const int idx = F.tid + 512 * i; vst[i] = *(const v4u*)(ZM + (size_t)(cj * 256 + (idx >> 4)) * ZM_LD + 4096 + ch * MD + (idx & 15) * 8); }
        float mrow[4], lrow[4]; int entR[4];
#pragma unroll
        for (int r = 0; r < 4; ++r) entR[r] = __shfl(entA, 4 * g + r);
        if (active) {
            f32x4 sacc[16];
#pragma unroll
            for (int nt = 0; nt < 16; ++nt) { sacc[nt] = (f32x4){0.f, 0.f, 0.f, 0.f};
#pragma unroll
                for (int ks = 0; ks < 4; ++ks) { const bf16x8 b = *(const LAS bf16x8*)(kv + krd[ks] + 4096 * nt);
                    sacc[nt] = __builtin_amdgcn_mfma_f32_16x16x32_bf16(__builtin_bit_cast(bf16x8, qa[ks]), b, sacc[nt], 0, 0, 0); } }
#pragma unroll
            for (int r = 0; r < 4; ++r) { const int tokr = entR[r] >> 2; float mx = -INFINITY;
#pragma unroll
                for (int nt = 0; nt < 16; ++nt) { float s = sacc[nt][r] * scale; if (cown && (cj * 256 + 16 * nt + l15) > tokr) s = -INFINITY; sacc[nt][r] = s; mx = fmaxf(mx, s); }
                mx = dpp_max16(mx); mrow[r] = mx; float sum = 0.f;
#pragma unroll
                for (int nt = 0; nt < 16; ++nt) { const float p = __expf(sacc[nt][r] - mx); sum += p; *(LAS bf16*)(pw + (4 * g + r) * 528 + (16 * nt + l15) * 2) = (bf16)f2bf(p); }
                lrow[r] = dpp_add16(sum); }
        }
        __syncthreads();
#pragma unroll
        for (int i = 0; i < 8; ++i) *(LAS v4u*)(kv + stg + 8192 * i) = vst[i];
        if (u + nmb < U) { MOBA_DECODE(u + nmb, h, j, qb, cnt, own, lst); MOBA_LOADQ(); }
        __syncthreads();
        if (active) {
            f32x4 oacc[8];
#pragma unroll
            for (int c = 0; c < 8; ++c) oacc[c] = (f32x4){0.f, 0.f, 0.f, 0.f};
#pragma unroll
            for (int ks = 0; ks < 8; ++ks) { const bf16x8 a = *(const LAS bf16x8*)(pw + l15 * 528 + (32 * ks + 8 * g) * 2);
#pragma unroll
                for (int c = 0; c < 8; ++c) {
                    const s16x4 t0 = __builtin_amdgcn_ds_read_tr16_b64_v4i16((LAS s16x4*)(kv + vrd[0][c] + 8192 * ks));
                    const s16x4 t1 = __builtin_amdgcn_ds_read_tr16_b64_v4i16((LAS s16x4*)(kv + vrd[1][c] + 8192 * ks));
                    const bf16x8 b = {t0.x, t0.y, t0.z, t0.w, t1.x, t1.y, t1.z, t1.w};
                    oacc[c] = __builtin_amdgcn_mfma_f32_16x16x32_bf16(a, b, oacc[c], 0, 0, 0); } }
#pragma unroll
            for (int r = 0; r < 4; ++r) if (entR[r] >= 0) { const int tok = entR[r] >> 2, slot = entR[r] & 3; const size_t base = ((size_t)(tok * MH + ch) * 4 + slot); const float inv = 1.0f / lrow[r];
#pragma unroll
                for (int c = 0; c < 8; ++c) PO[base * MD + 16 * c + l15] = (bf16)f2bf(oacc[c][r] * inv);
                if (l15 == 0) { PML[base * 2] = mrow[r]; PML[base * 2 + 1] = lrow[r]; } }
        }
        __syncthreads();
    }
#undef MOBA_DECODE
#undef MOBA_LOADQ
}
__device__ __forceinline__ void p6_moba_combine(Frame& F) {
    const bf16* PO = (const bf16*)(F.ws + WS_PARTO); const float* PML = (const float*)(F.ws + WS_PARTML); bf16* YB = (bf16*)(F.ws + WS_YA);
    for (int t = F.gw; t < S_; t += F.NGW) {
        const int h = F.lane >> 2, dq = F.lane & 3, blk = t >> 8, nsel = blk < 3 ? blk : 3; const size_t base = (size_t)(t * MH + h) * 4;
        const f32x4 ml0 = *(const f32x4*)(PML + base * 2), ml1 = *(const f32x4*)(PML + base * 2 + 4);
        v4u x[4][4];
#pragma unroll
        for (int s = 0; s < 4; ++s)
#pragma unroll
            for (int k = 0; k < 4; ++k) x[s][k] = *(const v4u*)(PO + (base + s) * MD + dq * 32 + k * 8);
        const float ms[4] = {ml0.x, ml0.z, ml1.x, ml1.z}, ls[4] = {ml0.y, ml0.w, ml1.y, ml1.w};
        float M = ms[3];
#pragma unroll
        for (int s = 0; s < 3; ++s) if (s < nsel) M = fmaxf(M, ms[s]);
        float wsum = 0.f, w[4];
#pragma unroll
        for (int s = 0; s < 4; ++s) { w[s] = (s == 3 || s < nsel) ? __expf(ms[s] - M) * ls[s] : 0.f; wsum += w[s]; }
        const float inv = 1.0f / wsum;
#pragma unroll
        for (int k = 0; k < 4; ++k) { float o[8] = {0.f, 0.f, 0.f, 0.f, 0.f, 0.f, 0.f, 0.f};
#pragma unroll
            for (int s = 0; s < 4; ++s) if (s == 3 || s < nsel) { const v4u v = x[s][k]; o[0] += w[s] * bflo(v.x); o[1] += w[s] * bfhi(v.x); o[2] += w[s] * bflo(v.y); o[3] += w[s] * bfhi(v.y); o[4] += w[s] * bflo(v.z); o[5] += w[s] * bfhi(v.z); o[6] += w[s] * bflo(v.w); o[7] += w[s] * bfhi(v.w); }
            const float i16 = inv * 16.0f; *(v2u*)((unsigned char*)YB + (size_t)t * 4096 + 2048 + h * MD + dq * 32 + k * 8) = (v2u){pk4_fp8(o[0] * i16, o[1] * i16, o[2] * i16, o[3] * i16), pk4_fp8(o[4] * i16, o[5] * i16, o[6] * i16, o[7] * i16)}; }
    }
}

__device__ __forceinline__ void p6_rwkv_post(Frame& F) {
    const float* Y = (const float*)(F.ws + WS_Y); const bf16* GG = (const bf16*)(F.ws + WS_GG); const float* BC = (const float*)(F.ws + WS_BC);
    const unsigned char* SC = F.ws + WS_SCAN; bf16* YA = (bf16*)(F.ws + WS_YA);
    const float* gn_w = F.in[12]; const float* gn_b = F.in[13];
    const int hq = F.gw & 7, c = hq * 256 + 4 * F.lane, h = hq * 4 + (F.lane >> 4), q = F.lane & 15, tstep = F.NGW >> 3;
    const f32x4 gw4 = *(const f32x4*)(gn_w + c), gb4 = *(const f32x4*)(gn_b + c);
    for (int tb = F.gw >> 3; tb < S_; tb += 4 * tstep) {
        f32x4 yy[4]; v2u vv[4], gg[4]; float bcv[4];
#pragma unroll
        for (int k = 0; k < 4; ++k) { const int t = tb + k * tstep; yy[k] = (f32x4){0.f, 0.f, 0.f, 0.f}; vv[k] = gg[k] = (v2u){0u, 0u}; bcv[k] = 0.f;
            if (t < S_) { yy[k] = *(const f32x4*)(Y + (size_t)t * RW + c); vv[k] = *(const v2u*)(SC + ((size_t)h * S_ + t) * SCAN_REC + 512 + 8 * q); gg[k] = *(const v2u*)(GG + (size_t)t * RW + c); bcv[k] = BC[t * RH + h]; } }
#pragma unroll
        for (int k = 0; k < 4; ++k) { const int t = tb + k * tstep;
            if (t < S_) {
                const f32x4 y = yy[k];
                const float mean = dpp_add16((y.x + y.y) + (y.z + y.w)) * (1.f / 64.f); const f32x4 d = y - mean;
                const float var = dpp_add16((d.x * d.x + d.y * d.y) + (d.z * d.z + d.w * d.w)) * (1.f / 64.f);
                const f32x4 yn = d * (1.0f / sqrtf(var + 64e-5f)) * gw4 + gb4;
                const f32x4 o = (yn + bcv[k] * bf4(vv[k])) * bf4(gg[k]);
                *(unsigned*)((unsigned char*)YA + (size_t)t * 4096 + c) = pk4_fp8(o.x * 16.f, o.y * 16.f, o.z * 16.f, o.w * 16.f); } }
    }
}

__device__ __forceinline__ void p9_norm(Frame& F) {
    for (int m = F.gw; m < S_; m += F.NGW) rms_row_to_bf16((const float*)(F.ws + WS_H1R) + (size_t)m * D_, F.in[17], (bf16*)(F.ws + WS_HN) + (size_t)m * D_, F.lane);
}

__device__ __forceinline__ float uniq_key(float s, int n) { return __uint_as_float((__float_as_uint(s) & ~0xffu) | (unsigned)(255 - n)); }
#define INS16(A_, X_) do { float x_ = (X_); _Pragma("unroll") for (int i_ = 0; i_ < 16; ++i_) { const float hi_ = fmaxf(A_[i_], x_); x_ = fminf(A_[i_], x_); A_[i_] = hi_; } } while (0)
__device__ __forceinline__ void p11_route(Frame& F) {
    const bf16* QRY = (const bf16*)(F.ws + WS_QRY); const bf16* SK = (const bf16*)(F.ws + WS_SUBK);
    int* PIDX = (int*)(F.ws + WS_PIDX); float* PGT = (float*)(F.ws + WS_PG);
    LAS float* sc = (LAS float*)(F.lds + F.wave * 16640);
    LAS int* ptab = (LAS int*)(F.lds + 8 * 16640);
    if (F.tid < 50) { const int l = F.tid; const int ci = l < 16 ? 0 : l < 24 ? 1 : l < 29 ? 2 : l < 33 ? 3 : l < 36 ? 4 : l < 38 ? 5 : l < 40 ? 6 : l < 42 ? 7 : l - 34;
        const int cj = l < 16 ? l : l < 24 ? l - 16 : l < 29 ? l - 24 : l < 33 ? l - 29 : l < 36 ? l - 33 : l < 38 ? l - 36 : l < 40 ? l - 38 : l < 42 ? l - 40 : 0; ptab[l] = ci * 16 + cj; }
    __syncthreads();
    const int g = F.lane >> 4, l15 = F.lane & 15;
    for (int item = F.gw; item < (S_ / 16) * PH; item += F.NGW) {
        const int tile = item >> 3, h = item & 7, t0 = tile * 16;
#pragma unroll
        for (int c = 0; c < 2; ++c) {
            f32x4 acc[8];
#pragma unroll
            for (int nt = 0; nt < 8; ++nt) acc[nt] = (f32x4){0.f, 0.f, 0.f, 0.f};
#pragma unroll
            for (int ks = 0; ks < 4; ++ks) { const gbf16x8 a = *(const gbf16x8*)(QRY + (size_t)(t0 + l15) * 2048 + h * 256 + c * 128 + 32 * ks + 8 * g);
#pragma unroll
                for (int nt = 0; nt < 8; ++nt) acc[nt] = __builtin_amdgcn_mfma_f32_16x16x32_bf16(a, *(const gbf16x8*)(SK + ((size_t)(h * 2 + c) * PNK + 16 * nt + l15) * 128 + 32 * ks + 8 * g), acc[nt], 0, 0, 0); }
#pragma unroll
            for (int nt = 0; nt < 8; ++nt)
#pragma unroll
                for (int r = 0; r < 4; ++r) sc[(c * 16 + 4 * g + r) * 129 + 16 * nt + l15] = acc[nt][r];
        }
        { LAS float* row = sc + (F.lane & 31) * 129; float a[16]; const int nb = (F.lane >> 5) * (PNK / 2);
#pragma unroll
            for (int i = 0; i < 16; ++i) a[i] = -INFINITY;
#pragma unroll 4
            for (int n = 0; n < PNK / 2; ++n) INS16(a, uniq_key(row[nb + n], nb + n));
            float o[16];
#pragma unroll
            for (int i = 0; i < 16; ++i) o[i] = __builtin_bit_cast(float, __builtin_amdgcn_ds_bpermute(((F.lane + 32) & 63) << 2, __builtin_bit_cast(int, a[i])));
#pragma unroll
            for (int i = 0; i < 16; ++i) INS16(a, o[i]);
          if (F.lane < 32) {
            float tv[16]; int ti[16];
#pragma unroll
            for (int i = 0; i < 16; ++i) { ti[i] = 255 - (int)(__float_as_uint(a[i]) & 255u); tv[i] = row[ti[i]]; }
#pragma unroll
            for (int i = 0; i < 16; ++i) { row[i] = tv[i]; row[16 + i] = __int_as_float(ti[i]); }
          } }
        if (F.lane < 16) {
            const LAS float* r0 = sc + F.lane * 129; const LAS float* r1 = sc + (16 + F.lane) * 129;
            float v0[16], v1[16];
#pragma unroll
            for (int i = 0; i < 16; ++i) { v0[i] = r0[i]; v1[i] = r1[i]; }
            float b[16];
#pragma unroll
            for (int i = 0; i < 16; ++i) b[i] = -INFINITY;
            { int p = 0;
#pragma unroll
              for (int i = 0; i < 16; ++i)
#pragma unroll
                  for (int j = 0; j < 16; ++j) if ((i + 1) * (j + 1) <= 16) { INS16(b, uniq_key(v0[i] + v1[j], p)); ++p; } }
            const int t = t0 + F.lane; float pv[16]; float den = 0.f; float mx = 0.f;
            float rsn; { const f32x4* pp = (const f32x4*)((const float*)(F.ws + WS_PSQ) + (size_t)t * 64); float q = 0.f;
#pragma unroll
              for (int k = 0; k < 16; ++k) { const f32x4 a4 = pp[k]; q += (a4.x + a4.y) + (a4.z + a4.w); }
              rsn = 1.0f / sqrtf(q * (1.f / D_) + 1e-6f); }
#pragma unroll
            for (int r = 0; r < 16; ++r) { const int p = 255 - (int)(__float_as_uint(b[r]) & 255u); const int ij = ptab[p]; const int ii = ij >> 4, jj = ij & 15;
                const float val = r0[ii] + r1[jj]; if (r == 0) mx = val; pv[r] = __expf((val - mx) * rsn); den += pv[r];
                PIDX[(size_t)t * 128 + h * PT + r] = __float_as_int(r0[16 + ii]) * PNK + __float_as_int(r1[16 + jj]); }
            const float inv = 1.0f / den;
#pragma unroll
            for (int r = 0; r < 16; ++r) PGT[(size_t)t * 128 + h * PT + r] = pv[r] * inv;
        }
    }
    __syncthreads();
}
#undef INS16

__device__ __forceinline__ float gelu_erf(float v) {
    const float av = fabsf(v), tt = __builtin_amdgcn_rcpf(av * 0.2316418882f + 1.0f);
    float q = tt * 0.5307027145f + (-0.7265760135f); q = q * tt + 0.7107068705f; q = q * tt + (-0.142248368f); q = q * tt + 0.127414796f; q = q * tt;
    const float e = __builtin_amdgcn_exp2f((v * v) * (-0.72134752044f));
    const float m = v * (q * e); return v < 0.f ? m : v - m;
}
__device__ __forceinline__ void p12_peer(Frame& F) {
    const bf16* HN = (const bf16*)(F.ws + WS_HN);
    const unsigned char* U4 = F.ws + WS_U8; const unsigned short* USS = (const unsigned short*)(F.ws + WS_USC); const unsigned char* V8 = F.ws + WS_V8; const float* VSC = (const float*)(F.ws + WS_VSC);
    const int* PIDX = (const int*)(F.ws + WS_PIDX); const float* PGT = (const float*)(F.ws + WS_PG); const float* PSQ = (const float*)(F.ws + WS_PSQ);
    const float* lnf = F.in[22];
    LAS unsigned char* XQ = F.lds + F.wave * 17408;
    LAS unsigned short* EL = (LAS unsigned short*)(XQ + 16384);
    LAS float* WL = (LAS float*)XQ;
    const int g8 = F.lane >> 3, k8 = F.lane & 7;
    float sx[4];
#pragma unroll
    for (int i = 0; i < 4; ++i) {
        const int t = F.gw + i * F.NGW; v4u xp[8]; float mxa = 0.f;
#pragma unroll
        for (int j = 0; j < 8; ++j) { xp[j] = ((const v4u*)(HN + (size_t)t * D_))[F.lane + 64 * j];
            mxa = fmaxf(fmaxf(fmaxf(mxa, fmaxf(fabsf(bflo(xp[j].x)), fabsf(bfhi(xp[j].x)))), fmaxf(fabsf(bflo(xp[j].y)), fabsf(bfhi(xp[j].y)))), fmaxf(fmaxf(fabsf(bflo(xp[j].z)), fabsf(bfhi(xp[j].z))), fmaxf(fabsf(bflo(xp[j].w)), fabsf(bfhi(xp[j].w))))); }
        mxa = wave_max(mxa); const float inv = mxa > 0.f ? 127.0f / mxa : 0.f;
        const float rsn = 1.0f / sqrtf(wave_sum(PSQ[(size_t)t * 64 + F.lane]) * (1.f / D_) + 1e-6f);
        sx[i] = mxa * rsn * (1.0f / 127.0f);
#pragma unroll
        for (int j = 0; j < 8; ++j) {
            const int q0 = (int)rintf(bflo(xp[j].x) * inv), q1 = (int)rintf(bfhi(xp[j].x) * inv), q2 = (int)rintf(bflo(xp[j].y) * inv), q3 = (int)rintf(bfhi(xp[j].y) * inv);
            const int q4 = (int)rintf(bflo(xp[j].z) * inv), q5 = (int)rintf(bfhi(xp[j].z) * inv), q6 = (int)rintf(bflo(xp[j].w) * inv), q7 = (int)rintf(bfhi(xp[j].w) * inv);
            *(LAS v2u*)(XQ + i * 4096 + 8 * (F.lane + 64 * j)) = (v2u){(unsigned)((q0 & 0xff) | ((q1 & 0xff) << 8) | ((q2 & 0xff) << 16) | (q3 << 24)), (unsigned)((q4 & 0xff) | ((q5 & 0xff) << 8) | ((q6 & 0xff) << 16) | (q7 << 24))}; }
        EL[i * 128 + F.lane] = (unsigned short)PIDX[(size_t)t * 128 + F.lane]; EL[i * 128 + 64 + F.lane] = (unsigned short)PIDX[(size_t)t * 128 + 64 + F.lane];
        asm volatile("" ::: "memory");
    }
    LDS_WAIT(); asm volatile("" ::: "memory");
    float psum[4][16];
#pragma unroll
    for (int i = 0; i < 4; ++i)
#pragma unroll
        for (int b = 0; b < 16; ++b) psum[i][b] = 0.f;
#define P12_U4(W_, XA_, XB_, ACC_) do { ACC_ = __builtin_amdgcn_sdot4((int)((W_) & 0x0F0F0F0Fu), (int)(XA_), ACC_, false); ACC_ = __builtin_amdgcn_sdot4((int)(((W_) >> 4) & 0x0F0F0F0Fu), (int)(XB_), ACC_, false); } while (0)
#define P12_ISSUE(c_, i_, h_, CW_, SC_) do { _Pragma("unroll") for (int bb = 0; bb < 8; ++bb) { const unsigned ro = (unsigned)(c_) * 16384u + (unsigned)EL[(i_) * 128 + ((h_) * 8 + bb) * 8 + g8]; \
        CW_[bb] = *(const v4u*)(U4 + (size_t)(ro * 128u + 16u * (unsigned)k8)); SC_[bb] = USS[(size_t)(ro * 8u + (unsigned)k8)]; } } while (0)
#define P12_XQ(c_, i_) do { xa = *(const LAS v4u*)(XQ + (i_) * 4096 + 256 * (c_) + 32 * k8); xb = *(const LAS v4u*)(XQ + (i_) * 4096 + 256 * (c_) + 32 * k8 + 16); \
        int xs = __builtin_amdgcn_sdot4((int)xa.x, 0x01010101, 0, false); xs = __builtin_amdgcn_sdot4((int)xa.y, 0x01010101, xs, false); xs = __builtin_amdgcn_sdot4((int)xa.z, 0x01010101, xs, false); xs = __builtin_amdgcn_sdot4((int)xa.w, 0x01010101, xs, false); \
        xs = __builtin_amdgcn_sdot4((int)xb.x, 0x01010101, xs, false); xs = __builtin_amdgcn_sdot4((int)xb.y, 0x01010101, xs, false); xs = __builtin_amdgcn_sdot4((int)xb.z, 0x01010101, xs, false); xs = __builtin_amdgcn_sdot4((int)xb.w, 0x01010101, xs, false); \
        xo = 8 * xs; } while (0)
#define P12_COMP(i_, h_, CW_, SC_) do { _Pragma("unroll") for (int bb = 0; bb < 8; ++bb) { int a0 = 0, a1 = 0; P12_U4(CW_[bb].x, xa.x, xa.y, a0); P12_U4(CW_[bb].y, xa.z, xa.w, a1); P12_U4(CW_[bb].z, xb.x, xb.y, a0); P12_U4(CW_[bb].w, xb.z, xb.w, a1); \
        psum[(i_)][(h_) * 8 + bb] += __uint_as_float(SC_[bb] << 16) * (float)((a0 + a1) - xo); } } while (0)
#define P12_BAR() asm volatile("" ::: "memory")
    { v4u cwA[8], cwB[8]; unsigned scA[8], scB[8]; v4u xa, xb; int xo;
      P12_ISSUE(0, 0, 0, cwA, scA);
_Pragma("nounroll")
      for (int c = 0; c < 16; ++c) { const int cn = c + 1 < 16 ? c + 1 : 15;
          P12_XQ(c, 0); P12_ISSUE(c, 0, 1, cwB, scB); P12_BAR(); P12_COMP(0, 0, cwA, scA); P12_ISSUE(c, 1, 0, cwA, scA); P12_BAR(); P12_COMP(0, 1, cwB, scB);
          P12_XQ(c, 1); P12_ISSUE(c, 1, 1, cwB, scB); P12_BAR(); P12_COMP(1, 0, cwA, scA); P12_ISSUE(c, 2, 0, cwA, scA); P12_BAR(); P12_COMP(1, 1, cwB, scB);
          P12_XQ(c, 2); P12_ISSUE(c, 2, 1, cwB, scB); P12_BAR(); P12_COMP(2, 0, cwA, scA); P12_ISSUE(c, 3, 0, cwA, scA); P12_BAR(); P12_COMP(2, 1, cwB, scB);
          P12_XQ(c, 3); P12_ISSUE(c, 3, 1, cwB, scB); P12_BAR(); P12_COMP(3, 0, cwA, scA); P12_ISSUE(cn, 0, 0, cwA, scA); P12_BAR(); P12_COMP(3, 1, cwB, scB);
      } }
#undef P12_ISSUE
#undef P12_XQ
#undef P12_COMP
#undef P12_BAR
#undef P12_U4
    asm volatile("" ::: "memory"); LDS_WAIT();
#pragma unroll
    for (int i = 0; i < 4; ++i) { const int t = F.gw + i * F.NGW;
#pragma unroll
        for (int b = 0; b < 16; ++b) { float d = psum[i][b];
            d += __builtin_bit_cast(float, __builtin_amdgcn_update_dpp(0, __builtin_bit_cast(int, d), 0xB1, 0xF, 0xF, false));
            d += __builtin_bit_cast(float, __builtin_amdgcn_update_dpp(0, __builtin_bit_cast(int, d), 0x4E, 0xF, 0xF, false));
            d += __builtin_bit_cast(float, __builtin_amdgcn_update_dpp(0, __builtin_bit_cast(int, d), 0x141, 0xF, 0xF, false));
            const int idx = b * 8 + g8; const float w = PGT[(size_t)t * 128 + idx] * gelu_erf(sx[i] * d) * VSC[EL[i * 128 + idx]];
            if (k8 == 0) WL[i * 128 + idx] = w; } }
    asm volatile("" ::: "memory"); LDS_WAIT();
    { typedef unsigned v3u_ __attribute__((ext_vector_type(3))); typedef unsigned v6u_ __attribute__((ext_vector_type(6))); typedef float v32f_ __attribute__((ext_vector_type(32)));
      const int eg = F.lane >> 4, cl = F.lane & 15; const bool hi5 = (F.lane & 32) != 0, hi4 = (F.lane & 16) != 0;
      LAS float* SSQ = (LAS float*)(XQ + 4096);
#pragma unroll
      for (int i = 0; i < 4; ++i) SSQ[i * 64 + F.lane] = 0.f;
#define P12_VISSUE(c_, i_, q_, D_X) do { _Pragma("unroll") for (int b = 0; b < 8; ++b) { const int idx = ((q_) * 8 + b) * 4 + eg; const unsigned ro = (unsigned)(c_) * 16384u + (unsigned)EL[(i_) * 128 + idx]; \
          const v3u_ ld_ = *(const v3u_*)(V8 + (size_t)(ro * 192u + 12u * (unsigned)cl)); if (b & 1) D_X[b >> 1].hi = ld_; else D_X[b >> 1].lo = ld_; } } while (0)
#define P12_VCOMP(i_, q_, D_X) do { _Pragma("unroll") for (int b = 0; b < 8; b += 2) { asm volatile("" : "+v"(D_X[b >> 1]));     \
          const float w0_ = WL[(i_) * 128 + ((q_) * 8 + b) * 4 + eg], w1_ = WL[(i_) * 128 + ((q_) * 8 + b + 1) * 4 + eg]; \
          const v32f_ f = __builtin_amdgcn_cvt_scalef32_pk32_f32_fp6(D_X[b >> 1], 1.0f); \
          _Pragma("unroll") for (int m = 0; m < 8; ++m) acc2[m] += (f32x2){f[2 * m], f[2 * m + 1]} * w0_; \
          _Pragma("unroll") for (int m = 0; m < 8; ++m) acc2[m] += (f32x2){f[16 + 2 * m], f[17 + 2 * m]} * w1_; asm volatile("" ::: "memory"); } } while (0)
      v6u_ dA[4], dB[4];
      P12_VISSUE(0, 0, 0, dA);
_Pragma("nounroll")
      for (int c = 0; c < 16; ++c) {
          int lo_ = 16 * cl + 4 * eg; asm volatile("" : "+v"(lo_));
_Pragma("nounroll")
          for (int i = 0; i < 4; ++i) { const int t = F.gw + i * F.NGW;
              f32x2 acc2[8];
#pragma unroll
              for (int m = 0; m < 8; ++m) acc2[m] = (f32x2){0.f, 0.f};
              const v2u hb = *(const v2u*)(HN + ((size_t)t * D_ + (size_t)(unsigned)(256 * c + lo_)));
              P12_VISSUE(c, i, 1, dB); asm volatile("" ::: "memory"); P12_VCOMP(i, 0, dA);
              P12_VISSUE(c, i, 2, dA); asm volatile("" ::: "memory"); P12_VCOMP(i, 1, dB);
              P12_VISSUE(c, i, 3, dB); asm volatile("" ::: "memory"); P12_VCOMP(i, 2, dA);
              { const int in_ = i + 1 < 4 ? i + 1 : 0, cn_ = i + 1 < 4 ? c : (c + 1 < 16 ? c + 1 : 15); P12_VISSUE(cn_, in_, 0, dA); } asm volatile("" ::: "memory"); P12_VCOMP(i, 3, dB);
              float r8[8], r4[4];
#pragma unroll
              for (int m = 0; m < 8; ++m) { const float lo_v = (m & 1) ? acc2[m >> 1].y : acc2[m >> 1].x, hi_v = (m & 1) ? acc2[4 + (m >> 1)].y : acc2[4 + (m >> 1)].x;
                  const float keep = hi5 ? hi_v : lo_v, send = hi5 ? lo_v : hi_v;
                  r8[m] = keep + __builtin_bit_cast(float, __builtin_amdgcn_ds_bpermute((F.lane ^ 32) << 2, __builtin_bit_cast(int, send))); }
#pragma unroll
              for (int m = 0; m < 4; ++m) { const float keep = hi4 ? r8[4 + m] : r8[m], send = hi4 ? r8[m] : r8[4 + m];
                  r4[m] = keep + __builtin_bit_cast(float, __builtin_amdgcn_ds_bpermute((F.lane ^ 16) << 2, __builtin_bit_cast(int, send))); }
              int lo3_ = lo_; asm volatile("" : "+v"(lo3_));
              const size_t col = (size_t)t * D_ + (size_t)(unsigned)(256 * c + lo3_);
              const f32x4 o = {r4[0] + bflo(hb.x), r4[1] + bfhi(hb.x), r4[2] + bflo(hb.y), r4[3] + bfhi(hb.y)};
              SSQ[i * 64 + F.lane] += (o.x * o.x + o.y * o.y) + (o.z * o.z + o.w * o.w);
              *(f32x4*)(F.out + col) = o;
          }
      }
#undef P12_VISSUE
#undef P12_VCOMP
      __builtin_amdgcn_fence(__ATOMIC_SEQ_CST, "agent");
      const int l2_ = fresh_lane(), lo2_ = 16 * (l2_ & 15) + 4 * (l2_ >> 4);
#pragma unroll
      for (int i = 0; i < 4; ++i) { const int t = F.gw + i * F.NGW;
          const float rs = 1.0f / sqrtf(wave_sum(SSQ[i * 64 + l2_]) * (1.f / D_) + 1e-6f);
_Pragma("nounroll")
          for (int c0 = 0; c0 < 16; c0 += 8) {
#pragma unroll
              for (int c = c0; c < c0 + 8; ++c) { const size_t col = (size_t)t * D_ + (size_t)(unsigned)(256 * c + lo2_); const f32x4 gn = *(const f32x4*)(lnf + (256 * c + lo2_));
                  const f32x4 o = *(const f32x4*)(F.out + col);
                  *(f32x4*)(F.out + col) = (f32x4){o.x * rs * gn.x, o.y * rs * gn.y, o.z * rs * gn.z, o.w * rs * gn.w}; }
              asm volatile("" ::: "memory"); } }
    }
}

struct Args { const float* in[23]; float* out; unsigned char* ws; int ph_lo, ph_hi, li, pad; };
__global__ void __launch_bounds__(NWAVES * 64, 2) mk_fwd(Args args) {
    extern __shared__ __attribute__((aligned(16))) unsigned char lds[];
    Frame F;
    F.lds = (LAS unsigned char*)lds;
    F.tid = threadIdx.x; F.lane = F.tid & 63; F.wave = __builtin_amdgcn_readfirstlane(F.tid >> 6);
    F.G = gridDim.x; F.gw = blockIdx.x * NWAVES + F.wave; F.NGW = F.G * NWAVES;
    F.in = args.in; F.out = args.out; F.ws = args.ws;
    volatile LAS unsigned* MISC = (volatile LAS unsigned*)(F.lds + MISC_OFF);
    for (int u = F.tid; u < (LDS_BYTES - LDSCTL_OFF) / 4; u += NWAVES * 64) ((LAS unsigned*)(F.lds + LDSCTL_OFF))[u] = 0u;
    __syncthreads();
    unsigned* ctl = (unsigned*)(F.ws + WS_CTL);
    XcdBarrier bar; bar.bar = ctl + CW_BAR + args.li * XCD_BAR_WORDS; bar.x = 0; bar.st = nullptr;
    const int lo = args.ph_lo, hi = args.ph_hi;
    if (hi - lo > 1) bar = xcd_barrier_post(ctl + CW_BAR + args.li * XCD_BAR_WORDS, MISC + 8);
#define IN(k) ((lo <= (k) && (k) < hi) && (F.lane = fresh_lane(), F.tid = F.wave * 64 + F.lane, true))
#ifndef PROBE_DUP
#define PROBE_DUP 0
#endif
#define REP(k) _Pragma("unroll") for (int _r = 0; _r < ((((PROBE_DUP) >> (k)) & 1) ? 2 : 1); ++_r)
#define SEAM(k) do { if (IN(k) && IN((k) + 1)) xcd_barrier(bar); } while (0)

    if (IN(0)) { REP(0) { p0_prologue(F); __syncthreads(); } SEAM(0); }
    if (IN(1)) REP(1) {
        { pg8::Gemm g{(const pg8::bf16_t*)(F.ws + WS_XN8), (const pg8::bf16_t*)(F.ws + WS_WINT8), S_, 20992, D_ / 2, 1.0f / (I8_SA * I8_SW)};     pg8::StaticOrder S; S.init(S_, 20992, F.G, (int)blockIdx.x);
          pg8::EpiZ E{(bf16*)(F.ws + WS_ZR), (bf16*)(F.ws + WS_ZM), (bf16*)(F.ws + WS_ZG), 0};
          pg8::gemm_phase<pg8::EpiZ, pg8::StaticOrder, PG8_ALIGN, PG8_SP2, 2>(F.lds, g, S, E, F.wave); }
        __syncthreads();
        if (F.G == 256 && blockIdx.x >= 64) {
            F.lane = fresh_lane(); const int qw = ((int)blockIdx.x - 64) * NWAVES + F.wave, qn = 192 * NWAVES;
            quant_rows4(F.in[20], F.in[17], F.ws + WS_U8, (bf16*)(F.ws + WS_USC), QROWS_EARLY, qw, qn, F.lane);
            quant_rows_fp6(F.in[21], F.ws + WS_V8, (float*)(F.ws + WS_VSC), QROWS_EARLY, qw, qn, F.lane);
        } else if (F.G != 256 && blockIdx.x == 0) { for (int w = F.wave; w < NWAVES; w += NWAVES) { quant_rows4(F.in[20], F.in[17], F.ws + WS_U8, (bf16*)(F.ws + WS_USC), QROWS_EARLY, w, NWAVES, F.lane); quant_rows_fp6(F.in[21], F.ws + WS_V8, (float*)(F.ws + WS_VSC), QROWS_EARLY, w, NWAVES, F.lane); } }
    }
    SEAM(1);
    if (IN(2)) { REP(2) { p2_prep(F); } SEAM(2); }
    if (IN(3)) REP(3) {
        pg8::Gemm g{(const pg8::bf16_t*)(F.ws + WS_LORAA), (const pg8::bf16_t*)(F.ws + WS_LORABT), S_, LORA_N, LORA_K}; pg8::StaticOrder S; S.init(S_, LORA_N, F.G, (int)blockIdx.x);
        pg8::EpiLora E{(float*)(F.ws + WS_WDEC), (float*)(F.ws + WS_ICLR), (float*)(F.ws + WS_GG), F.in[4], F.in[6]};
        pg8::gemm_phase<pg8::EpiLora, pg8::StaticOrder, PG8_ALIGN, PG8_SP2>(F.lds, g, S, E, F.wave);
        __syncthreads();
    }
    SEAM(3);
    if (IN(4)) { REP(4) { p4_rwkv_prep(F); } p4_moba_gate(F); SEAM(4); }
    if (IN(5)) {
        if (F.G >= 256) { if (blockIdx.x < 128) { p5_scan_block(F, blockIdx.x);
#if PROBE_DUP & 0x10000
            __syncthreads(); p5_scan_block(F, blockIdx.x);
#endif
            } else { p5_moba_units(F, blockIdx.x - 128, F.G - 128); __syncthreads(); late_prep(F, (blockIdx.x - 128) * NWAVES + F.wave, (F.G - 128) * NWAVES);
#if PROBE_DUP & 0x20000
            __syncthreads(); p5_moba_units(F, blockIdx.x - 128, F.G - 128);
#endif
            } __syncthreads(); }
        SEAM(5);
    }
    if (IN(6)) { REP(6) { p6_rwkv_post(F); p6_moba_combine(F); } SEAM(6); }
    if (IN(7)) REP(7) {
        pg8::StaticOrder S; S.init(S_, D_, F.G, (int)blockIdx.x);
        { pg8::Gemm g{(const pg8::bf16_t*)(F.ws + WS_YA), (const pg8::bf16_t*)(F.ws + WS_WPA), S_, D_, 2048};
          pg8::EpiGateFold E{(const bf16*)(F.ws + WS_ZG), ZG_LD, (bf16*)(F.ws + WS_MERGED), D_};
          pg8::gemm_phase<pg8::EpiGateFold, pg8::StaticOrder, PG8_ALIGN, PG8_SP2, 1>(F.lds, g, S, E, F.wave); }
        __syncthreads();
    }
    SEAM(7);
    if (IN(8)) REP(8) {
        pg8::Gemm g{(const pg8::bf16_t*)(F.ws + WS_MERGED), (const pg8::bf16_t*)(F.ws + WS_WOUT), S_, D_, D_ / 2};   pg8::StaticOrder S; S.init(S_, D_, F.G, (int)blockIdx.x);
        pg8::EpiResNorm E{F.in[0], D_, (bf16*)(F.ws + WS_HN), (float*)(F.ws + WS_PSQ)};
        pg8::gemm_phase<pg8::EpiResNorm, pg8::StaticOrder, PG8_ALIGN, PG8_SP2, true>(F.lds, g, S, E, F.wave);
        __syncthreads();
    }
    SEAM(8);
    if (IN(10)) REP(10) {
        pg8::Gemm g{(const pg8::bf16_t*)(F.ws + WS_HN), (const pg8::bf16_t*)(F.ws + WS_WQ), S_, 2048, D_}; pg8::StaticOrder S; S.init(S_, 2048, F.G, (int)blockIdx.x);
        pg8::EpiBf16 E{(bf16*)(F.ws + WS_QRY), 2048};
        pg8::gemm_phase<pg8::EpiBf16, pg8::StaticOrder, PG8_ALIGN, PG8_SP2>(F.lds, g, S, E, F.wave);
        __syncthreads();
    }
    SEAM(10);
    if (IN(11)) { REP(11) { p11_route(F); } SEAM(11); }
    if (IN(12)) { REP(12) { p12_peer(F); } }
#undef IN
#undef SEAM
}

extern "C" void kernel_launch(void* const* d_in, const int* in_sizes, int n_in, void* d_out, int out_size, void* d_ws, size_t ws_size, hipStream_t stream) {
    static int grid = 0;
    if (grid == 0) {
        if (n_in != 23 || out_size != S_ * D_ || ws_size < WS_END) { fprintf(stderr, "kernel_launch: unexpected shapes: n_in %d out %d ws %zu (need %zu)\n", n_in, out_size, ws_size, (size_t)WS_END); grid = -1; return; }
        int dev = 0, cus = 0, per_cu = 0;
        if (hipGetDevice(&dev) != hipSuccess || hipDeviceGetAttribute(&cus, hipDeviceAttributeMultiprocessorCount, dev) != hipSuccess) { grid = -1; return; }
        if (hipFuncSetAttribute((const void*)mk_fwd, hipFuncAttributeMaxDynamicSharedMemorySize, LDS_BYTES) != hipSuccess) { fprintf(stderr, "kernel_launch: hipFuncSetAttribute failed\n"); grid = -1; return; }
        if (hipOccupancyMaxActiveBlocksPerMultiprocessor(&per_cu, (const void*)mk_fwd, NWAVES * 64, LDS_BYTES) != hipSuccess || per_cu < 1) { fprintf(stderr, "kernel_launch: occupancy query reports %d\n", per_cu); }
        (void)hipGetLastError();
        grid = cus;
        if (grid != 256) fprintf(stderr, "kernel_launch: %d CUs (built for 256)\n", grid);
    }
    if (grid < 0) return;
    if (hipMemsetAsync((char*)d_ws + WS_CTL, 0, CTL_ZERO_BYTES, stream) != hipSuccess) return;
    Args a{};
    for (int i = 0; i < 23; ++i) a.in[i] = (const float*)d_in[i];
    a.out = (float*)d_out; a.ws = (unsigned char*)d_ws;
#if MK_N_LAUNCHES == 1
    a.ph_lo = 0; a.ph_hi = N_PHASES; a.li = 0;
    hipLaunchKernelGGL(mk_fwd, dim3(grid), dim3(NWAVES * 64), LDS_BYTES, stream, a);
#else
    for (int p = 0; p < N_PHASES; ++p) { a.ph_lo = p; a.ph_hi = p + 1; a.li = 0; hipLaunchKernelGGL(mk_fwd, dim3(grid), dim3(NWAVES * 64), LDS_BYTES, stream, a); }
#endif
}
```
